# Optimizing an MI355X kernel written in HIP

```python
import jax
import jax.numpy as jnp
from jax import lax
import numpy as np

D_MODEL = 1024
BATCH = 16
SEQ = 2048
DEPTH = 1

CTX_LEN = 256
GRID_W = 64

RET_HEADS = 8
RET_DK = 64
RET_DV = 64
QK_WIDTH = RET_HEADS * RET_DK
RET_WIDTH = RET_HEADS * RET_DV
RET_CHUNK = 128
ROPE_PAIRS_PER_AXIS = RET_DK // 4
ROPE_BASE = 10000.0

FNET_GROUPS = 4
FNET_GROUP_DIM = 128
FNET_WIDTH = FNET_GROUPS * FNET_GROUP_DIM

MIX_WIDTH = RET_WIDTH + FNET_WIDTH

Q_OFF = 0
K_OFF = Q_OFF + QK_WIDTH
V_OFF = K_OFF + QK_WIDTH
G_OFF = V_OFF + RET_WIDTH
F_OFF = G_OFF + RET_WIDTH
IN_WIDTH = F_OFF + FNET_WIDTH

PEER_HEADS = 8
PEER_D_KEY = 256
PEER_N_KEYS = 128
PEER_N_EXPERTS = PEER_N_KEYS * PEER_N_KEYS
PEER_TOPK = 16
PEER_BLOCK = 128

N_MOD = 6
EPS = 1e-6

kernel_name = 'hybrid_retention_fnet_peer_dit_layer'


def _rms(x, gain):
    xf = x.astype(jnp.float32)
    y = xf * lax.rsqrt(jnp.mean(xf * xf, axis=-1, keepdims=True) + EPS)
    return (y * gain.astype(jnp.float32)).astype(x.dtype)


def _modulate(h, shift, scale):
    return h * (1 + scale) + shift


def _heads(t, d):
    b, n, _ = t.shape
    return t.reshape(b, n, -1, d).astype(jnp.float32)


def _axial_rope(rows):
    row_ids = jnp.repeat(jnp.arange(rows, dtype=jnp.float32), GRID_W)
    col_ids = jnp.tile(jnp.arange(GRID_W, dtype=jnp.float32), rows)
    freqs = ROPE_BASE ** (-jnp.arange(ROPE_PAIRS_PER_AXIS, dtype=jnp.float32) / ROPE_PAIRS_PER_AXIS)
    ang = jnp.concatenate([row_ids[:, None] * freqs[None, :], col_ids[:, None] * freqs[None, :]], axis=-1)
    return jnp.cos(ang), jnp.sin(ang)


def _rotate(t, cos, sin):
    half = t.shape[-1] // 2
    t1, t2 = t[..., :half], t[..., half:]
    cs = cos[None, :, None, :]
    sn = sin[None, :, None, :]
    return jnp.concatenate([t1 * cs - t2 * sn, t2 * cs + t1 * sn], axis=-1)


def _log_gamma(a):
    return jnp.log1p(-jnp.exp(a.astype(jnp.float32)))


def _retention_chunked(q, k, v, log_gamma, state0, strict):
    b, n, h, _ = q.shape
    c = RET_CHUNK
    nc = n // c

    def to_chunks(t):
        return t.reshape(b, nc, c, h, t.shape[-1]).transpose(1, 0, 3, 2, 4)

    qc, kc, vc = to_chunks(q), to_chunks(k), to_chunks(v)
    pos = jnp.arange(c, dtype=jnp.float32)
    diff = pos[:, None] - pos[None, :]
    allowed = diff > 0 if strict else diff >= 0
    decay_mask = jnp.where(allowed[None], jnp.exp(log_gamma[:, None, None] * jnp.maximum(diff, 0.0)[None]), 0.0)
    q_decay = jnp.exp(log_gamma[:, None] * (pos + 1.0)[None, :])
    k_decay = jnp.exp(log_gamma[:, None] * (c - 1.0 - pos)[None, :])
    chunk_decay = jnp.exp(log_gamma * c)

    def step(state, inp):
        qi, ki, vi = inp
        scores = jnp.einsum('bhid,bhjd->bhij', qi, ki) * decay_mask[None]
        inner = jnp.einsum('bhij,bhjv->bhiv', scores, vi)
        cross = jnp.einsum('bhid,bhdv->bhiv', qi, state) * q_decay[None, :, :, None]
        new_state = state * chunk_decay[None, :, None, None] + jnp.einsum('bhjd,bhjv->bhdv', ki * k_decay[None, :, :, None], vi)
        return new_state, inner + cross

    final, out = lax.scan(step, state0, (qc, kc, vc))
    out = out.transpose(1, 0, 3, 2, 4).reshape(b, n, h, v.shape[-1])
    return out, final


def _bidir_retention(q, k, v, log_gf, log_gb, state_f0, state_b0):
    out_f, st_f = _retention_chunked(q, k, v, log_gf, state_f0, False)
    flip = lambda t: jnp.flip(t, axis=1)
    out_b, st_b = _retention_chunked(flip(q), flip(k), flip(v), log_gb, state_b0, True)
    return out_f + flip(out_b), st_f, st_b


def _context_states(k, v, log_gf, log_gb):
    n = k.shape[1]
    pos = jnp.arange(n, dtype=jnp.float32)
    wf = jnp.exp(log_gf[:, None] * (n - 1.0 - pos)[None, :])
    wb = jnp.exp(log_gb[:, None] * pos[None, :])
    st_f = jnp.einsum('bnhd,hn,bnhv->bhdv', k, wf, v)
    st_b = jnp.einsum('bnhd,hn,bnhv->bhdv', k, wb, v)
    return st_f, st_b


def _fourier_mix(f):
    b, n, _ = f.shape
    fg = f.astype(jnp.float32).reshape(b, n, FNET_GROUPS, FNET_GROUP_DIM)
    return jnp.fft.fftn(fg, axes=(1, 3), norm='ortho').real.reshape(b, n, FNET_WIDTH)


def _mixer(h, w_in_l, log_gf, log_gb, ret_gain, state_f0, state_b0, rope):
    b, n, _ = h.shape
    proj = h @ w_in_l
    q = _heads(proj[..., Q_OFF:K_OFF], RET_DK)
    k = _heads(proj[..., K_OFF:V_OFF], RET_DK) * (RET_DK ** -0.5)
    v = _heads(proj[..., V_OFF:G_OFF], RET_DV)
    gate = proj[..., G_OFF:F_OFF].astype(jnp.float32)
    if rope is not None:
        cos, sin = rope
        q = _rotate(q, cos, sin)
        k = _rotate(k, cos, sin)
    ret, st_f, st_b = _bidir_retention(q, k, v, log_gf, log_gb, state_f0, state_b0)
    ret = ret * lax.rsqrt(jnp.mean(ret * ret, axis=-1, keepdims=True) + EPS)
    ret = ret.reshape(b, n, RET_WIDTH) * ret_gain.astype(jnp.float32) * jax.nn.silu(gate)
    four = _fourier_mix(proj[..., F_OFF:])
    mix = jnp.concatenate([ret, four], axis=-1).astype(h.dtype)
    return mix, st_f, st_b


def _peer(h, w_q, keys1, keys2, u, v):
    b, n, d = h.shape
    q = (h @ w_q).reshape(b, n, PEER_HEADS, PEER_D_KEY).astype(jnp.float32)
    half = PEER_D_KEY // 2
    s1 = jnp.einsum('bnhd,kd->bnhk', q[..., :half], keys1.astype(jnp.float32))
    s2 = jnp.einsum('bnhd,kd->bnhk', q[..., half:], keys2.astype(jnp.float32))
    v1, i1 = lax.top_k(s1, PEER_TOPK)
    v2, i2 = lax.top_k(s2, PEER_TOPK)
    cand = (v1[..., :, None] + v2[..., None, :]).reshape(b, n, PEER_HEADS, PEER_TOPK * PEER_TOPK)
    top_v, top_i = lax.top_k(cand, PEER_TOPK)
    e1 = jnp.take_along_axis(i1, top_i // PEER_TOPK, axis=-1)
    e2 = jnp.take_along_axis(i2, top_i % PEER_TOPK, axis=-1)
    ids = e1 * PEER_N_KEYS + e2
    wts = jax.nn.softmax(top_v, axis=-1)
    t = b * n
    nb = t // PEER_BLOCK
    k_all = PEER_HEADS * PEER_TOPK
    hb = h.reshape(nb, PEER_BLOCK, d)
    idb = ids.reshape(nb, PEER_BLOCK, k_all)
    wb = wts.reshape(nb, PEER_BLOCK, k_all)

    def block(args):
        hx, idx, w = args
        ue = jnp.take(u, idx, axis=0)
        act = jnp.einsum('td,tkd->tk', hx, ue).astype(jnp.float32)
        coef = (w * jax.nn.gelu(act, approximate=False)).astype(h.dtype)
        ve = jnp.take(v, idx, axis=0)
        return jnp.einsum('tk,tkd->td', coef, ve)

    out = lax.map(block, (hb, idb, wb))
    return out.reshape(b, n, d).astype(h.dtype)


def setup_inputs(seed: int = 0) -> dict:
    key = jax.random.key(seed)
    ks = jax.random.split(key, 24)
    f32 = jnp.float32

    def nrm(k, shape, scale):
        return jax.random.normal(k, shape, f32) * scale

    def gain(k, shape):
        return 1.0 + 0.05 * jax.random.normal(k, shape, f32)

    base_decay = -(5.0 + jnp.arange(RET_HEADS, dtype=f32)) * np.float32(np.log(2.0))
    return {
        'x': nrm(ks[0], (BATCH, SEQ, D_MODEL), 1.0),
        'c': nrm(ks[1], (BATCH, D_MODEL), 1.0),
        'ctx': nrm(ks[2], (BATCH, CTX_LEN, D_MODEL), 1.0),
        'c_ctx': nrm(ks[3], (D_MODEL,), 1.0),
        'w_ada': nrm(ks[4], (DEPTH, D_MODEL, N_MOD * D_MODEL), 0.5 * D_MODEL ** -0.5),
        'b_ada': nrm(ks[5], (DEPTH, N_MOD * D_MODEL), 0.01),
        'norm_pre_mix': gain(ks[6], (DEPTH, D_MODEL)),
        'norm_post_mix': gain(ks[7], (DEPTH, D_MODEL)),
        'w_in': nrm(ks[8], (DEPTH, D_MODEL, IN_WIDTH), D_MODEL ** -0.5),
        'ret_decay_fwd': base_decay[None, :] + nrm(ks[9], (DEPTH, RET_HEADS), 0.05),
        'ret_decay_bwd': base_decay[None, :] + nrm(ks[10], (DEPTH, RET_HEADS), 0.05),
        'ret_norm_gain': gain(ks[11], (DEPTH, RET_WIDTH)),
        'w_out': nrm(ks[12], (DEPTH, MIX_WIDTH, D_MODEL), MIX_WIDTH ** -0.5),
        'norm_pre_ffn': gain(ks[13], (DEPTH, D_MODEL)),
        'norm_post_ffn': gain(ks[14], (DEPTH, D_MODEL)),
        'peer_w_query': nrm(ks[15], (DEPTH, D_MODEL, PEER_HEADS * PEER_D_KEY), D_MODEL ** -0.5),
        'peer_sub_keys_1': nrm(ks[16], (DEPTH, PEER_N_KEYS, PEER_D_KEY // 2), (PEER_D_KEY // 2) ** -0.5),
        'peer_sub_keys_2': nrm(ks[17], (DEPTH, PEER_N_KEYS, PEER_D_KEY // 2), (PEER_D_KEY // 2) ** -0.5),
        'peer_u': nrm(ks[18], (DEPTH, PEER_N_EXPERTS, D_MODEL), D_MODEL ** -0.5),
        'peer_v': nrm(ks[19], (DEPTH, PEER_N_EXPERTS, D_MODEL), D_MODEL ** -0.5),
    }


def reference(x, c, ctx, c_ctx, w_ada, b_ada, norm_pre_mix, norm_post_mix, w_in, ret_decay_fwd, ret_decay_bwd, ret_norm_gain, w_out, norm_pre_ffn, norm_post_ffn, peer_w_query, peer_sub_keys_1, peer_sub_keys_2, peer_u, peer_v):
    n = x.shape[1]
    rows = n // GRID_W
    rope = _axial_rope(rows)
    for i in range(DEPTH):
        mod_x = (jax.nn.silu(c) @ w_ada[i] + b_ada[i])[:, None, :]
        mod_c = (jax.nn.silu(c_ctx) @ w_ada[i] + b_ada[i])[None, None, :]
        sh1, sc1, g1, sh2, sc2, g2 = jnp.split(mod_x, N_MOD, axis=-1)
        csh1, csc1, cg1, csh2, csc2, cg2 = jnp.split(mod_c, N_MOD, axis=-1)
        log_gf = _log_gamma(ret_decay_fwd[i])
        log_gb = _log_gamma(ret_decay_bwd[i])
        update_ctx = i + 1 < DEPTH

        hc = _modulate(_rms(ctx, norm_pre_mix[i]), csh1, csc1)
        if update_ctx:
            zeros = jnp.zeros((ctx.shape[0], RET_HEADS, RET_DK, RET_DV), jnp.float32)
            mix_c, st_f, st_b = _mixer(hc, w_in[i], log_gf, log_gb, ret_norm_gain[i], zeros, zeros, None)
        else:
            kv = hc @ w_in[i][:, K_OFF:G_OFF]
            k_c = _heads(kv[..., :QK_WIDTH], RET_DK) * (RET_DK ** -0.5)
            v_c = _heads(kv[..., QK_WIDTH:], RET_DV)
            st_f, st_b = _context_states(k_c, v_c, log_gf, log_gb)

        hx = _modulate(_rms(x, norm_pre_mix[i]), sh1, sc1)
        mix_x, _, _ = _mixer(hx, w_in[i], log_gf, log_gb, ret_norm_gain[i], st_f, st_b, rope)
        x = x + g1 * _rms(mix_x @ w_out[i], norm_post_mix[i])

        h2 = _modulate(_rms(x, norm_pre_ffn[i]), sh2, sc2)
        x = x + g2 * _rms(_peer(h2, peer_w_query[i], peer_sub_keys_1[i], peer_sub_keys_2[i], peer_u[i], peer_v[i]), norm_post_ffn[i])

        if update_ctx:
            ctx = ctx + cg1 * _rms(mix_c @ w_out[i], norm_post_mix[i])
            hc2 = _modulate(_rms(ctx, norm_pre_ffn[i]), csh2, csc2)
            ctx = ctx + cg2 * _rms(_peer(hc2, peer_w_query[i], peer_sub_keys_1[i], peer_sub_keys_2[i], peer_u[i], peer_v[i]), norm_post_ffn[i])
    return x
```

```cpp
#include <hip/hip_runtime.h>
#include <hip/hip_cooperative_groups.h>
#include <cstdio>
namespace cg = cooperative_groups;

#define DI __device__ __forceinline__
#define LAS __attribute__((address_space(3)))
typedef unsigned short bf16_t;
typedef short bf16x8 __attribute__((ext_vector_type(8)));
typedef float f32x4 __attribute__((ext_vector_type(4)));
typedef float f32x16 __attribute__((ext_vector_type(16)));
typedef unsigned u32x4 __attribute__((ext_vector_type(4)));
typedef unsigned u32x2 __attribute__((ext_vector_type(2)));

constexpr int NB = 16, SEQ = 2048, DM = 1024, NTOK = NB * SEQ, CTXL = 256, NCTX = NB * CTXL;
constexpr int INW = 2560, F_OFF = 2048;
constexpr float EPSV = 1e-6f;
constexpr int NTHREADS = 512, NWAVES = 8;
constexpr int LDS_BYTES = 160 * 1024;

constexpr size_t MB = 1024 * 1024;
constexpr size_t WS_MOD = 64 * 1024;
constexpr size_t WS_ROPE = 512 * 1024;
constexpr size_t WS_KEYS = 1 * MB;
constexpr size_t WS_WIN = 2 * MB;
constexpr size_t WS_WF = 6 * MB;
constexpr size_t WS_WOUT = 8 * MB;
constexpr size_t WS_WQ = 10 * MB;
constexpr size_t WS_DFT = 14 * MB;
constexpr size_t WS_HC = 30 * MB;
constexpr size_t WS_CKV = 38 * MB;
constexpr size_t WS_IDS = 46 * MB;
constexpr size_t WS_WTS = 62 * MB;
constexpr size_t WS_HX = 80 * MB;
constexpr size_t WS_QKVG = 144 * MB;
constexpr size_t WS_FT = 272 * MB;
constexpr size_t WS_MIX = 336 * MB;
constexpr size_t WS_SB = 400 * MB;
constexpr size_t WS_END = 416 * MB;

namespace pg8 {
#define PG8_LAS __attribute__((address_space(3)))
constexpr int BM = 256, BK = 64, HALF = 128, HTB = HALF * BK * 2, STAGE_BYTES = 8 * HTB, NXCD = 8, WGM = 8;
__host__ __device__ __forceinline__ int lds_byte(int r, int c) { const int st = (r >> 4) * 2 + (c >> 5), rr = r & 15, cc = c & 31, ob = rr * 64 + cc * 2; return st * 1024 + (ob ^ (((ob >> 9) & 1) << 5)); }
__host__ __device__ __forceinline__ void stage_rc(int b, int& R, int& C) { const int st = b / 1024, sb = b % 1024, swz = sb ^ (((sb >> 9) & 1) << 5); R = (st >> 1) * 16 + swz / 64; C = (st & 1) * 32 + (swz % 64) / 2; }
__host__ __device__ __forceinline__ int perm32(int rho) { const int n = rho >> 4, i = rho & 15; return 8 * (i >> 2) + 4 * n + (i & 3); }
struct Unit { int pm, pn; };
struct Gemm { const bf16_t* A; const bf16_t* Bt; int M, N, K; };
struct StaticOrder {
    int nM, nN, nwg, G, c;
    __host__ __device__ void init(int M, int N, int G_, int c_) { nM = M / BM; nN = N / BM; nwg = nM * nN; G = G_; c = c_; }
    __host__ __device__ bool next(int i, Unit& u) const {
        const long L = (long)i * G + c; if (L >= nwg) return false;
        int wgid = (int)L; { const int q = nwg / NXCD, r = nwg % NXCD, xcd = wgid % NXCD, off = wgid / NXCD; wgid = (xcd < r ? xcd * (q + 1) : r * (q + 1) + (xcd - r) * q) + off; }
        const int nig = WGM * nN, gid = wgid / nig, fm = gid * WGM, gsz = (nM - fm) < WGM ? (nM - fm) : WGM;
        u.pm = fm + ((wgid % nig) % gsz); u.pn = (wgid % nig) / gsz; return true;
    }
    __device__ __forceinline__ void a_ready(const Unit&) const {}
    __device__ __forceinline__ void done(const Unit&) const {}
};
__device__ __forceinline__ unsigned cvt_pk_bf16(float lo, float hi) { unsigned r; asm volatile("v_cvt_pk_bf16_f32 %0, %1, %2" : "=v"(r) : "v"(lo), "v"(hi)); return r; }

struct EpiF32 {
    static constexpr bool PERM = false;
    float* C; int ldc;
    __device__ __forceinline__ void operator()(const f32x4 (&acc)[2][2][4][2], const Unit& u, int wr, int wc, int fr, int fq) const {
        const int row0 = u.pm * BM + wr * 64 + fr, col0 = u.pn * BM + wc * 32 + 4 * fq;
#pragma unroll
        for (int ai = 0; ai < 2; ++ai)
#pragma unroll
            for (int m = 0; m < 4; ++m) { float* rowp = C + (size_t)(row0 + ai * HALF + m * 16) * ldc + col0;
#pragma unroll
                for (int bj = 0; bj < 2; ++bj)
#pragma unroll
                    for (int n = 0; n < 2; ++n) *(f32x4*)(rowp + bj * HALF + n * 16) = acc[ai][bj][m][n]; }
    }
};
template <class F> struct EpiBf16F {
    static constexpr bool PERM = true;
    F f;
    __device__ __forceinline__ void operator()(const f32x4 (&acc)[2][2][4][2], const Unit& u, int wr, int wc, int fr, int fq) const {
        const int row0 = u.pm * BM + wr * 64 + fr, col0 = u.pn * BM + wc * 32 + 8 * fq;
#pragma unroll
        for (int ai = 0; ai < 2; ++ai)
#pragma unroll
            for (int m = 0; m < 4; ++m)
#pragma unroll
                for (int bj = 0; bj < 2; ++bj) f(row0 + ai * HALF + m * 16, col0 + bj * HALF, acc[ai][bj][m][0], acc[ai][bj][m][1]);
    }
};

template <class Epi, class Sched>
__device__ __forceinline__ void gemm_phase(PG8_LAS unsigned char* lds, const Gemm g, const Sched& S, const Epi& E) {
    const int tid = threadIdx.x, wid = __builtin_amdgcn_readfirstlane(tid >> 6), lane = tid & 63, wr = wid >> 2, wc = wid & 3, fr = lane & 15, fq = lane >> 4;
    const int K = g.K, nt = K / BK;
    unsigned voffA[2], voffB[2];
#pragma unroll
    for (int i = 0; i < 2; ++i) { int R, C; stage_rc(tid * 16 + i * 8192, R, C); const int Rb = Epi::PERM ? ((R & ~31) + perm32(R & 31)) : R;
        voffA[i] = (unsigned)(R * K + C) * 2u; voffB[i] = (unsigned)(Rb * K + C) * 2u; }
    const size_t kstep = (size_t)(BK * 2);
    const size_t hstep = (size_t)HALF * K * 2;
    const size_t tstep = 2 * hstep;
    const unsigned ldsw = (unsigned)wid * 1024u;
    const int aoff = lds_byte(wr * 64 + fr, fq * 8), boff = lds_byte(wc * 32 + fr, fq * 8);
#define PG8_SA(b, h) (((b) * 2 + (h)) * HTB)
#define PG8_SB(b, h) ((4 + (b) * 2 + (h)) * HTB)
#define PG8_STAGE(bufoff, gbase, voff) do { _Pragma("unroll") for (int _i = 0; _i < 2; ++_i) \
        __builtin_amdgcn_global_load_lds((const unsigned*)((const char*)(gbase) + (voff)[_i]), (PG8_LAS unsigned*)(lds + (bufoff) + ldsw + _i * 8192), 16, 0, 0); } while (0)
#define PG8_LDA(dst, b, h) do { _Pragma("unroll") for (int m = 0; m < 4; ++m) _Pragma("unroll") for (int k = 0; k < 2; ++k) dst[m][k] = *(const PG8_LAS bf16x8*)(lds + PG8_SA(b, h) + aoff + m * 2048 + k * 1024); } while (0)
#define PG8_LDB(dst, b, h) do { _Pragma("unroll") for (int n = 0; n < 2; ++n) _Pragma("unroll") for (int k = 0; k < 2; ++k) dst[n][k] = *(const PG8_LAS bf16x8*)(lds + PG8_SB(b, h) + boff + n * 2048 + k * 1024); } while (0)
#define PG8_MMA(ai, bj, At, Bt) do { __builtin_amdgcn_s_setprio(1); _Pragma("unroll") for (int m = 0; m < 4; ++m) _Pragma("unroll") for (int n = 0; n < 2; ++n) _Pragma("unroll") for (int k = 0; k < 2; ++k) \
        acc[ai][bj][m][n] = __builtin_amdgcn_mfma_f32_16x16x32_bf16(Bt[n][k], At[m][k], acc[ai][bj][m][n], 0, 0, 0); __builtin_amdgcn_s_setprio(0); } while (0)
#define PG8_WAIT_V(n) asm volatile("s_waitcnt vmcnt(" #n ")" ::: "memory")
#define PG8_WAIT_L(n) asm volatile("s_waitcnt lgkmcnt(" #n ")" ::: "memory")
#define PG8_BAR __builtin_amdgcn_s_barrier()
#define PG8_SCHED __builtin_amdgcn_sched_barrier(0)
    Unit cur, nxt; int ui = 0;
    if (!S.next(0, cur)) return;
    f32x4 acc[2][2][4][2];
#pragma unroll
    for (int a = 0; a < 2; ++a)
#pragma unroll
        for (int b = 0; b < 2; ++b)
#pragma unroll
            for (int m = 0; m < 4; ++m)
#pragma unroll
                for (int n = 0; n < 2; ++n) acc[a][b][m][n] = (f32x4){0.f, 0.f, 0.f, 0.f};
    bf16x8 At[4][2], B0[2][2], B1[2][2];
    const char* cA = (const char*)g.A + (size_t)cur.pm * tstep; const char* cB = (const char*)g.Bt + (size_t)cur.pn * tstep;
    S.a_ready(cur);
    PG8_STAGE(PG8_SB(0, 0), cB, voffB); PG8_STAGE(PG8_SA(0, 0), cA, voffA); PG8_STAGE(PG8_SB(0, 1), cB + hstep, voffB); PG8_STAGE(PG8_SA(0, 1), cA + hstep, voffA);
    if (wr == 1) PG8_BAR;
    PG8_WAIT_V(4); PG8_BAR;
    PG8_STAGE(PG8_SB(1, 0), cB + kstep, voffB); PG8_STAGE(PG8_SA(1, 0), cA + kstep, voffA); PG8_STAGE(PG8_SB(1, 1), cB + hstep + kstep, voffB);
    PG8_WAIT_V(6); PG8_BAR;
    for (;;) {
        const bool has_next = S.next(ui + 1, nxt);
        const char* nA = has_next ? (const char*)g.A + (size_t)nxt.pm * tstep : cA; const char* nB = has_next ? (const char*)g.Bt + (size_t)nxt.pn * tstep : cB;
        for (int t = 0; t < nt; t += 2) {
            const bool last = (t == nt - 2);
            const char* a1 = cA + (size_t)(t + 1) * kstep;
            const char* a2 = last ? nA : cA + (size_t)(t + 2) * kstep; const char* b2 = last ? nB : cB + (size_t)(t + 2) * kstep;
            const char* a3 = a2 + kstep; const char* b3 = b2 + kstep;
            if (last && has_next) S.a_ready(nxt);
            PG8_LDB(B0, 0, 0); PG8_SCHED; PG8_LDA(At, 0, 0); PG8_STAGE(PG8_SA(1, 1), a1 + hstep, voffA);
            PG8_WAIT_L(8); PG8_BAR; PG8_WAIT_L(0); PG8_MMA(0, 0, At, B0); PG8_BAR; PG8_SCHED;
            PG8_LDB(B1, 0, 1); PG8_STAGE(PG8_SB(0, 0), b2, voffB);
            PG8_BAR; PG8_WAIT_L(0); PG8_MMA(0, 1, At, B1); PG8_BAR;
            PG8_LDA(At, 0, 1); PG8_STAGE(PG8_SA(0, 0), a2, voffA);
            PG8_BAR; PG8_WAIT_L(0); PG8_MMA(1, 0, At, B0); PG8_BAR; PG8_SCHED;
            PG8_STAGE(PG8_SB(0, 1), b2 + hstep, voffB);
            PG8_WAIT_V(6); PG8_BAR; PG8_MMA(1, 1, At, B1); PG8_BAR;
            PG8_LDB(B0, 1, 0); PG8_SCHED; PG8_LDA(At, 1, 0); PG8_STAGE(PG8_SA(0, 1), a2 + hstep, voffA);
            PG8_WAIT_L(8); PG8_BAR; PG8_WAIT_L(0); PG8_MMA(0, 0, At, B0); PG8_BAR; PG8_SCHED;
            PG8_LDB(B1, 1, 1); PG8_STAGE(PG8_SB(1, 0), b3, voffB);
            PG8_BAR; PG8_WAIT_L(0); PG8_MMA(0, 1, At, B1); PG8_BAR;
            PG8_LDA(At, 1, 1); PG8_STAGE(PG8_SA(1, 0), a3, voffA);
            PG8_BAR; PG8_WAIT_L(0); PG8_MMA(1, 0, At, B0); PG8_BAR; PG8_SCHED;
            PG8_STAGE(PG8_SB(1, 1), b3 + hstep, voffB);
            PG8_WAIT_V(6); PG8_BAR; PG8_MMA(1, 1, At, B1); PG8_BAR;
        }
        E(acc, cur, wr, wc, fr, fq); S.done(cur);
        if (!has_next) break;
#pragma unroll
        for (int a = 0; a < 2; ++a)
#pragma unroll
            for (int b = 0; b < 2; ++b)
#pragma unroll
                for (int m = 0; m < 4; ++m)
#pragma unroll
                    for (int n = 0; n < 2; ++n) acc[a][b][m][n] = (f32x4){0.f, 0.f, 0.f, 0.f};
        cur = nxt; cA = nA; cB = nB; ++ui;
    }
    PG8_WAIT_V(0);
    if (wr == 0) PG8_BAR;
    PG8_BAR;
#undef PG8_SA
#undef PG8_SB
#undef PG8_STAGE
#undef PG8_LDA
#undef PG8_LDB
#undef PG8_MMA
#undef PG8_WAIT_V
#undef PG8_WAIT_L
#undef PG8_BAR
#undef PG8_SCHED
}
}

DI unsigned pk2(float lo, float hi) { return pg8::cvt_pk_bf16(lo, hi); }
DI bf16_t f2bf(float f) { return (bf16_t)(pk2(f, 0.f) & 0xffffu); }
DI float bf2f(bf16_t b) { return __uint_as_float(((unsigned)b) << 16); }
DI float bflo(unsigned w) { return __uint_as_float(w << 16); }
DI float bfhi(unsigned w) { return __uint_as_float(w & 0xffff0000u); }
DI float wave_sum(float v) {
#pragma unroll
    for (int o = 1; o < 64; o <<= 1) v += __shfl_xor(v, o);
    return v;
}
DI float siluf(float x) { return x / (1.f + __expf(-x)); }
DI float gelu_erf(float a) { return 0.5f * a * (1.f + erff(a * 0.70710678118654752f)); }
#define LDS_WAIT() asm volatile("s_waitcnt lgkmcnt(0)" ::: "memory")
#define MFMA32(a, b, c) __builtin_amdgcn_mfma_f32_32x32x16_bf16((a), (b), (c), 0, 0, 0)
DI int crow(int reg, int h) { return (reg & 3) + 8 * (reg >> 2) + 4 * h; }

struct Params { const float* in[20]; float* out; unsigned char* ws; int ph_lo, ph_hi; };
enum { I_X = 0, I_C, I_CTX, I_CCTX, I_WADA, I_BADA, I_NPREMIX, I_NPOSTMIX, I_WIN, I_DECF, I_DECB, I_RETGAIN, I_WOUT, I_NPREFFN, I_NPOSTFFN, I_WQ, I_KEYS1, I_KEYS2, I_U, I_V };

DI int win_srccol(int n) { if (n < 1024) { const int p = n & 63; return (n & ~63) + (p >> 1) + 32 * (p & 1); } return n; }
DI void p0_transpose_item(const float* W, int ldw, int nout, bf16_t* WT, int mode, LAS float* scr, int item, int lane) {
    const int nblk = nout / 32, kb = item / nblk, nb = item % nblk, k0 = 64 * kb, n0 = 32 * nb;
    const int nn = n0 + (lane & 31);
    const int sc = mode ? win_srccol(nn) : nn;
    const float scale = (mode && nn >= 512 && nn < 1024) ? 0.125f : 1.0f;
#pragma unroll 8
    for (int i = 0; i < 32; ++i) { const int kk = 2 * i + (lane >> 5); scr[kk * 33 + (lane & 31)] = W[(size_t)(k0 + kk) * ldw + sc] * scale; }
    LDS_WAIT();
    const int c = lane & 7;
#pragma unroll
    for (int j = 0; j < 4; ++j) { const int n = (lane >> 3) + 8 * j; const LAS float* s = scr + (8 * c) * 33 + n;
        u32x4 o; o.x = pk2(s[0 * 33], s[1 * 33]); o.y = pk2(s[2 * 33], s[3 * 33]); o.z = pk2(s[4 * 33], s[5 * 33]); o.w = pk2(s[6 * 33], s[7 * 33]);
        *(u32x4*)(WT + (size_t)(n0 + n) * 1024 + k0 + 8 * c) = o; }
    LDS_WAIT();
}

DI void phase0(const Params& P, LAS unsigned char* lds) {
    const int tid = threadIdx.x, lane = tid & 63, wave = tid >> 6;
    const int gw = blockIdx.x * NWAVES + wave, NGW = gridDim.x * NWAVES;
    const int gt = blockIdx.x * NTHREADS + tid, NGT = gridDim.x * NTHREADS;
    unsigned char* ws = P.ws;
    LAS float* scr = (LAS float*)(lds + wave * 8704);
    LAS float* ctab = (LAS float*)(lds + 69632);
    LAS float* stab = ctab + 128;
    LAS float* svec = (LAS float*)(lds + 71680);
    if (tid < 128) { float s, c; sincospif((float)tid * (1.0f / 64.0f), &s, &c); ctab[tid] = c; stab[tid] = s; }
    for (int i = tid; i < 17 * 1024; i += NTHREADS) { const float v = (i < 16384) ? P.in[I_C][i] : P.in[I_CCTX][i - 16384]; svec[i] = siluf(v); }
    __syncthreads();
    {
        bf16_t* WIN = (bf16_t*)(ws + WS_WIN); bf16_t* WOUT = (bf16_t*)(ws + WS_WOUT); bf16_t* WQ = (bf16_t*)(ws + WS_WQ);
        constexpr int I1 = 16 * 64, I2 = 16 * 32, I3 = 16 * 64;
        for (int it = gw; it < I1 + I2 + I3; it += NGW) {
            int r = it;
            if (r < I1) { p0_transpose_item(P.in[I_WIN], INW, 2048, WIN, 1, scr, r, lane); continue; } r -= I1;
            if (r < I2) { p0_transpose_item(P.in[I_WOUT], 1024, 1024, WOUT, 0, scr, r, lane); continue; } r -= I2;
            p0_transpose_item(P.in[I_WQ], 2048, 2048, WQ, 0, scr, r, lane);
        }
    }
    {
        bf16_t* WF = (bf16_t*)(ws + WS_WF);
        for (int it = gw; it < 4096; it += NGW) {
            const int kk = it >> 2, g = it & 3;
            const float* src = P.in[I_WIN] + (size_t)kk * INW + F_OFF + g * 128;
            scr[lane] = src[lane]; scr[lane + 64] = src[lane + 64];
            LDS_WAIT();
#pragma unroll
            for (int q = 0; q < 2; ++q) {
                const int l = lane + 64 * q; float ac = 0.f, as = 0.f;
                for (int c = 0; c < 128; ++c) { const float f = scr[c]; const int m = (c * l) & 127; ac += f * ctab[m]; as += f * stab[m]; }
                WF[(size_t)((g * 2 + 0) * 128 + l) * 1024 + kk] = f2bf(ac);
                WF[(size_t)((g * 2 + 1) * 128 + l) * 1024 + kk] = f2bf(as);
            }
            LDS_WAIT();
        }
    }
    {
        bf16_t* DFT = (bf16_t*)(ws + WS_DFT);
        for (int idx = gt; idx < 2048 * 2048; idx += NGT) {
            const int k = idx >> 11, c2 = (idx & 2047) * 2, p = c2 >> 11, n0 = c2 & 2047;
            float s0, c0, s1, c1;
            sincospif((float)((n0 * k) & 2047) * (1.0f / 1024.0f), &s0, &c0);
            sincospif((float)(((n0 + 1) * k) & 2047) * (1.0f / 1024.0f), &s1, &c1);
            const float v0 = (p ? -s0 : c0) * (1.0f / 512.0f), v1 = (p ? -s1 : c1) * (1.0f / 512.0f);
            *(unsigned*)(DFT + (size_t)k * 4096 + c2) = pk2(v0, v1);
        }
    }
    {
        float* RC = (float*)(ws + WS_ROPE); float* RS = RC + 2048 * 32;
        for (int idx = gt; idx < 2048 * 32; idx += NGT) {
            const int n = idx >> 5, j = idx & 31; const float pos = (float)((j < 16) ? (n >> 6) : (n & 63));
            const float freq = powf(10000.0f, -(float)(j & 15) * (1.0f / 16.0f)); const float ang = pos * freq;
            RC[idx] = cosf(ang); RS[idx] = sinf(ang);
        }
        bf16_t* KEYS = (bf16_t*)(ws + WS_KEYS);
        for (int idx = gt; idx < 2 * 128 * 128; idx += NGT) KEYS[idx] = f2bf(idx < 16384 ? P.in[I_KEYS1][idx] : P.in[I_KEYS2][idx - 16384]);
    }
    {
        float* MOD = (float*)(ws + WS_MOD);
        for (int cb = blockIdx.x; cb < 256; cb += gridDim.x) {
            if (wave < 6) {
                const int col = cb * 24 + wave * 4;
                f32x4 acc[17];
#pragma unroll
                for (int r = 0; r < 17; ++r) acc[r] = (f32x4){0.f, 0.f, 0.f, 0.f};
#pragma unroll 1
                for (int i = 0; i < 16; ++i) {
                    const int k = lane + 64 * i;
                    const f32x4 w = *(const f32x4*)(P.in[I_WADA] + (size_t)k * 6144 + col);
#pragma unroll
                    for (int r = 0; r < 17; ++r) { const float s = svec[r * 1024 + k]; acc[r] += w * s; }
                }
#pragma unroll
                for (int r = 0; r < 17; ++r) {
                    f32x4 a = acc[r];
#pragma unroll
                    for (int o = 1; o < 64; o <<= 1) { a.x += __shfl_xor(a.x, o); a.y += __shfl_xor(a.y, o); a.z += __shfl_xor(a.z, o); a.w += __shfl_xor(a.w, o); }
                    if (lane == 0) { const f32x4 bb = *(const f32x4*)(P.in[I_BADA] + col); *(f32x4*)(MOD + (size_t)r * 6144 + col) = a + bb; }
                }
            }
        }
    }
}

DI void norm_mod_row(const float* xrow, const float* gain, const float* sh, const float* sc, bf16_t* orow, int lane) {
    const f32x4* xr = (const f32x4*)xrow + lane;
    f32x4 v[4]; float ss = 0.f;
#pragma unroll
    for (int j = 0; j < 4; ++j) { v[j] = xr[64 * j]; ss += (v[j].x * v[j].x + v[j].y * v[j].y) + (v[j].z * v[j].z + v[j].w * v[j].w); }
    const float rstd = rsqrtf(wave_sum(ss) * (1.0f / DM) + EPSV);
#pragma unroll
    for (int j = 0; j < 4; ++j) {
        const f32x4 g = ((const f32x4*)gain)[64 * j + lane], s = ((const f32x4*)sc)[64 * j + lane], h = ((const f32x4*)sh)[64 * j + lane];
        const f32x4 y = v[j] * rstd * g * (s + 1.0f) + h;
        u32x2 o; o.x = pk2(y.x, y.y); o.y = pk2(y.z, y.w);
        ((u32x2*)orow)[64 * j + lane] = o;
    }
}
DI void phase1(const Params& P) {
    const int lane = threadIdx.x & 63, wave = threadIdx.x >> 6;
    const int gw = blockIdx.x * NWAVES + wave, NGW = gridDim.x * NWAVES;
    const float* MOD = (const float*)(P.ws + WS_MOD);
    bf16_t* HX = (bf16_t*)(P.ws + WS_HX); bf16_t* HC = (bf16_t*)(P.ws + WS_HC);
    for (int r = gw; r < NTOK + NCTX; r += NGW) {
        if (r < NTOK) { const int b = r >> 11; const float* m = MOD + (size_t)b * 6144;
            norm_mod_row(P.in[I_X] + (size_t)r * DM, P.in[I_NPREMIX], m, m + 1024, HX + (size_t)r * DM, lane); }
        else { const int rc = r - NTOK; const float* m = MOD + (size_t)16 * 6144;
            norm_mod_row(P.in[I_CTX] + (size_t)rc * DM, P.in[I_NPREMIX], m, m + 1024, HC + (size_t)rc * DM, lane); }
    }
}

struct FPlain { bf16_t* O; int ldc;
    DI void operator()(int row, int col0, const f32x4& v0, const f32x4& v1) const {
        u32x4 w; w.x = pk2(v0[0], v0[1]); w.y = pk2(v0[2], v0[3]); w.z = pk2(v1[0], v1[1]); w.w = pk2(v1[2], v1[3]);
        *(u32x4*)(O + (size_t)row * ldc + col0) = w; } };
struct FQkvg { bf16_t* O; const float* RC; const float* RS;
    DI void operator()(int row, int col0, const f32x4& a0, const f32x4& a1) const {
        f32x4 v0 = a0, v1 = a1;
        if (col0 < 1024) {
            const int n = row & 2047, j0 = (col0 & 63) >> 1;
            const f32x4 cs = *(const f32x4*)(RC + n * 32 + j0), sn = *(const f32x4*)(RS + n * 32 + j0);
            f32x4 r0, r1;
            r0[0] = v0[0] * cs[0] - v0[1] * sn[0]; r0[1] = v0[1] * cs[0] + v0[0] * sn[0];
            r0[2] = v0[2] * cs[1] - v0[3] * sn[1]; r0[3] = v0[3] * cs[1] + v0[2] * sn[1];
            r1[0] = v1[0] * cs[2] - v1[1] * sn[2]; r1[1] = v1[1] * cs[2] + v1[0] * sn[2];
            r1[2] = v1[2] * cs[3] - v1[3] * sn[3]; r1[3] = v1[3] * cs[3] + v1[2] * sn[3];
            v0 = r0; v1 = r1;
        }
        u32x4 w; w.x = pk2(v0[0], v0[1]); w.y = pk2(v0[2], v0[3]); w.z = pk2(v1[0], v1[1]); w.w = pk2(v1[2], v1[3]);
        *(u32x4*)(O + (size_t)row * 2048 + col0) = w; } };
struct FFnetT { bf16_t* FT;
    DI void operator()(int row, int col0, const f32x4& v0, const f32x4& v1) const {
        const int g = row >> 8, p = (row >> 7) & 1, l = row & 127, b = col0 >> 11, n = col0 & 2047;
        u32x4 w; w.x = pk2(v0[0], v0[1]); w.y = pk2(v0[2], v0[3]); w.z = pk2(v1[0], v1[1]); w.w = pk2(v1[2], v1[3]);
        *(u32x4*)(FT + (size_t)((b * 4 + g) * 128 + l) * 4096 + p * 2048 + n) = w; } };
struct FFnetOut { bf16_t* MIX;
    DI void operator()(int row, int col0, const f32x4& v0, const f32x4& v1) const {
        const int b = col0 >> 9, gc = col0 & 511;
        u32x4 w; w.x = pk2(v0[0], v0[1]); w.y = pk2(v0[2], v0[3]); w.z = pk2(v1[0], v1[1]); w.w = pk2(v1[2], v1[3]);
        *(u32x4*)(MIX + (size_t)(b * 2048 + row) * 1024 + 512 + gc) = w; } };

template <class F> DI void run_gemm(LAS unsigned char* lds, const bf16_t* A, const bf16_t* Bt, int M, int N, int K, const F& f) {
    pg8::Gemm g{A, Bt, M, N, K}; pg8::StaticOrder S; S.init(M, N, (int)gridDim.x, (int)blockIdx.x);
    pg8::EpiBf16F<F> E{f};
    pg8::gemm_phase<pg8::EpiBf16F<F>, pg8::StaticOrder>(lds, g, S, E);
}

constexpr int R_Q = 0, R_K = 18432, R_KFT = 36864, R_KBT = 54272, R_VT = 71680, R_P = 89088, R_SFT = 123904, R_SBT = 133120;
constexpr int LQ = 72, LT = 136, LO = 65;

DI f32x16 mma_tile(const LAS bf16_t* A, int lda, const LAS bf16_t* Bt, int ldb, int K, f32x16 acc, int lane) {
    const int r = lane & 31, hh = lane >> 5;
    const LAS bf16_t* ap = A + r * lda + 8 * hh; const LAS bf16_t* bp = Bt + r * ldb + 8 * hh;
    for (int k0 = 0; k0 < K; k0 += 16) { const bf16x8 a = *(const LAS bf16x8*)(ap + k0); const bf16x8 b = *(const LAS bf16x8*)(bp + k0); acc = MFMA32(a, b, acc); }
    return acc;
}
DI void stage_chunk(LAS unsigned char* lds, const bf16_t* src, int stride, int colQ, int colK, int colV, float lgf, float ef0, float lgb, float eb0) {
    const int tid = threadIdx.x, j = tid >> 2, c0 = (tid & 3) * 16;
    const bf16_t* rowp = src + (size_t)j * stride;
    const u32x4 k0 = *(const u32x4*)(rowp + colK + c0), k1 = *(const u32x4*)(rowp + colK + c0 + 8);
    const u32x4 v0 = *(const u32x4*)(rowp + colV + c0), v1 = *(const u32x4*)(rowp + colV + c0 + 8);
    LAS bf16_t* Ks = (LAS bf16_t*)(lds + R_K); LAS bf16_t* KfT = (LAS bf16_t*)(lds + R_KFT); LAS bf16_t* KbT = (LAS bf16_t*)(lds + R_KBT); LAS bf16_t* VT = (LAS bf16_t*)(lds + R_VT);
    *(LAS u32x4*)(Ks + j * LQ + c0) = k0; *(LAS u32x4*)(Ks + j * LQ + c0 + 8) = k1;
    if (colQ >= 0) { const u32x4 q0 = *(const u32x4*)(rowp + colQ + c0), q1 = *(const u32x4*)(rowp + colQ + c0 + 8);
        LAS bf16_t* Qs = (LAS bf16_t*)(lds + R_Q); *(LAS u32x4*)(Qs + j * LQ + c0) = q0; *(LAS u32x4*)(Qs + j * LQ + c0 + 8) = q1; }
    const float wf = __expf(lgf * (ef0 - (float)j)), wb = __expf(lgb * (eb0 + (float)j));
    const unsigned kw[8] = {k0.x, k0.y, k0.z, k0.w, k1.x, k1.y, k1.z, k1.w};
    const unsigned vw[8] = {v0.x, v0.y, v0.z, v0.w, v1.x, v1.y, v1.z, v1.w};
#pragma unroll
    for (int i = 0; i < 8; ++i) {
        const float ka = bflo(kw[i]), kb = bfhi(kw[i]);
        const int d = c0 + 2 * i;
        KfT[d * LT + j] = f2bf(ka * wf); KfT[(d + 1) * LT + j] = f2bf(kb * wf);
        KbT[d * LT + j] = f2bf(ka * wb); KbT[(d + 1) * LT + j] = f2bf(kb * wb);
        VT[d * LT + j] = (bf16_t)(vw[i] & 0xffffu); VT[(d + 1) * LT + j] = (bf16_t)(vw[i] >> 16);
    }
}
DI void store_state_T(bf16_t* ST, int ld, const f32x16& s, int dkb, int dvb, int lane) {
    const int dv = 32 * dvb + (lane & 31), hh = lane >> 5;
#pragma unroll
    for (int g = 0; g < 4; ++g) { u32x2 o; o.x = pk2(s[4 * g], s[4 * g + 1]); o.y = pk2(s[4 * g + 2], s[4 * g + 3]);
        *(u32x2*)(ST + dv * ld + 32 * dkb + 8 * g + 4 * hh) = o; }
}
DI void store_state_T(LAS bf16_t* ST, int ld, const f32x16& s, int dkb, int dvb, int lane) {
    const int dv = 32 * dvb + (lane & 31), hh = lane >> 5;
#pragma unroll
    for (int g = 0; g < 4; ++g) { u32x2 o; o.x = pk2(s[4 * g], s[4 * g + 1]); o.y = pk2(s[4 * g + 2], s[4 * g + 3]);
        *(LAS u32x2*)(ST + dv * ld + 32 * dkb + 8 * g + 4 * hh) = o; }
}

DI void retention_item(const Params& P, LAS unsigned char* lds, int item) {
    const int tid = threadIdx.x, lane = tid & 63, wave = __builtin_amdgcn_readfirstlane(tid >> 6), hh = lane >> 5;
    const int b = item >> 4, h = (item >> 1) & 7, hf = item & 1;
    const float lgf = log1pf(-expf(P.in[I_DECF][h])), lgb = log1pf(-expf(P.in[I_DECB][h]));
    const bf16_t* QKVG = (const bf16_t*)(P.ws + WS_QKVG) + (size_t)b * SEQ * 2048;
    const bf16_t* CKV = (const bf16_t*)(P.ws + WS_CKV) + (size_t)b * CTXL * 1024;
    bf16_t* SBST = (bf16_t*)(P.ws + WS_SB) + (size_t)item * 8 * 4096;
    bf16_t* MIX = (bf16_t*)(P.ws + WS_MIX) + (size_t)b * SEQ * 1024;
    const int c0 = 8 * hf, clast = c0 + 7; const float P0 = 128.f * c0, Pend = 128.f * (clast + 1);
    LAS bf16_t* Qs = (LAS bf16_t*)(lds + R_Q); LAS bf16_t* Ks = (LAS bf16_t*)(lds + R_K); LAS bf16_t* KfT = (LAS bf16_t*)(lds + R_KFT); LAS bf16_t* KbT = (LAS bf16_t*)(lds + R_KBT);
    LAS bf16_t* VT = (LAS bf16_t*)(lds + R_VT); LAS bf16_t* Ps = (LAS bf16_t*)(lds + R_P); LAS float* Os = (LAS float*)(lds + R_P);
    LAS bf16_t* SfT = (LAS bf16_t*)(lds + R_SFT); LAS bf16_t* SbT = (LAS bf16_t*)(lds + R_SBT);
    const int sdk = (wave >> 1) & 1, sdv = wave & 1;
    const bool isF = wave < 4;
    f32x16 Sacc;
#pragma unroll
    for (int i = 0; i < 16; ++i) Sacc[i] = 0.f;
    f32x16 zero = Sacc;

    for (int x = 0; x < 10; ++x) {
        const bf16_t* src; int stride, colK, colV; float pos0f, pos0b; bool cf, cb;
        if (x < 2) { src = CKV + (size_t)(128 * x) * 1024; stride = 1024; colK = h * 64; colV = 512 + h * 64; pos0f = -256.f + 128.f * x; pos0b = 2048.f + 128.f * x; cf = true; cb = true; }
        else { const int c = (hf ? 0 : 8) + (x - 2); src = QKVG + (size_t)(128 * c) * 2048; stride = 2048; colK = 512 + h * 64; colV = 1024 + h * 64; pos0f = 128.f * c; pos0b = pos0f; cf = (hf == 1); cb = (hf == 0); }
        const float ef0 = cf ? (P0 - 1.f - pos0f) : 0.f, eb0 = cb ? (pos0b - Pend) : 0.f;
        __syncthreads();
        stage_chunk(lds, src, stride, -1, colK, colV, lgf, ef0, lgb, eb0);
        __syncthreads();
        if (isF) { if (cf) Sacc = mma_tile(KfT + 32 * sdk * LT, LT, VT + 32 * sdv * LT, LT, 128, Sacc, lane); }
        else { if (cb) Sacc = mma_tile(KbT + 32 * sdk * LT, LT, VT + 32 * sdv * LT, LT, 128, Sacc, lane); }
    }
    const float gb128 = __expf(lgb * 128.f), gf128 = __expf(lgf * 128.f);
    for (int c = clast; c >= c0; --c) {
        if (!isF) store_state_T(SBST + (size_t)(c - c0) * 4096, 64, Sacc, sdk, sdv, lane);
        if (c > c0) {
            __syncthreads();
            stage_chunk(lds, QKVG + (size_t)(128 * c) * 2048, 2048, -1, 512 + h * 64, 1024 + h * 64, lgf, 127.f, lgb, 0.f);
            __syncthreads();
            if (!isF) { Sacc = Sacc * gb128; Sacc = mma_tile(KbT + 32 * sdk * LT, LT, VT + 32 * sdv * LT, LT, 128, Sacc, lane); }
        }
    }
    for (int c = c0; c <= clast; ++c) {
        __syncthreads();
        stage_chunk(lds, QKVG + (size_t)(128 * c) * 2048, 2048, h * 64, 512 + h * 64, 1024 + h * 64, lgf, 127.f, lgb, 0.f);
        if (isF) store_state_T(SfT, LQ, Sacc, sdk, sdv, lane);
        {
            const int r = tid >> 3, pc = tid & 7; const u32x4 w = *(const u32x4*)(SBST + (size_t)(c - c0) * 4096 + r * 64 + pc * 8);
            *(LAS u32x4*)(SbT + r * LQ + pc * 8) = w; }
        __syncthreads();
        const int ib = wave >> 1, db = wave & 1;
#pragma unroll
        for (int t = 0; t < 2; ++t) {
            const int jb = 2 * db + t;
            f32x16 s = mma_tile(Qs + 32 * ib * LQ, LQ, Ks + 32 * jb * LQ, LQ, 64, zero, lane);
            const int j = 32 * jb + (lane & 31);
#pragma unroll
            for (int r = 0; r < 16; ++r) { const int i = 32 * ib + crow(r, hh); const int dlt = i - j;
                const float dec = dlt >= 0 ? __expf(lgf * (float)dlt) : __expf(lgb * (float)(-dlt));
                Ps[i * LT + j] = f2bf(s[r] * dec); }
        }
        __syncthreads();
        f32x16 o = mma_tile(Ps + 32 * ib * LT, LT, VT + 32 * db * LT, LT, 128, zero, lane);
        f32x16 tf = mma_tile(Qs + 32 * ib * LQ, LQ, SfT + 32 * db * LQ, LQ, 64, zero, lane);
        f32x16 tb = mma_tile(Qs + 32 * ib * LQ, LQ, SbT + 32 * db * LQ, LQ, 64, zero, lane);
#pragma unroll
        for (int r = 0; r < 16; ++r) { const float i = (float)(32 * ib + crow(r, hh)); o[r] += __expf(lgf * (i + 1.f)) * tf[r] + __expf(lgb * (128.f - i)) * tb[r]; }
        __syncthreads();
#pragma unroll
        for (int r = 0; r < 16; ++r) Os[(32 * ib + crow(r, hh)) * LO + 32 * db + (lane & 31)] = o[r];
        if (isF) { Sacc = Sacc * gf128; Sacc = mma_tile(KfT + 32 * sdk * LT, LT, VT + 32 * sdv * LT, LT, 128, Sacc, lane); }
        __syncthreads();
        {
            const int i = tid >> 2, q4 = tid & 3; float ov[16]; float ss = 0.f;
#pragma unroll
            for (int e = 0; e < 16; ++e) { ov[e] = Os[i * LO + 16 * q4 + e]; ss += ov[e] * ov[e]; }
            ss += __shfl_xor(ss, 1); ss += __shfl_xor(ss, 2);
            const float rstd = rsqrtf(ss * (1.0f / 64.0f) + EPSV);
            const bf16_t* gp = QKVG + (size_t)(128 * c + i) * 2048 + 1536 + h * 64 + 16 * q4;
            const u32x4 g0 = *(const u32x4*)gp, g1 = *(const u32x4*)(gp + 8);
            const unsigned gw_[8] = {g0.x, g0.y, g0.z, g0.w, g1.x, g1.y, g1.z, g1.w};
            const float* gn = P.in[I_RETGAIN] + h * 64 + 16 * q4;
            unsigned ow[8];
#pragma unroll
            for (int e = 0; e < 8; ++e) {
                const float ya = ov[2 * e] * rstd * gn[2 * e] * siluf(bflo(gw_[e])), yb = ov[2 * e + 1] * rstd * gn[2 * e + 1] * siluf(bfhi(gw_[e]));
                ow[e] = pk2(ya, yb);
            }
            bf16_t* mp = MIX + (size_t)(128 * c + i) * 1024 + h * 64 + 16 * q4;
            *(u32x4*)mp = (u32x4){ow[0], ow[1], ow[2], ow[3]}; *(u32x4*)(mp + 8) = (u32x4){ow[4], ow[5], ow[6], ow[7]};
        }
    }
    __syncthreads();
}

DI void phase5(const Params& P) {
    const int lane = threadIdx.x & 63, wave = threadIdx.x >> 6;
    const int gw = blockIdx.x * NWAVES + wave, NGW = gridDim.x * NWAVES;
    const float* MOD = (const float*)(P.ws + WS_MOD);
    const float* O = (const float*)(P.ws + WS_QKVG);
    bf16_t* H2 = (bf16_t*)(P.ws + WS_HX);
    for (int r = gw; r < NTOK; r += NGW) {
        const int b = r >> 11; const float* m = MOD + (size_t)b * 6144;
        const f32x4* orow = (const f32x4*)(O + (size_t)r * DM) + lane; const f32x4* xrow = (const f32x4*)(P.in[I_X] + (size_t)r * DM) + lane;
        f32x4 ov[4], xv[4]; float ss = 0.f;
#pragma unroll
        for (int j = 0; j < 4; ++j) { ov[j] = orow[64 * j]; xv[j] = xrow[64 * j]; ss += (ov[j].x * ov[j].x + ov[j].y * ov[j].y) + (ov[j].z * ov[j].z + ov[j].w * ov[j].w); }
        const float rstd = rsqrtf(wave_sum(ss) * (1.0f / DM) + EPSV);
        float ss2 = 0.f;
#pragma unroll
        for (int j = 0; j < 4; ++j) {
            const f32x4 gn = ((const f32x4*)P.in[I_NPOSTMIX])[64 * j + lane], g1 = ((const f32x4*)(m + 2048))[64 * j + lane];
            xv[j] = xv[j] + g1 * (ov[j] * rstd * gn);
            ((f32x4*)(P.out + (size_t)r * DM))[64 * j + lane] = xv[j];
            ss2 += (xv[j].x * xv[j].x + xv[j].y * xv[j].y) + (xv[j].z * xv[j].z + xv[j].w * xv[j].w);
        }
        const float rstd2 = rsqrtf(wave_sum(ss2) * (1.0f / DM) + EPSV);
#pragma unroll
        for (int j = 0; j < 4; ++j) {
            const f32x4 gn = ((const f32x4*)P.in[I_NPREFFN])[64 * j + lane], sh = ((const f32x4*)(m + 3072))[64 * j + lane], sc = ((const f32x4*)(m + 4096))[64 * j + lane];
            const f32x4 y = xv[j] * rstd2 * gn * (sc + 1.0f) + sh;
            u32x2 o; o.x = pk2(y.x, y.y); o.y = pk2(y.z, y.w);
            ((u32x2*)(H2 + (size_t)r * DM))[64 * j + lane] = o;
        }
    }
}

#define INS16(L, xx) do { float _x = (xx); _Pragma("unroll") for (int _i = 0; _i < 16; ++_i) { const float _t = fmaxf(L[_i], _x); _x = fminf(L[_i], _x); L[_i] = _t; } } while (0)
constexpr int KLD = 136;
DI void topk_half(const LAS bf16_t* keys  , const bf16_t* qrow  , float (&L)[16], int lane) {
    const int r = lane & 31, hh = lane >> 5;
    f32x16 acc[4];
#pragma unroll
    for (int t = 0; t < 4; ++t)
#pragma unroll
        for (int i = 0; i < 16; ++i) acc[t][i] = 0.f;
#pragma unroll 2
    for (int k0 = 0; k0 < 128; k0 += 16) {
        const bf16x8 bq = *(const bf16x8*)(qrow + k0 + 8 * hh);
#pragma unroll
        for (int t = 0; t < 4; ++t) { const bf16x8 a = *(const LAS bf16x8*)(keys + (32 * t + r) * KLD + k0 + 8 * hh); acc[t] = MFMA32(a, bq, acc[t]); }
    }
#pragma unroll
    for (int i = 0; i < 16; ++i) L[i] = -3.0e38f;
#pragma unroll
    for (int t = 0; t < 4; ++t)
#pragma unroll
        for (int i = 0; i < 16; ++i) {
            const unsigned idx = 32u * t + (unsigned)((i & 3) + 8 * (i >> 2));
            const float pv = __uint_as_float((__float_as_uint(acc[t][i]) & 0xFFFFFF80u) | idx);
            INS16(L, pv);
        }
#pragma unroll
    for (int i = 0; i < 16; ++i) L[i] = __uint_as_float(__float_as_uint(L[i]) | ((unsigned)hh << 2));
    float Pn[16];
#pragma unroll
    for (int i = 0; i < 16; ++i) Pn[i] = __shfl_xor(L[i], 32);
#pragma unroll
    for (int i = 0; i < 16; ++i) INS16(L, Pn[i]);
}
DI unsigned pack4idx(float a, float b, float c, float d) { return (__float_as_uint(a) & 127u) | ((__float_as_uint(b) & 127u) << 8) | ((__float_as_uint(c) & 127u) << 16) | ((__float_as_uint(d) & 127u) << 24); }
DI unsigned pick_idx(unsigned w0, unsigned w1, unsigned w2, unsigned w3, unsigned a) {
    const unsigned lo = (a & 4u) ? w1 : w0, hi = (a & 4u) ? w3 : w2, w = (a & 8u) ? hi : lo;
    return (w >> (8u * (a & 3u))) & 127u;
}
DI void phase7(const Params& P, LAS unsigned char* lds) {
    const int tid = threadIdx.x, lane = tid & 63, wave = tid >> 6;
    const int gw = blockIdx.x * NWAVES + wave, NGW = gridDim.x * NWAVES;
    LAS bf16_t* keys = (LAS bf16_t*)lds;
    const bf16_t* KEYS = (const bf16_t*)(P.ws + WS_KEYS);
    for (int i = tid; i < 256 * 16; i += NTHREADS) { const int r = i >> 4, pc = i & 15; *(LAS u32x4*)(keys + r * KLD + pc * 8) = *(const u32x4*)(KEYS + r * 128 + pc * 8); }
    __syncthreads();
    const bf16_t* PQ = (const bf16_t*)(P.ws + WS_FT);
    int* IDS = (int*)(P.ws + WS_IDS); float* WTS = (float*)(P.ws + WS_WTS);
    for (int task = gw; task < 1024 * 8; task += NGW) {
        const int tg = task >> 3, h = task & 7, tok = tg * 32 + (lane & 31), hh = lane >> 5;
        const bf16_t* qrow = PQ + (size_t)tok * 2048 + h * 256;
        float L1[16], L2[16];
        topk_half(keys, qrow, L1, lane);
        topk_half(keys + 128 * KLD, qrow + 128, L2, lane);
        const unsigned w10 = pack4idx(L1[0], L1[1], L1[2], L1[3]), w11 = pack4idx(L1[4], L1[5], L1[6], L1[7]), w12 = pack4idx(L1[8], L1[9], L1[10], L1[11]), w13 = pack4idx(L1[12], L1[13], L1[14], L1[15]);
        const unsigned w20 = pack4idx(L2[0], L2[1], L2[2], L2[3]), w21 = pack4idx(L2[4], L2[5], L2[6], L2[7]), w22 = pack4idx(L2[8], L2[9], L2[10], L2[11]), w23 = pack4idx(L2[12], L2[13], L2[14], L2[15]);
        float C[16];
#pragma unroll
        for (int i = 0; i < 16; ++i) C[i] = -3.0e38f;
#pragma unroll
        for (int a = 0; a < 16; ++a)
#pragma unroll
            for (int bq = 0; bq < 16; ++bq)
                if ((a + 1) * (bq + 1) <= 16) { const float s = L1[a] + L2[bq]; const float pv = __uint_as_float((__float_as_uint(s) & 0xFFFFFF00u) | (unsigned)(a * 16 + bq)); INS16(C, pv); }
        float e[16], sum = 0.f;
#pragma unroll
        for (int i = 0; i < 16; ++i) { e[i] = __expf(C[i] - C[0]); sum += e[i]; }
        const float inv = 1.0f / sum;
        if (hh == 0) {
            int idv[16];
#pragma unroll
            for (int i = 0; i < 16; ++i) { const unsigned code = __float_as_uint(C[i]) & 255u; idv[i] = (int)(pick_idx(w10, w11, w12, w13, code >> 4) * 128u + pick_idx(w20, w21, w22, w23, code & 15u)); }
            int* op = IDS + (size_t)tok * 128 + h * 16;
#pragma unroll
            for (int i = 0; i < 4; ++i) *(int4*)(op + 4 * i) = make_int4(idv[4 * i], idv[4 * i + 1], idv[4 * i + 2], idv[4 * i + 3]);
        } else {
            float* op = WTS + (size_t)tok * 128 + h * 16;
#pragma unroll
            for (int i = 0; i < 4; ++i) *(f32x4*)(op + 4 * i) = (f32x4){e[4 * i] * inv, e[4 * i + 1] * inv, e[4 * i + 2] * inv, e[4 * i + 3] * inv};
        }
    }
}

DI void phase8(const Params& P) {
    const int lane = threadIdx.x & 63, wave = threadIdx.x >> 6;
    const int gw = blockIdx.x * NWAVES + wave, NGW = gridDim.x * NWAVES;
    const float* MOD = (const float*)(P.ws + WS_MOD);
    const bf16_t* H2 = (const bf16_t*)(P.ws + WS_HX);
    const int* IDS = (const int*)(P.ws + WS_IDS); const float* WTS = (const float*)(P.ws + WS_WTS);
    const float* U = P.in[I_U]; const float* V = P.in[I_V];
    for (int t = gw; t < NTOK; t += NGW) {
        const int b = t >> 11; const float* m = MOD + (size_t)b * 6144;
        f32x4 hv[4], acc[4];
#pragma unroll
        for (int j = 0; j < 4; ++j) { const u32x2 w = ((const u32x2*)(H2 + (size_t)t * DM))[64 * j + lane]; hv[j] = (f32x4){bflo(w.x), bfhi(w.x), bflo(w.y), bfhi(w.y)}; acc[j] = (f32x4){0.f, 0.f, 0.f, 0.f}; }
        const int id0 = IDS[(size_t)t * 128 + lane], id1 = IDS[(size_t)t * 128 + 64 + lane];
        const float w0 = WTS[(size_t)t * 128 + lane], w1 = WTS[(size_t)t * 128 + 64 + lane];
        for (int k = 0; k < 128; k += 2) {
            const int ea = __builtin_amdgcn_readlane(k < 64 ? id0 : id1, k & 63), eb = __builtin_amdgcn_readlane(k < 64 ? id0 : id1, (k + 1) & 63);
            const float wka = __int_as_float(__builtin_amdgcn_readlane(__float_as_int(k < 64 ? w0 : w1), k & 63));
            const float wkb = __int_as_float(__builtin_amdgcn_readlane(__float_as_int(k < 64 ? w0 : w1), (k + 1) & 63));
            const f32x4* ua = (const f32x4*)(U + (size_t)ea * DM) + lane; const f32x4* ub = (const f32x4*)(U + (size_t)eb * DM) + lane;
            const f32x4* va = (const f32x4*)(V + (size_t)ea * DM) + lane; const f32x4* vb = (const f32x4*)(V + (size_t)eb * DM) + lane;
            f32x4 qa[4], qb[4], ra[4], rb[4];
#pragma unroll
            for (int j = 0; j < 4; ++j) { qa[j] = ua[64 * j]; qb[j] = ub[64 * j]; }
#pragma unroll
            for (int j = 0; j < 4; ++j) { ra[j] = va[64 * j]; rb[j] = vb[64 * j]; }
            float da = 0.f, db = 0.f;
#pragma unroll
            for (int j = 0; j < 4; ++j) { const f32x4 pa = qa[j] * hv[j], pb = qb[j] * hv[j]; da += (pa.x + pa.y) + (pa.z + pa.w); db += (pb.x + pb.y) + (pb.z + pb.w); }
            da = wave_sum(da); db = wave_sum(db);
            const float ca = wka * gelu_erf(da), cb = wkb * gelu_erf(db);
#pragma unroll
            for (int j = 0; j < 4; ++j) acc[j] += ra[j] * ca + rb[j] * cb;
        }
        float ss = 0.f;
#pragma unroll
        for (int j = 0; j < 4; ++j) ss += (acc[j].x * acc[j].x + acc[j].y * acc[j].y) + (acc[j].z * acc[j].z + acc[j].w * acc[j].w);
        const float rstd = rsqrtf(wave_sum(ss) * (1.0f / DM) + EPSV);
#pragma unroll
        for (int j = 0; j < 4; ++j) {
            const f32x4 gn = ((const f32x4*)P.in[I_NPOSTFFN])[64 * j + lane], g2 = ((const f32x4*)(m + 5120))[64 * j + lane];
            f32x4* op = (f32x4*)(P.out + (size_t)t * DM) + 64 * j + lane;
            *op = *op + g2 * (acc[j] * rstd * gn);
        }
    }
}

__global__ void __launch_bounds__(NTHREADS, 2) fwd_megakernel(Params P) {
    extern __shared__ __attribute__((aligned(16))) unsigned char lds_raw[];
    LAS unsigned char* lds = (LAS unsigned char*)lds_raw;
    cg::grid_group grid = cg::this_grid();
    unsigned char* ws = P.ws;
    const int lo = P.ph_lo, hi = P.ph_hi;
#define IN(k) (lo <= (k) && (k) < hi)
#define SEAM(k) do { if (IN(k) && IN((k) + 1)) grid.sync(); } while (0)
    if (IN(0)) phase0(P, lds);
    SEAM(0);
    if (IN(1)) phase1(P);
    SEAM(1);
    if (IN(2)) {
        run_gemm(lds, (const bf16_t*)(ws + WS_HC), (const bf16_t*)(ws + WS_WIN) + (size_t)512 * 1024, NCTX, 1024, 1024, FPlain{(bf16_t*)(ws + WS_CKV), 1024});
        run_gemm(lds, (const bf16_t*)(ws + WS_HX), (const bf16_t*)(ws + WS_WIN), NTOK, 2048, 1024, FQkvg{(bf16_t*)(ws + WS_QKVG), (const float*)(ws + WS_ROPE), (const float*)(ws + WS_ROPE) + 2048 * 32});
        run_gemm(lds, (const bf16_t*)(ws + WS_WF), (const bf16_t*)(ws + WS_HX), 1024, NTOK, 1024, FFnetT{(bf16_t*)(ws + WS_FT)});
    }
    SEAM(2);
    if (IN(3)) {
        run_gemm(lds, (const bf16_t*)(ws + WS_DFT), (const bf16_t*)(ws + WS_FT), 2048, 8192, 4096, FFnetOut{(bf16_t*)(ws + WS_MIX)});
        for (int item = blockIdx.x; item < 256; item += gridDim.x) retention_item(P, lds, item);
    }
    SEAM(3);
    if (IN(4)) {
        pg8::Gemm g{(const bf16_t*)(ws + WS_MIX), (const bf16_t*)(ws + WS_WOUT), NTOK, 1024, 1024}; pg8::StaticOrder S; S.init(NTOK, 1024, (int)gridDim.x, (int)blockIdx.x);
        pg8::EpiF32 E{(float*)(ws + WS_QKVG), 1024};
        pg8::gemm_phase<pg8::EpiF32, pg8::StaticOrder>(lds, g, S, E);
    }
    SEAM(4);
    if (IN(5)) phase5(P);
    SEAM(5);
    if (IN(6)) run_gemm(lds, (const bf16_t*)(ws + WS_HX), (const bf16_t*)(ws + WS_WQ), NTOK, 2048, 1024, FPlain{(bf16_t*)(ws + WS_FT), 2048});
    SEAM(6);
    if (IN(7)) phase7(P, lds);
    SEAM(7);
    if (IN(8)) phase8(P);
#undef IN
#undef SEAM
}

extern "C" void kernel_launch(void* const* d_in, const int* in_sizes, int n_in, void* d_out, int out_size, void* d_ws, size_t ws_size, hipStream_t stream) {
    static int grid = 0;
    if (grid == 0) {
        int dev = 0, cus = 0, per_cu = 0;
        hipGetDevice(&dev);
        hipDeviceGetAttribute(&cus, hipDeviceAttributeMultiprocessorCount, dev);
        hipFuncSetAttribute((const void*)fwd_megakernel, hipFuncAttributeMaxDynamicSharedMemorySize, LDS_BYTES);
        hipOccupancyMaxActiveBlocksPerMultiprocessor(&per_cu, (const void*)fwd_megakernel, NTHREADS, LDS_BYTES);
        if (per_cu < 1) { fprintf(stderr, "kernel_launch: occupancy query says %d blocks/CU\n", per_cu); per_cu = 1; }
        grid = cus;
        if (ws_size < WS_END || n_in != 20) fprintf(stderr, "kernel_launch: unexpected ws_size %zu / n_in %d\n", ws_size, n_in);
        (void)hipGetLastError();
    }
    Params p{};
    for (int i = 0; i < 20; ++i) p.in[i] = (const float*)d_in[i];
    p.out = (float*)d_out; p.ws = (unsigned char*)d_ws; p.ph_lo = 0; p.ph_hi = 9;
    void* args[] = {&p};
    hipError_t e = hipLaunchCooperativeKernel((const void*)fwd_megakernel, dim3(grid), dim3(NTHREADS), args, LDS_BYTES, stream);
    if (e != hipSuccess) fprintf(stderr, "cooperative launch failed: %s (grid %d)\n", hipGetErrorString(e), grid);
}
```

```cpp
#include <hip/hip_runtime.h>
#include <hip/hip_cooperative_groups.h>
#include <cstdio>
namespace cg = cooperative_groups;
#define VARIANT 0
#define SPLITK 0
#define TIMESEC 0
#define TSK 20
#define TS_BEGIN(id) do { if (TIMESEC == (id) && SPLITK > 0 && blockIdx.x == 0 && threadIdx.x == 0) ((volatile unsigned long long*)(P.ws + 32768))[0] = __builtin_amdgcn_s_memrealtime(); } while (0)
#define TS_END(id) do { if (TIMESEC == (id) && SPLITK > 0 && blockIdx.x == 0 && threadIdx.x == 0) { volatile unsigned long long* _p = (volatile unsigned long long*)(P.ws + 32768); _p[1] = _p[1] + (__builtin_amdgcn_s_memrealtime() - _p[0]); } } while (0)
#define DUPK -1

#define DI __device__ __forceinline__
#define LAS __attribute__((address_space(3)))
typedef unsigned short bf16_t;
typedef short bf16x8 __attribute__((ext_vector_type(8)));
typedef float f32x4 __attribute__((ext_vector_type(4)));
typedef float f32x16 __attribute__((ext_vector_type(16)));
typedef unsigned u32x4 __attribute__((ext_vector_type(4)));
typedef unsigned u32x2 __attribute__((ext_vector_type(2)));

constexpr int NB = 16, SEQ = 2048, DM = 1024, NTOK = NB * SEQ, CTXL = 256, NCTX = NB * CTXL;
constexpr int INW = 2560, F_OFF = 2048;
constexpr float EPSV = 1e-6f;
constexpr int NTHREADS = 512, NWAVES = 8;
constexpr int LDS_BYTES = 160 * 1024;

constexpr size_t MB = 1024 * 1024;
constexpr size_t WS_MOD = 64 * 1024;
constexpr size_t WS_ROPE = 512 * 1024;
constexpr size_t WS_KEYS = 1 * MB;
constexpr size_t WS_WIN = 2 * MB;
constexpr size_t WS_WF = 6 * MB;
constexpr size_t WS_WOUT = 8 * MB;
constexpr size_t WS_WQ = 10 * MB;
constexpr size_t WS_DFT = 14 * MB;
constexpr size_t WS_HC = 30 * MB;
constexpr size_t WS_CKV = 38 * MB;
constexpr size_t WS_IDS = 46 * MB;
constexpr size_t WS_WTS = 62 * MB;
constexpr size_t WS_HX = 80 * MB;
constexpr size_t WS_QKVG = 144 * MB;
constexpr size_t WS_FT = 272 * MB;
constexpr size_t WS_MIX = 336 * MB;
constexpr size_t WS_SB = 400 * MB;
constexpr size_t WS_H2S = 416 * MB;
constexpr size_t WS_END = 480 * MB;
constexpr size_t WS_SID = 30 * MB;
constexpr size_t WS_SIDB = 46 * MB;
constexpr size_t WS_SWT = 400 * MB;
constexpr size_t WS_CIT = 14 * MB;
constexpr size_t WS_PART = 144 * MB;
constexpr size_t WS_POUT = 272 * MB;

namespace pg8 {
#define PG8_LAS __attribute__((address_space(3)))
constexpr int BM = 256, BK = 64, HALF = 128, HTB = HALF * BK * 2, STAGE_BYTES = 8 * HTB, NXCD = 8, WGM = 8;
__host__ __device__ __forceinline__ int lds_byte(int r, int c) { const int st = (r >> 4) * 2 + (c >> 5), rr = r & 15, cc = c & 31, ob = rr * 64 + cc * 2; return st * 1024 + (ob ^ (((ob >> 9) & 1) << 5)); }
__host__ __device__ __forceinline__ void stage_rc(int b, int& R, int& C) { const int st = b / 1024, sb = b % 1024, swz = sb ^ (((sb >> 9) & 1) << 5); R = (st >> 1) * 16 + swz / 64; C = (st & 1) * 32 + (swz % 64) / 2; }
__host__ __device__ __forceinline__ int perm32(int rho) { const int n = rho >> 4, i = rho & 15; return 8 * (i >> 2) + 4 * n + (i & 3); }
struct Unit { int pm, pn; };
struct Gemm { const bf16_t* A; const bf16_t* Bt; int M, N, K; };
struct StaticOrder {
    int nM, nN, nwg, G, c;
    __host__ __device__ void init(int M, int N, int G_, int c_) { nM = M / BM; nN = N / BM; nwg = nM * nN; G = G_; c = c_; }
    __host__ __device__ bool next(int i, Unit& u) const {
        const long L = (long)i * G + c; if (L >= nwg) return false;
        int wgid = (int)L; { const int q = nwg / NXCD, r = nwg % NXCD, xcd = wgid % NXCD, off = wgid / NXCD; wgid = (xcd < r ? xcd * (q + 1) : r * (q + 1) + (xcd - r) * q) + off; }
        const int nig = WGM * nN, gid = wgid / nig, fm = gid * WGM, gsz = (nM - fm) < WGM ? (nM - fm) : WGM;
        u.pm = fm + ((wgid % nig) % gsz); u.pn = (wgid % nig) / gsz; return true;
    }
    __device__ __forceinline__ void a_ready(const Unit&) const {}
    __device__ __forceinline__ void done(const Unit&) const {}
};
__device__ __forceinline__ unsigned cvt_pk_bf16(float lo, float hi) { unsigned r; asm volatile("v_cvt_pk_bf16_f32 %0, %1, %2" : "=v"(r) : "v"(lo), "v"(hi)); return r; }

struct EpiF32 {
    static constexpr bool PERM = false;
    float* C; int ldc;
    __device__ __forceinline__ void operator()(const f32x4 (&acc)[2][2][4][2], const Unit& u, int wr, int wc, int fr, int fq) const {
        const int row0 = u.pm * BM + wr * 64 + fr, col0 = u.pn * BM + wc * 32 + 4 * fq;
#pragma unroll
        for (int ai = 0; ai < 2; ++ai)
#pragma unroll
            for (int m = 0; m < 4; ++m) { float* rowp = C + (size_t)(row0 + ai * HALF + m * 16) * ldc + col0;
#pragma unroll
                for (int bj = 0; bj < 2; ++bj)
#pragma unroll
                    for (int n = 0; n < 2; ++n) *(f32x4*)(rowp + bj * HALF + n * 16) = acc[ai][bj][m][n]; }
    }
};
template <class F> struct EpiBf16F {
    static constexpr bool PERM = true;
    F f;
    __device__ __forceinline__ void operator()(const f32x4 (&acc)[2][2][4][2], const Unit& u, int wr, int wc, int fr, int fq) const {
        const int row0 = u.pm * BM + wr * 64 + fr, col0 = u.pn * BM + wc * 32 + 8 * fq;
#pragma unroll
        for (int ai = 0; ai < 2; ++ai)
#pragma unroll
            for (int m = 0; m < 4; ++m)
#pragma unroll
                for (int bj = 0; bj < 2; ++bj) f(row0 + ai * HALF + m * 16, col0 + bj * HALF, acc[ai][bj][m][0], acc[ai][bj][m][1]);
    }
};

template <class Epi, class Sched>
__device__ __forceinline__ void gemm_phase(PG8_LAS unsigned char* lds, const Gemm g, const Sched& S, const Epi& E) {
    const int tid = threadIdx.x, wid = __builtin_amdgcn_readfirstlane(tid >> 6), lane = tid & 63, wr = wid >> 2, wc = wid & 3, fr = lane & 15, fq = lane >> 4;
    const int K = g.K, nt = K / BK;
    unsigned voffA[2], voffB[2];
#pragma unroll
    for (int i = 0; i < 2; ++i) { int R, C; stage_rc(tid * 16 + i * 8192, R, C); const int Rb = Epi::PERM ? ((R & ~31) + perm32(R & 31)) : R;
        voffA[i] = (unsigned)(R * K + C) * 2u; voffB[i] = (unsigned)(Rb * K + C) * 2u; }
    const size_t kstep = (size_t)(BK * 2);
    const size_t hstep = (size_t)HALF * K * 2;
    const size_t tstep = 2 * hstep;
    const unsigned ldsw = (unsigned)wid * 1024u;
    const int aoff = lds_byte(wr * 64 + fr, fq * 8), boff = lds_byte(wc * 32 + fr, fq * 8);
#define PG8_SA(b, h) (((b) * 2 + (h)) * HTB)
#define PG8_SB(b, h) ((4 + (b) * 2 + (h)) * HTB)
#define PG8_STAGE(bufoff, gbase, voff) do { _Pragma("unroll") for (int _i = 0; _i < 2; ++_i) \
        __builtin_amdgcn_global_load_lds((const unsigned*)((const char*)(gbase) + (voff)[_i]), (PG8_LAS unsigned*)(lds + (bufoff) + ldsw + _i * 8192), 16, 0, 0); } while (0)
#define PG8_LDA(dst, b, h) do { _Pragma("unroll") for (int m = 0; m < 4; ++m) _Pragma("unroll") for (int k = 0; k < 2; ++k) dst[m][k] = *(const PG8_LAS bf16x8*)(lds + PG8_SA(b, h) + aoff + m * 2048 + k * 1024); } while (0)
#define PG8_LDB(dst, b, h) do { _Pragma("unroll") for (int n = 0; n < 2; ++n) _Pragma("unroll") for (int k = 0; k < 2; ++k) dst[n][k] = *(const PG8_LAS bf16x8*)(lds + PG8_SB(b, h) + boff + n * 2048 + k * 1024); } while (0)
#define PG8_MMA(ai, bj, At, Bt) do { __builtin_amdgcn_s_setprio(1); _Pragma("unroll") for (int m = 0; m < 4; ++m) _Pragma("unroll") for (int n = 0; n < 2; ++n) _Pragma("unroll") for (int k = 0; k < 2; ++k) \
        acc[ai][bj][m][n] = __builtin_amdgcn_mfma_f32_16x16x32_bf16(Bt[n][k], At[m][k], acc[ai][bj][m][n], 0, 0, 0); __builtin_amdgcn_s_setprio(0); } while (0)
#define PG8_WAIT_V(n) asm volatile("s_waitcnt vmcnt(" #n ")" ::: "memory")
#define PG8_WAIT_L(n) asm volatile("s_waitcnt lgkmcnt(" #n ")" ::: "memory")
#define PG8_BAR __builtin_amdgcn_s_barrier()
#define PG8_SCHED __builtin_amdgcn_sched_barrier(0)
    Unit cur, nxt; int ui = 0;
    if (!S.next(0, cur)) return;
    f32x4 acc[2][2][4][2];
#pragma unroll
    for (int a = 0; a < 2; ++a)
#pragma unroll
        for (int b = 0; b < 2; ++b)
#pragma unroll
            for (int m = 0; m < 4; ++m)
#pragma unroll
                for (int n = 0; n < 2; ++n) acc[a][b][m][n] = (f32x4){0.f, 0.f, 0.f, 0.f};
    bf16x8 At[4][2], B0[2][2], B1[2][2];
    const char* cA = (const char*)g.A + (size_t)cur.pm * tstep; const char* cB = (const char*)g.Bt + (size_t)cur.pn * tstep;
    S.a_ready(cur);
    PG8_STAGE(PG8_SB(0, 0), cB, voffB); PG8_STAGE(PG8_SA(0, 0), cA, voffA); PG8_STAGE(PG8_SB(0, 1), cB + hstep, voffB); PG8_STAGE(PG8_SA(0, 1), cA + hstep, voffA);
    if (wr == 1) PG8_BAR;
    PG8_WAIT_V(4); PG8_BAR;
    PG8_STAGE(PG8_SB(1, 0), cB + kstep, voffB); PG8_STAGE(PG8_SA(1, 0), cA + kstep, voffA); PG8_STAGE(PG8_SB(1, 1), cB + hstep + kstep, voffB);
    PG8_WAIT_V(6); PG8_BAR;
    for (;;) {
        const bool has_next = S.next(ui + 1, nxt);
        const char* nA = has_next ? (const char*)g.A + (size_t)nxt.pm * tstep : cA; const char* nB = has_next ? (const char*)g.Bt + (size_t)nxt.pn * tstep : cB;
        for (int t = 0; t < nt; t += 2) {
            const bool last = (t == nt - 2);
            const char* a1 = cA + (size_t)(t + 1) * kstep;
            const char* a2 = last ? nA : cA + (size_t)(t + 2) * kstep; const char* b2 = last ? nB : cB + (size_t)(t + 2) * kstep;
            const char* a3 = a2 + kstep; const char* b3 = b2 + kstep;
            if (last && has_next) S.a_ready(nxt);
            PG8_LDB(B0, 0, 0); PG8_SCHED; PG8_LDA(At, 0, 0); PG8_STAGE(PG8_SA(1, 1), a1 + hstep, voffA);
            PG8_WAIT_L(8); PG8_BAR; PG8_WAIT_L(0); PG8_MMA(0, 0, At, B0); PG8_BAR; PG8_SCHED;
            PG8_LDB(B1, 0, 1); PG8_STAGE(PG8_SB(0, 0), b2, voffB);
            PG8_BAR; PG8_WAIT_L(0); PG8_MMA(0, 1, At, B1); PG8_BAR;
            PG8_LDA(At, 0, 1); PG8_STAGE(PG8_SA(0, 0), a2, voffA);
            PG8_BAR; PG8_WAIT_L(0); PG8_MMA(1, 0, At, B0); PG8_BAR; PG8_SCHED;
            PG8_STAGE(PG8_SB(0, 1), b2 + hstep, voffB);
            PG8_WAIT_V(6); PG8_BAR; PG8_MMA(1, 1, At, B1); PG8_BAR;
            PG8_LDB(B0, 1, 0); PG8_SCHED; PG8_LDA(At, 1, 0); PG8_STAGE(PG8_SA(0, 1), a2 + hstep, voffA);
            PG8_WAIT_L(8); PG8_BAR; PG8_WAIT_L(0); PG8_MMA(0, 0, At, B0); PG8_BAR; PG8_SCHED;
            PG8_LDB(B1, 1, 1); PG8_STAGE(PG8_SB(1, 0), b3, voffB);
            PG8_BAR; PG8_WAIT_L(0); PG8_MMA(0, 1, At, B1); PG8_BAR;
            PG8_LDA(At, 1, 1); PG8_STAGE(PG8_SA(1, 0), a3, voffA);
            PG8_BAR; PG8_WAIT_L(0); PG8_MMA(1, 0, At, B0); PG8_BAR; PG8_SCHED;
            PG8_STAGE(PG8_SB(1, 1), b3 + hstep, voffB);
            PG8_WAIT_V(6); PG8_BAR; PG8_MMA(1, 1, At, B1); PG8_BAR;
        }
        E(acc, cur, wr, wc, fr, fq); S.done(cur);
        if (!has_next) break;
#pragma unroll
        for (int a = 0; a < 2; ++a)
#pragma unroll
            for (int b = 0; b < 2; ++b)
#pragma unroll
                for (int m = 0; m < 4; ++m)
#pragma unroll
                    for (int n = 0; n < 2; ++n) acc[a][b][m][n] = (f32x4){0.f, 0.f, 0.f, 0.f};
        cur = nxt; cA = nA; cB = nB; ++ui;
    }
    PG8_WAIT_V(0);
    if (wr == 0) PG8_BAR;
    PG8_BAR;
#undef PG8_SA
#undef PG8_SB
#undef PG8_STAGE
#undef PG8_LDA
#undef PG8_LDB
#undef PG8_MMA
#undef PG8_WAIT_V
#undef PG8_WAIT_L
#undef PG8_BAR
#undef PG8_SCHED
}
}

DI unsigned pk2(float lo, float hi) { return pg8::cvt_pk_bf16(lo, hi); }
DI bf16_t f2bf(float f) { return (bf16_t)(pk2(f, 0.f) & 0xffffu); }
DI float bf2f(bf16_t b) { return __uint_as_float(((unsigned)b) << 16); }
DI float bflo(unsigned w) { return __uint_as_float(w << 16); }
DI float bfhi(unsigned w) { return __uint_as_float(w & 0xffff0000u); }
DI float wave_sum(float v) {
#pragma unroll
    for (int o = 1; o < 64; o <<= 1) v += __shfl_xor(v, o);
    return v;
}
DI float siluf(float x) { return x / (1.f + __expf(-x)); }
DI float gelu_erf(float a) { return 0.5f * a * (1.f + erff(a * 0.70710678118654752f)); }
#define LDS_WAIT() asm volatile("s_waitcnt lgkmcnt(0)" ::: "memory")
#define MFMA32(a, b, c) __builtin_amdgcn_mfma_f32_32x32x16_bf16((a), (b), (c), 0, 0, 0)
DI int crow(int reg, int h) { return (reg & 3) + 8 * (reg >> 2) + 4 * h; }
DI f32x16 zero16() { f32x16 z;
#pragma unroll
    for (int i = 0; i < 16; ++i) z[i] = 0.f;
    return z; }


#define XB_TMO      128
#define XB_XCNT(j)  (256  + 64 * (j))
#define XB_XSUB(j)  (1280 + 64 * (j))
#define XB_XGEN(j)  (2304 + 64 * (j))
#define XB_TOP      3328
#define XB_TOPGEN   3392
#define XCD_BAR_WORDS 3456
#define XB_SPIN_CAP (1u << 22)
DI unsigned xb_ld(unsigned* p)              { return __hip_atomic_load(p, __ATOMIC_RELAXED, __HIP_MEMORY_SCOPE_AGENT); }
DI unsigned xb_add(unsigned* p, unsigned v) { return __hip_atomic_fetch_add(p, v, __ATOMIC_RELAXED, __HIP_MEMORY_SCOPE_AGENT); }
DI unsigned xb_xcc_id() { return (unsigned)__builtin_amdgcn_s_getreg((3 << 11) | 20) & 0xFu; }
#define XB_SPIN(cond, bar) do { unsigned _sp = 0; while (cond) { __builtin_amdgcn_s_sleep(1); \
    if ((++_sp & 255u) == 0u) { if (xb_ld(&(bar)[XB_TMO])) break; if (_sp > XB_SPIN_CAP) { atomicAdd(&(bar)[XB_TMO], 1u); break; } } } } while (0)
struct XcdBarrier { unsigned* bar; unsigned x; volatile LAS unsigned* st; };
DI XcdBarrier xcd_barrier_post(unsigned* bar, volatile LAS unsigned* st) {
    XcdBarrier b; b.bar = bar; b.x = xb_xcc_id(); b.st = st;
    if (threadIdx.x == 0) (void)xb_add(&bar[XB_XCNT(b.x)], 1u);
    return b;
}
DI void xcd_barrier_complete(unsigned* bar, unsigned x, unsigned& nloc, unsigned& nx) {
    const unsigned G = gridDim.x * gridDim.y * gridDim.z;
    unsigned sum, cnt, mine, sp = 0u;
    for (;;) {
        sum = 0u; cnt = 0u; mine = 0u;
#pragma unroll
        for (unsigned j = 0; j < 16; ++j) { const unsigned c = xb_ld(&bar[XB_XCNT(j)]); sum += c; cnt += (c > 0u) ? 1u : 0u; mine = (j == x) ? c : mine; }
        if (sum == G) break;
        __builtin_amdgcn_s_sleep(1);
        if ((++sp & 255u) == 0u) { if (xb_ld(&bar[XB_TMO])) break; if (sp > XB_SPIN_CAP) { atomicAdd(&bar[XB_TMO], 1u); break; } }
    }
    nloc = mine > 0u ? mine : 1u; nx = cnt > 0u ? cnt : 1u;
}
DI void xcd_barrier(const XcdBarrier& b) {
    asm volatile("s_waitcnt vmcnt(0)" ::: "memory");
    __syncthreads();
    if (threadIdx.x == 0) {
        unsigned* bar = b.bar;
        __builtin_amdgcn_s_waitcnt(0);
        unsigned nloc = b.st[0], nx = b.st[1];
        if (nloc == 0u) { xcd_barrier_complete(bar, b.x, nloc, nx); b.st[0] = nloc; b.st[1] = nx; }
        const unsigned old = xb_add(&bar[XB_XSUB(b.x)], 1u);
        const unsigned gen = old / nloc;
        if (old + 1u == (gen + 1u) * nloc) {
            __builtin_amdgcn_fence(__ATOMIC_RELEASE, "agent");
            asm volatile("s_waitcnt vmcnt(0)" ::: "memory");
            const unsigned og = xb_add(&bar[XB_TOP], 1u);
            const unsigned tg = og / nx;
            if (og + 1u == (tg + 1u) * nx) xb_add(&bar[XB_TOPGEN], 1u);
            else XB_SPIN(xb_ld(&bar[XB_TOPGEN]) == tg, bar);
            __builtin_amdgcn_fence(__ATOMIC_ACQUIRE, "agent");
            xb_add(&bar[XB_XGEN(b.x)], 1u);
            asm volatile("s_waitcnt vmcnt(0)" ::: "memory");
        } else {
            XB_SPIN(xb_ld(&bar[XB_XGEN(b.x)]) == gen, bar);
            __builtin_amdgcn_fence(__ATOMIC_ACQUIRE, "agent");
            asm volatile("s_waitcnt vmcnt(0)" ::: "memory");
        }
    }
    __syncthreads();
}

struct Params { const float* in[20]; float* out; unsigned char* ws; int ph_lo, ph_hi, variant, pad; };
enum { I_X = 0, I_C, I_CTX, I_CCTX, I_WADA, I_BADA, I_NPREMIX, I_NPOSTMIX, I_WIN, I_DECF, I_DECB, I_RETGAIN, I_WOUT, I_NPREFFN, I_NPOSTFFN, I_WQ, I_KEYS1, I_KEYS2, I_U, I_V };

DI int win_srccol(int n) { if (n < 1024) { const int p = n & 63; return (n & ~63) + (p >> 1) + 32 * (p & 1); } return n; }
DI void p0_transpose_item(const float* W, int ldw, int nout, bf16_t* WT, int mode, LAS float* scr, int item, int lane) {
    const int nblk = nout / 32, kb = item / nblk, nb = item % nblk, k0 = 64 * kb, n0 = 32 * nb;
    const int nn = n0 + (lane & 31);
    const int sc = mode ? win_srccol(nn) : nn;
    const float scale = (mode && nn >= 512 && nn < 1024) ? 0.125f : 1.0f;
#pragma unroll 8
    for (int i = 0; i < 32; ++i) { const int kk = 2 * i + (lane >> 5); scr[kk * 33 + (lane & 31)] = W[(size_t)(k0 + kk) * ldw + sc] * scale; }
    LDS_WAIT();
    const int c = lane & 7;
#pragma unroll
    for (int j = 0; j < 4; ++j) { const int n = (lane >> 3) + 8 * j; const LAS float* s = scr + (8 * c) * 33 + n;
        u32x4 o; o.x = pk2(s[0 * 33], s[1 * 33]); o.y = pk2(s[2 * 33], s[3 * 33]); o.z = pk2(s[4 * 33], s[5 * 33]); o.w = pk2(s[6 * 33], s[7 * 33]);
        *(u32x4*)(WT + (size_t)(n0 + n) * 1024 + k0 + 8 * c) = o; }
    LDS_WAIT();
}

DI void phase0(const Params& P, LAS unsigned char* lds) {
    const int tid = threadIdx.x, lane = tid & 63, wave = tid >> 6;
    const int gw = blockIdx.x * NWAVES + wave, NGW = gridDim.x * NWAVES;
    const int gt = blockIdx.x * NTHREADS + tid, NGT = gridDim.x * NTHREADS;
    unsigned char* ws = P.ws;
    LAS float* scr = (LAS float*)(lds + wave * 8704);
    LAS float* ctab = (LAS float*)(lds + 69632);
    LAS float* stab = ctab + 128;
    LAS float* svec = (LAS float*)(lds + 71680);
    if (tid < 128) { float s, c; sincospif((float)tid * (1.0f / 64.0f), &s, &c); ctab[tid] = c; stab[tid] = s; }
    for (int i = tid; i < 17 * 1024; i += NTHREADS) { const float v = (i < 16384) ? P.in[I_C][i] : P.in[I_CCTX][i - 16384]; svec[i] = siluf(v); }
    __syncthreads();
    {
        bf16_t* WIN = (bf16_t*)(ws + WS_WIN); bf16_t* WOUT = (bf16_t*)(ws + WS_WOUT); bf16_t* WQ = (bf16_t*)(ws + WS_WQ);
        constexpr int I1 = 16 * 64, I2 = 16 * 32, I3 = 16 * 64;
        for (int it = gw; it < I1 + I2 + I3; it += NGW) {
            int r = it;
            if (r < I1) { p0_transpose_item(P.in[I_WIN], INW, 2048, WIN, 1, scr, r, lane); continue; } r -= I1;
            if (r < I2) { p0_transpose_item(P.in[I_WOUT], 1024, 1024, WOUT, 0, scr, r, lane); continue; } r -= I2;
            p0_transpose_item(P.in[I_WQ], 2048, 2048, WQ, 0, scr, r, lane);
        }
    }
    {
        bf16_t* WF = (bf16_t*)(ws + WS_WF);
        for (int it = gw; it < 4096; it += NGW) {
            const int kk = it >> 2, g = it & 3;
            const float* src = P.in[I_WIN] + (size_t)kk * INW + F_OFF + g * 128;
            scr[lane] = src[lane]; scr[lane + 64] = src[lane + 64];
            LDS_WAIT();
#pragma unroll
            for (int q = 0; q < 2; ++q) {
                const int l = lane + 64 * q; float ac = 0.f, as = 0.f;
                for (int c = 0; c < 128; ++c) { const float f = scr[c]; const int m = (c * l) & 127; ac += f * ctab[m]; as += f * stab[m]; }
                WF[(size_t)((g * 2 + 0) * 128 + l) * 1024 + kk] = f2bf(ac);
                WF[(size_t)((g * 2 + 1) * 128 + l) * 1024 + kk] = f2bf(as);
            }
            LDS_WAIT();
        }
    }
    {
        bf16_t* DFT = (bf16_t*)(ws + WS_DFT);
        for (int idx = gt; idx < 2048 * 2048; idx += NGT) {
            const int k = idx >> 11, c2 = (idx & 2047) * 2, p = c2 >> 11, n0 = c2 & 2047;
            float s0, c0, s1, c1;
            sincospif((float)((n0 * k) & 2047) * (1.0f / 1024.0f), &s0, &c0);
            sincospif((float)(((n0 + 1) * k) & 2047) * (1.0f / 1024.0f), &s1, &c1);
            const float v0 = (p ? -s0 : c0) * (1.0f / 512.0f), v1 = (p ? -s1 : c1) * (1.0f / 512.0f);
            *(unsigned*)(DFT + (size_t)k * 4096 + c2) = pk2(v0, v1);
        }
    }
    {
        float* RC = (float*)(ws + WS_ROPE); float* RS = RC + 2048 * 32;
        for (int idx = gt; idx < 2048 * 32; idx += NGT) {
            const int n = idx >> 5, j = idx & 31; const float pos = (float)((j < 16) ? (n >> 6) : (n & 63));
            const float freq = powf(10000.0f, -(float)(j & 15) * (1.0f / 16.0f)); const float ang = pos * freq;
            RC[idx] = cosf(ang); RS[idx] = sinf(ang);
        }
        bf16_t* KEYS = (bf16_t*)(ws + WS_KEYS);
        for (int idx = gt; idx < 2 * 128 * 128; idx += NGT) KEYS[idx] = f2bf(idx < 16384 ? P.in[I_KEYS1][idx] : P.in[I_KEYS2][idx - 16384]);
    }
    {
        float* MOD = (float*)(ws + WS_MOD);
        for (int cb = blockIdx.x; cb < 256; cb += gridDim.x) {
            if (wave < 6) {
                const int col = cb * 24 + wave * 4;
                f32x4 acc[17];
#pragma unroll
                for (int r = 0; r < 17; ++r) acc[r] = (f32x4){0.f, 0.f, 0.f, 0.f};
#pragma unroll 1
                for (int i = 0; i < 16; ++i) {
                    const int k = lane + 64 * i;
                    const f32x4 w = *(const f32x4*)(P.in[I_WADA] + (size_t)k * 6144 + col);
#pragma unroll
                    for (int r = 0; r < 17; ++r) { const float s = svec[r * 1024 + k]; acc[r] += w * s; }
                }
#pragma unroll
                for (int r = 0; r < 17; ++r) {
                    f32x4 a = acc[r];
#pragma unroll
                    for (int o = 1; o < 64; o <<= 1) { a.x += __shfl_xor(a.x, o); a.y += __shfl_xor(a.y, o); a.z += __shfl_xor(a.z, o); a.w += __shfl_xor(a.w, o); }
                    if (lane == 0) { const f32x4 bb = *(const f32x4*)(P.in[I_BADA] + col); *(f32x4*)(MOD + (size_t)r * 6144 + col) = a + bb; }
                }
            }
        }
    }
}

DI void norm_mod_row(const float* xrow, const float* gain, const float* sh, const float* sc, bf16_t* orow, int lane) {
    const f32x4* xr = (const f32x4*)xrow + lane;
    f32x4 v[4]; float ss = 0.f;
#pragma unroll
    for (int j = 0; j < 4; ++j) { v[j] = xr[64 * j]; ss += (v[j].x * v[j].x + v[j].y * v[j].y) + (v[j].z * v[j].z + v[j].w * v[j].w); }
    const float rstd = rsqrtf(wave_sum(ss) * (1.0f / DM) + EPSV);
#pragma unroll
    for (int j = 0; j < 4; ++j) {
        const f32x4 g = ((const f32x4*)gain)[64 * j + lane], s = ((const f32x4*)sc)[64 * j + lane], h = ((const f32x4*)sh)[64 * j + lane];
        const f32x4 y = v[j] * rstd * g * (s + 1.0f) + h;
        u32x2 o; o.x = pk2(y.x, y.y); o.y = pk2(y.z, y.w);
        ((u32x2*)orow)[64 * j + lane] = o;
    }
}
DI void phase1(const Params& P) {
    const int lane = threadIdx.x & 63, wave = threadIdx.x >> 6;
    const int gw = blockIdx.x * NWAVES + wave, NGW = gridDim.x * NWAVES;
    const float* MOD = (const float*)(P.ws + WS_MOD);
    bf16_t* HX = (bf16_t*)(P.ws + WS_HX); bf16_t* HC = (bf16_t*)(P.ws + WS_HC);
    for (int r = gw; r < NTOK + NCTX; r += NGW) {
        if (r < NTOK) { const int b = r >> 11; const float* m = MOD + (size_t)b * 6144;
            norm_mod_row(P.in[I_X] + (size_t)r * DM, P.in[I_NPREMIX], m, m + 1024, HX + (size_t)r * DM, lane); }
        else { const int rc = r - NTOK; const float* m = MOD + (size_t)16 * 6144;
            norm_mod_row(P.in[I_CTX] + (size_t)rc * DM, P.in[I_NPREMIX], m, m + 1024, HC + (size_t)rc * DM, lane); }
    }
}

struct FPlain { bf16_t* O; int ldc;
    DI void operator()(int row, int col0, const f32x4& v0, const f32x4& v1) const {
        u32x4 w; w.x = pk2(v0[0], v0[1]); w.y = pk2(v0[2], v0[3]); w.z = pk2(v1[0], v1[1]); w.w = pk2(v1[2], v1[3]);
        *(u32x4*)(O + (size_t)row * ldc + col0) = w; } };
struct FQkvg { bf16_t* O; const float* RC; const float* RS;
    DI void operator()(int row, int col0, const f32x4& a0, const f32x4& a1) const {
        f32x4 v0 = a0, v1 = a1;
        if (col0 < 1024) {
            const int n = row & 2047, j0 = (col0 & 63) >> 1;
            const f32x4 cs = *(const f32x4*)(RC + n * 32 + j0), sn = *(const f32x4*)(RS + n * 32 + j0);
            f32x4 r0, r1;
            r0[0] = v0[0] * cs[0] - v0[1] * sn[0]; r0[1] = v0[1] * cs[0] + v0[0] * sn[0];
            r0[2] = v0[2] * cs[1] - v0[3] * sn[1]; r0[3] = v0[3] * cs[1] + v0[2] * sn[1];
            r1[0] = v1[0] * cs[2] - v1[1] * sn[2]; r1[1] = v1[1] * cs[2] + v1[0] * sn[2];
            r1[2] = v1[2] * cs[3] - v1[3] * sn[3]; r1[3] = v1[3] * cs[3] + v1[2] * sn[3];
            v0 = r0; v1 = r1;
        }
        u32x4 w; w.x = pk2(v0[0], v0[1]); w.y = pk2(v0[2], v0[3]); w.z = pk2(v1[0], v1[1]); w.w = pk2(v1[2], v1[3]);
        *(u32x4*)(O + (size_t)row * 2048 + col0) = w; } };
struct FFnetT { bf16_t* FT;
    DI void operator()(int row, int col0, const f32x4& v0, const f32x4& v1) const {
        const int g = row >> 8, p = (row >> 7) & 1, l = row & 127, b = col0 >> 11, n = col0 & 2047;
        u32x4 w; w.x = pk2(v0[0], v0[1]); w.y = pk2(v0[2], v0[3]); w.z = pk2(v1[0], v1[1]); w.w = pk2(v1[2], v1[3]);
        *(u32x4*)(FT + (size_t)((b * 4 + g) * 128 + l) * 4096 + p * 2048 + n) = w; } };
struct FFnetOut { bf16_t* MIX;
    DI void operator()(int row, int col0, const f32x4& v0, const f32x4& v1) const {
        const int b = col0 >> 9, gc = col0 & 511;
        u32x4 w; w.x = pk2(v0[0], v0[1]); w.y = pk2(v0[2], v0[3]); w.z = pk2(v1[0], v1[1]); w.w = pk2(v1[2], v1[3]);
        *(u32x4*)(MIX + (size_t)(b * 2048 + row) * 1024 + 512 + gc) = w; } };

template <class F> DI void run_gemm(LAS unsigned char* lds, const bf16_t* A, const bf16_t* Bt, int M, int N, int K, const F& f) {
    pg8::Gemm g{A, Bt, M, N, K}; pg8::StaticOrder S; S.init(M, N, (int)gridDim.x, (int)blockIdx.x);
    pg8::EpiBf16F<F> E{f};
    pg8::gemm_phase<pg8::EpiBf16F<F>, pg8::StaticOrder>(lds, g, S, E);
}

constexpr int R_Q = 0, R_K = 18432, R_KFT = 36864, R_KBT = 54272, R_VT = 71680, R_P = 89088, R_SFT = 123904, R_SBT = 133120;
constexpr int LQ = 72, LT = 136, LO = 65;
constexpr int R_DTAB = 142336;

DI f32x16 mma_tile(const LAS bf16_t* A, int lda, const LAS bf16_t* Bt, int ldb, int K, f32x16 acc, int lane) {
    const int r = lane & 31, hh = lane >> 5;
    const LAS bf16_t* ap = A + r * lda + 8 * hh; const LAS bf16_t* bp = Bt + r * ldb + 8 * hh;
#pragma unroll 4
    for (int k0 = 0; k0 < K; k0 += 16) { const bf16x8 a = *(const LAS bf16x8*)(ap + k0); const bf16x8 b = *(const LAS bf16x8*)(bp + k0); acc = MFMA32(a, b, acc); }
    return acc;
}
DI void stage_chunk(LAS unsigned char* lds, const bf16_t* src, int stride, int colQ, int colK, int colV, float lgf, float ef0, float lgb, float eb0) {
    const int tid = threadIdx.x, j = tid >> 2, c0 = (tid & 3) * 16;
    const bf16_t* rowp = src + (size_t)j * stride;
    const u32x4 k0 = *(const u32x4*)(rowp + colK + c0), k1 = *(const u32x4*)(rowp + colK + c0 + 8);
    const u32x4 v0 = *(const u32x4*)(rowp + colV + c0), v1 = *(const u32x4*)(rowp + colV + c0 + 8);
    LAS bf16_t* Ks = (LAS bf16_t*)(lds + R_K); LAS bf16_t* KfT = (LAS bf16_t*)(lds + R_KFT); LAS bf16_t* KbT = (LAS bf16_t*)(lds + R_KBT); LAS bf16_t* VT = (LAS bf16_t*)(lds + R_VT);
    *(LAS u32x4*)(Ks + j * LQ + c0) = k0; *(LAS u32x4*)(Ks + j * LQ + c0 + 8) = k1;
    if (colQ >= 0) { const u32x4 q0 = *(const u32x4*)(rowp + colQ + c0), q1 = *(const u32x4*)(rowp + colQ + c0 + 8);
        LAS bf16_t* Qs = (LAS bf16_t*)(lds + R_Q); *(LAS u32x4*)(Qs + j * LQ + c0) = q0; *(LAS u32x4*)(Qs + j * LQ + c0 + 8) = q1; }
    const float wf = __expf(lgf * (ef0 - (float)j)), wb = __expf(lgb * (eb0 + (float)j));
    const unsigned kw[8] = {k0.x, k0.y, k0.z, k0.w, k1.x, k1.y, k1.z, k1.w};
    const unsigned vw[8] = {v0.x, v0.y, v0.z, v0.w, v1.x, v1.y, v1.z, v1.w};
#pragma unroll
    for (int i = 0; i < 8; ++i) {
        const float ka = bflo(kw[i]), kb = bfhi(kw[i]);
        const int d = c0 + 2 * i;
        KfT[d * LT + j] = f2bf(ka * wf); KfT[(d + 1) * LT + j] = f2bf(kb * wf);
        KbT[d * LT + j] = f2bf(ka * wb); KbT[(d + 1) * LT + j] = f2bf(kb * wb);
        VT[d * LT + j] = (bf16_t)(vw[i] & 0xffffu); VT[(d + 1) * LT + j] = (bf16_t)(vw[i] >> 16);
    }
}
DI void store_state_T(bf16_t* ST, int ld, const f32x16& s, int dkb, int dvb, int lane) {
    const int dv = 32 * dvb + (lane & 31), hh = lane >> 5;
#pragma unroll
    for (int g = 0; g < 4; ++g) { u32x2 o; o.x = pk2(s[4 * g], s[4 * g + 1]); o.y = pk2(s[4 * g + 2], s[4 * g + 3]);
        *(u32x2*)(ST + dv * ld + 32 * dkb + 8 * g + 4 * hh) = o; }
}
DI void store_state_T(LAS bf16_t* ST, int ld, const f32x16& s, int dkb, int dvb, int lane) {
    const int dv = 32 * dvb + (lane & 31), hh = lane >> 5;
#pragma unroll
    for (int g = 0; g < 4; ++g) { u32x2 o; o.x = pk2(s[4 * g], s[4 * g + 1]); o.y = pk2(s[4 * g + 2], s[4 * g + 3]);
        *(LAS u32x2*)(ST + dv * ld + 32 * dkb + 8 * g + 4 * hh) = o; }
}

DI void retention_item(const Params& P, LAS unsigned char* lds, int item) {
    const int tid = threadIdx.x, lane = tid & 63, wave = __builtin_amdgcn_readfirstlane(tid >> 6), hh = lane >> 5;
    const int b = item >> 4, h = (item >> 1) & 7, hf = item & 1;
    const float lgf = log1pf(-expf(P.in[I_DECF][h])), lgb = log1pf(-expf(P.in[I_DECB][h]));
    const bf16_t* QKVG = (const bf16_t*)(P.ws + WS_QKVG) + (size_t)b * SEQ * 2048;
    const bf16_t* CKV = (const bf16_t*)(P.ws + WS_CKV) + (size_t)b * CTXL * 1024;
    bf16_t* SBST = (bf16_t*)(P.ws + WS_SB) + (size_t)item * 8 * 4096;
    bf16_t* MIX = (bf16_t*)(P.ws + WS_MIX) + (size_t)b * SEQ * 1024;
    const int c0 = 8 * hf, clast = c0 + 7; const float P0 = 128.f * c0, Pend = 128.f * (clast + 1);
    LAS bf16_t* Qs = (LAS bf16_t*)(lds + R_Q); LAS bf16_t* Ks = (LAS bf16_t*)(lds + R_K); LAS bf16_t* KfT = (LAS bf16_t*)(lds + R_KFT); LAS bf16_t* KbT = (LAS bf16_t*)(lds + R_KBT);
    LAS bf16_t* VT = (LAS bf16_t*)(lds + R_VT); LAS bf16_t* Ps = (LAS bf16_t*)(lds + R_P); LAS float* Os = (LAS float*)(lds + R_P);
    LAS bf16_t* SfT = (LAS bf16_t*)(lds + R_SFT); LAS bf16_t* SbT = (LAS bf16_t*)(lds + R_SBT);
    const int sdk = (wave >> 1) & 1, sdv = wave & 1;
    const bool isF = wave < 4;
    f32x16 Sacc;
#pragma unroll
    for (int i = 0; i < 16; ++i) Sacc[i] = 0.f;
    LAS float* dtab = (LAS float*)(lds + R_DTAB);
    { const int k = tid & 127, which = tid >> 7;
      dtab[tid] = which == 0 ? __expf(lgf * (float)k) : which == 1 ? __expf(lgb * (float)k) : which == 2 ? __expf(lgf * (float)(k + 1)) : __expf(lgb * (float)(128 - k)); }

    for (int x = 0; x < 10; ++x) {
        const bf16_t* src; int stride, colK, colV; float pos0f, pos0b; bool cf, cb;
        if (x < 2) { src = CKV + (size_t)(128 * x) * 1024; stride = 1024; colK = h * 64; colV = 512 + h * 64; pos0f = -256.f + 128.f * x; pos0b = 2048.f + 128.f * x; cf = true; cb = true; }
        else { const int c = (hf ? 0 : 8) + (x - 2); src = QKVG + (size_t)(128 * c) * 2048; stride = 2048; colK = 512 + h * 64; colV = 1024 + h * 64; pos0f = 128.f * c; pos0b = pos0f; cf = (hf == 1); cb = (hf == 0); }
        const float ef0 = cf ? (P0 - 1.f - pos0f) : 0.f, eb0 = cb ? (pos0b - Pend) : 0.f;
        __syncthreads();
        stage_chunk(lds, src, stride, -1, colK, colV, lgf, ef0, lgb, eb0);
        __syncthreads();
        if (isF) { if (cf) Sacc = mma_tile(KfT + 32 * sdk * LT, LT, VT + 32 * sdv * LT, LT, 128, Sacc, lane); }
        else { if (cb) Sacc = mma_tile(KbT + 32 * sdk * LT, LT, VT + 32 * sdv * LT, LT, 128, Sacc, lane); }
    }
    const float gb128 = __expf(lgb * 128.f), gf128 = __expf(lgf * 128.f);
    for (int c = clast; c >= c0; --c) {
        if (!isF) store_state_T(SBST + (size_t)(c - c0) * 4096, 64, Sacc, sdk, sdv, lane);
        if (c > c0) {
            __syncthreads();
            stage_chunk(lds, QKVG + (size_t)(128 * c) * 2048, 2048, -1, 512 + h * 64, 1024 + h * 64, lgf, 127.f, lgb, 0.f);
            __syncthreads();
            if (!isF) { Sacc = Sacc * gb128; Sacc = mma_tile(KbT + 32 * sdk * LT, LT, VT + 32 * sdv * LT, LT, 128, Sacc, lane); }
        }
    }
    for (int c = c0; c <= clast; ++c) {
        __syncthreads();
        stage_chunk(lds, QKVG + (size_t)(128 * c) * 2048, 2048, h * 64, 512 + h * 64, 1024 + h * 64, lgf, 127.f, lgb, 0.f);
        if (isF) store_state_T(SfT, LQ, Sacc, sdk, sdv, lane);
        {
            const int r = tid >> 3, pc = tid & 7; const u32x4 w = *(const u32x4*)(SBST + (size_t)(c - c0) * 4096 + r * 64 + pc * 8);
            *(LAS u32x4*)(SbT + r * LQ + pc * 8) = w; }
        __syncthreads();
        const int ib = wave >> 1, db = wave & 1;
#pragma unroll
        for (int t = 0; t < 2; ++t) {
            const int jb = 2 * db + t;
            f32x16 s = mma_tile(Qs + 32 * ib * LQ, LQ, Ks + 32 * jb * LQ, LQ, 64, zero16(), lane);
            const int j = 32 * jb + (lane & 31);
#pragma unroll
            for (int r = 0; r < 16; ++r) { const int i = 32 * ib + crow(r, hh); const int dlt = i - j;
                const float dec = dtab[dlt >= 0 ? dlt : 128 - dlt];
                Ps[i * LT + j] = f2bf(s[r] * dec); }
        }
        __syncthreads();
        f32x16 o = mma_tile(Ps + 32 * ib * LT, LT, VT + 32 * db * LT, LT, 128, zero16(), lane);
        f32x16 tf = mma_tile(Qs + 32 * ib * LQ, LQ, SfT + 32 * db * LQ, LQ, 64, zero16(), lane);
        f32x16 tb = mma_tile(Qs + 32 * ib * LQ, LQ, SbT + 32 * db * LQ, LQ, 64, zero16(), lane);
#pragma unroll
        for (int r = 0; r < 16; ++r) { const int i = 32 * ib + crow(r, hh); o[r] += dtab[256 + i] * tf[r] + dtab[384 + i] * tb[r]; }
        __syncthreads();
#pragma unroll
        for (int r = 0; r < 16; ++r) Os[(32 * ib + crow(r, hh)) * LO + 32 * db + (lane & 31)] = o[r];
        if (isF) { Sacc = Sacc * gf128; Sacc = mma_tile(KfT + 32 * sdk * LT, LT, VT + 32 * sdv * LT, LT, 128, Sacc, lane); }
        __syncthreads();
        {
            const int i = tid >> 2, q4 = tid & 3; float ov[16]; float ss = 0.f;
#pragma unroll
            for (int e = 0; e < 16; ++e) { ov[e] = Os[i * LO + 16 * q4 + e]; ss += ov[e] * ov[e]; }
            ss += __shfl_xor(ss, 1); ss += __shfl_xor(ss, 2);
            const float rstd = rsqrtf(ss * (1.0f / 64.0f) + EPSV);
            const bf16_t* gp = QKVG + (size_t)(128 * c + i) * 2048 + 1536 + h * 64 + 16 * q4;
            const u32x4 g0 = *(const u32x4*)gp, g1 = *(const u32x4*)(gp + 8);
            const unsigned gw_[8] = {g0.x, g0.y, g0.z, g0.w, g1.x, g1.y, g1.z, g1.w};
            const float* gn = P.in[I_RETGAIN] + h * 64 + 16 * q4;
            unsigned ow[8];
#pragma unroll
            for (int e = 0; e < 8; ++e) {
                const float ya = ov[2 * e] * rstd * gn[2 * e] * siluf(bflo(gw_[e])), yb = ov[2 * e + 1] * rstd * gn[2 * e + 1] * siluf(bfhi(gw_[e]));
                ow[e] = pk2(ya, yb);
            }
            bf16_t* mp = MIX + (size_t)(128 * c + i) * 1024 + h * 64 + 16 * q4;
            *(u32x4*)mp = (u32x4){ow[0], ow[1], ow[2], ow[3]}; *(u32x4*)(mp + 8) = (u32x4){ow[4], ow[5], ow[6], ow[7]};
        }
    }
    __syncthreads();
}

DI void phase5(const Params& P) {
    const int lane = threadIdx.x & 63, wave = threadIdx.x >> 6;
    const int gw = blockIdx.x * NWAVES + wave, NGW = gridDim.x * NWAVES;
    const float* MOD = (const float*)(P.ws + WS_MOD);
    const float* O = (const float*)(P.ws + WS_QKVG);
    bf16_t* H2 = (bf16_t*)(P.ws + WS_HX); bf16_t* H2S = (bf16_t*)(P.ws + WS_H2S);
    for (int r = gw; r < NTOK; r += NGW) {
        const int b = r >> 11; const float* m = MOD + (size_t)b * 6144;
        const f32x4* orow = (const f32x4*)(O + (size_t)r * DM) + lane; const f32x4* xrow = (const f32x4*)(P.in[I_X] + (size_t)r * DM) + lane;
        f32x4 ov[4], xv[4]; float ss = 0.f;
#pragma unroll
        for (int j = 0; j < 4; ++j) { ov[j] = orow[64 * j]; xv[j] = xrow[64 * j]; ss += (ov[j].x * ov[j].x + ov[j].y * ov[j].y) + (ov[j].z * ov[j].z + ov[j].w * ov[j].w); }
        const float rstd = rsqrtf(wave_sum(ss) * (1.0f / DM) + EPSV);
        float ss2 = 0.f;
#pragma unroll
        for (int j = 0; j < 4; ++j) {
            const f32x4 gn = ((const f32x4*)P.in[I_NPOSTMIX])[64 * j + lane], g1 = ((const f32x4*)(m + 2048))[64 * j + lane];
            xv[j] = xv[j] + g1 * (ov[j] * rstd * gn);
            ((f32x4*)(P.out + (size_t)r * DM))[64 * j + lane] = xv[j];
            ss2 += (xv[j].x * xv[j].x + xv[j].y * xv[j].y) + (xv[j].z * xv[j].z + xv[j].w * xv[j].w);
        }
        const float rstd2 = rsqrtf(wave_sum(ss2) * (1.0f / DM) + EPSV);
#pragma unroll
        for (int j = 0; j < 4; ++j) {
            const f32x4 gn = ((const f32x4*)P.in[I_NPREFFN])[64 * j + lane], sh = ((const f32x4*)(m + 3072))[64 * j + lane], sc = ((const f32x4*)(m + 4096))[64 * j + lane];
            const f32x4 y = xv[j] * rstd2 * gn * (sc + 1.0f) + sh;
            u32x2 o; o.x = pk2(y.x, y.y); o.y = pk2(y.z, y.w);
            ((u32x2*)(H2 + (size_t)r * DM))[64 * j + lane] = o;
            *(u32x2*)(H2S + ((size_t)(2 * j + (lane >> 5)) * NTOK + r) * 128 + 4 * (lane & 31)) = o;
        }
    }
}

#define INS16(L, xx) do { float _x = (xx); _Pragma("unroll") for (int _i = 0; _i < 16; ++_i) { const float _t = fmaxf(L[_i], _x); _x = fminf(L[_i], _x); L[_i] = _t; } } while (0)
constexpr int KLD = 136;
DI void topk_half(const LAS bf16_t* keys  , const bf16_t* qrow  , float (&L)[16], int lane) {
    const int r = lane & 31, hh = lane >> 5;
    f32x16 acc[4];
#pragma unroll
    for (int t = 0; t < 4; ++t)
#pragma unroll
        for (int i = 0; i < 16; ++i) acc[t][i] = 0.f;
#pragma unroll 2
    for (int k0 = 0; k0 < 128; k0 += 16) {
        const bf16x8 bq = *(const bf16x8*)(qrow + k0 + 8 * hh);
#pragma unroll
        for (int t = 0; t < 4; ++t) { const bf16x8 a = *(const LAS bf16x8*)(keys + (32 * t + r) * KLD + k0 + 8 * hh); acc[t] = MFMA32(a, bq, acc[t]); }
    }
#pragma unroll
    for (int i = 0; i < 16; ++i) L[i] = -3.0e38f;
#pragma unroll
    for (int t = 0; t < 4; ++t)
#pragma unroll
        for (int i = 0; i < 16; ++i) {
            const unsigned idx = 32u * t + (unsigned)((i & 3) + 8 * (i >> 2));
            const float pv = __uint_as_float((__float_as_uint(acc[t][i]) & 0xFFFFFF80u) | idx);
            INS16(L, pv);
        }
#pragma unroll
    for (int i = 0; i < 16; ++i) L[i] = __uint_as_float(__float_as_uint(L[i]) | ((unsigned)hh << 2));
    float Pn[16];
#pragma unroll
    for (int i = 0; i < 16; ++i) Pn[i] = __shfl_xor(L[i], 32);
#pragma unroll
    for (int i = 0; i < 16; ++i) INS16(L, Pn[i]);
}
DI unsigned pack4idx(float a, float b, float c, float d) { return (__float_as_uint(a) & 127u) | ((__float_as_uint(b) & 127u) << 8) | ((__float_as_uint(c) & 127u) << 16) | ((__float_as_uint(d) & 127u) << 24); }
DI unsigned pick_idx(unsigned w0, unsigned w1, unsigned w2, unsigned w3, unsigned a) {
    const unsigned lo = (a & 4u) ? w1 : w0, hi = (a & 4u) ? w3 : w2, w = (a & 8u) ? hi : lo;
    return (w >> (8u * (a & 3u))) & 127u;
}
typedef __bf16 bf16x2_t __attribute__((ext_vector_type(2)));
DI float dot2bf(unsigned a, unsigned b, float acc) { return __builtin_amdgcn_fdot2_f32_bf16(__builtin_bit_cast(bf16x2_t, a), __builtin_bit_cast(bf16x2_t, b), acc, false); }
#define DPP_ADD(x, ctrl) ((x) + __int_as_float(__builtin_amdgcn_update_dpp(0, __float_as_int(x), (ctrl), 0xf, 0xf, true)))
DI float dpp_sum16(float x) {
    x = DPP_ADD(x, 0x128);
    x = DPP_ADD(x, 0x141);
    x = DPP_ADD(x, 0x4E);
    x = DPP_ADD(x, 0xB1);
    return x;
}

constexpr int P7_IDS = 69632, P7_WTS = 77952, P7_SID = 94336, P7_SWT = 102528, P7_CUM = 118912;
DI void phase7(const Params& P, LAS unsigned char* lds) {
    const int tid = threadIdx.x, lane = tid & 63, wave = tid >> 6;
    LAS bf16_t* keys = (LAS bf16_t*)lds;
    LAS bf16_t* ids_l = (LAS bf16_t*)(lds + P7_IDS);
    LAS float* wts_l = (LAS float*)(lds + P7_WTS);
    LAS bf16_t* sid_l = (LAS bf16_t*)(lds + P7_SID);
    LAS float* swt_l = (LAS float*)(lds + P7_SWT);
    LAS unsigned char* cum_l = (LAS unsigned char*)(lds + P7_CUM);
    const bf16_t* KEYS = (const bf16_t*)(P.ws + WS_KEYS);
    for (int i = tid; i < 256 * 16; i += NTHREADS) { const int r = i >> 4, pc = i & 15; *(LAS u32x4*)(keys + r * KLD + pc * 8) = *(const u32x4*)(KEYS + r * 128 + pc * 8); }
    __syncthreads();
    const bf16_t* PQ = (const bf16_t*)(P.ws + WS_FT);
    bf16_t* SID = (bf16_t*)(P.ws + WS_SID); bf16_t* SIDB = (bf16_t*)(P.ws + WS_SIDB); float* SWT = (float*)(P.ws + WS_SWT);
    for (int tile = blockIdx.x; tile < 1024; tile += gridDim.x) {
        const int t0 = tile * 32;
        {
            const int h = wave, tl = lane & 31, tok = t0 + tl, hh = lane >> 5;
            const bf16_t* qrow = PQ + (size_t)tok * 2048 + h * 256;
            float L1[16], L2[16];
            topk_half(keys, qrow, L1, lane);
            topk_half(keys + 128 * KLD, qrow + 128, L2, lane);
            const unsigned w10 = pack4idx(L1[0], L1[1], L1[2], L1[3]), w11 = pack4idx(L1[4], L1[5], L1[6], L1[7]), w12 = pack4idx(L1[8], L1[9], L1[10], L1[11]), w13 = pack4idx(L1[12], L1[13], L1[14], L1[15]);
            const unsigned w20 = pack4idx(L2[0], L2[1], L2[2], L2[3]), w21 = pack4idx(L2[4], L2[5], L2[6], L2[7]), w22 = pack4idx(L2[8], L2[9], L2[10], L2[11]), w23 = pack4idx(L2[12], L2[13], L2[14], L2[15]);
            float C[16];
#pragma unroll
            for (int i = 0; i < 16; ++i) C[i] = -3.0e38f;
#pragma unroll
            for (int a = 0; a < 16; ++a)
#pragma unroll
                for (int bq = 0; bq < 16; ++bq)
                    if ((a + 1) * (bq + 1) <= 16) { const float sm = L1[a] + L2[bq]; const float pv = __uint_as_float((__float_as_uint(sm) & 0xFFFFFF00u) | (unsigned)(a * 16 + bq)); INS16(C, pv); }
            float e[16], sum = 0.f;
#pragma unroll
            for (int i = 0; i < 16; ++i) { e[i] = __expf(C[i] - C[0]); sum += e[i]; }
            const float inv = 1.0f / sum;
            if (hh == 0) {
#pragma unroll
                for (int i = 0; i < 16; ++i) { const unsigned code = __float_as_uint(C[i]) & 255u;
                    ids_l[tl * 130 + h * 16 + i] = (bf16_t)(pick_idx(w10, w11, w12, w13, code >> 4) * 128u + pick_idx(w20, w21, w22, w23, code & 15u)); }
            } else {
#pragma unroll
                for (int i = 0; i < 16; ++i) wts_l[tl * 128 + h * 16 + i] = e[i] * inv;
            }
        }
        __syncthreads();
        {
            const int tl = tid >> 4, j = tid & 15;
            unsigned key[8], rank[8], myid[8];
#pragma unroll
            for (int m = 0; m < 8; ++m) { myid[m] = ids_l[tl * 130 + 8 * j + m]; key[m] = ((myid[m] >> 9) << 7) | (unsigned)(8 * j + m); rank[m] = 0; }
            unsigned cumA = 0, cumB = 0;
            for (int i = 0; i < 128; ++i) {
                const unsigned idv = ids_l[tl * 130 + i], ebv = idv >> 9, kv = (ebv << 7) | (unsigned)i;
#pragma unroll
                for (int m = 0; m < 8; ++m) rank[m] += (kv < key[m]) ? 1u : 0u;
                cumA += (ebv < (unsigned)j) ? 1u : 0u; cumB += (ebv < (unsigned)(j + 16)) ? 1u : 0u;
            }
#pragma unroll
            for (int m = 0; m < 8; ++m) { sid_l[tl * 128 + rank[m]] = (bf16_t)myid[m]; swt_l[tl * 128 + rank[m]] = wts_l[tl * 128 + 8 * j + m]; }
            cum_l[tl * 40 + j] = (unsigned char)cumA; cum_l[tl * 40 + 16 + j] = (unsigned char)cumB; if (j == 0) cum_l[tl * 40 + 32] = 128;
        }
        __syncthreads();
        {
            const int tl = tid >> 4, pc = tid & 15;
            *(u32x4*)(SID + (size_t)(t0 + tl) * 128 + pc * 8) = *(const LAS u32x4*)(sid_l + tl * 128 + pc * 8);
            *(u32x4*)(SWT + (size_t)(t0 + tl) * 128 + pc * 8) = *(const LAS u32x4*)(swt_l + tl * 128 + pc * 8);
            *(u32x4*)(SWT + (size_t)(t0 + tl) * 128 + pc * 8 + 4) = *(const LAS u32x4*)(swt_l + tl * 128 + pc * 8 + 4);
#pragma unroll
            for (int rr = 0; rr < 2; ++rr) {
                const int rec = tid + rr * NTHREADS, eb = rec >> 5, tk = rec & 31;
                const unsigned lo = cum_l[tk * 40 + eb], hi = cum_l[tk * 40 + eb + 1], cnt = hi - lo;
                unsigned w[8];
#pragma unroll
                for (int q = 0; q < 8; ++q) {
                    unsigned a, b;
                    if (q == 0) a = cnt | (lo << 8); else { const unsigned k = 2 * q - 1; a = (k < cnt) ? (unsigned)sid_l[tk * 128 + ((lo + k) & 127)] : 0u; }
                    { const unsigned k = 2 * q; b = (k < cnt) ? (unsigned)sid_l[tk * 128 + ((lo + k) & 127)] : 0u; }
                    w[q] = a | (b << 16);
                }
                bf16_t* rp = SIDB + ((size_t)eb * NTOK + t0 + tk) * 16;
                *(u32x4*)rp = (u32x4){w[0], w[1], w[2], w[3]}; *(u32x4*)(rp + 8) = (u32x4){w[4], w[5], w[6], w[7]};
            }
        }
        __syncthreads();
    }
}

template <int VAR> DI void phase8(const Params& P, LAS unsigned char* lds, float* PART) {
    constexpr int variant = VAR;
    const int tid = threadIdx.x, lane = tid & 63, g = tid >> 4, l16 = tid & 15;
    LAS bf16_t* tab = (LAS bf16_t*)lds;
    const bf16_t* H2S = (const bf16_t*)(P.ws + WS_H2S);
    const bf16_t* SIDB = (const bf16_t*)(P.ws + WS_SIDB); const bf16_t* SID = (const bf16_t*)(P.ws + WS_SID);
    for (int role = blockIdx.x; role < 256; role += gridDim.x) {
        const int ds = role & 7, eb = role >> 3;
        __syncthreads();
        TS_BEGIN(1);
#pragma unroll 8
        for (int idx = tid; idx < 512 * 32; idx += NTHREADS) {
            const int row = idx >> 5, c4 = idx & 31;
            const f32x4 v = *(const f32x4*)(P.in[I_U] + (size_t)(512 * eb + row) * DM + 128 * ds + 4 * c4);
            u32x2 o; o.x = pk2(v.x, v.y); o.y = pk2(v.z, v.w);
            *(LAS u32x2*)(tab + row * 128 + 4 * c4) = o;
        }
        __syncthreads();
        TS_END(1);
        TS_BEGIN(2);
        u32x4 ra[4], rb[4], hq[4], na[4], nb[4], nh[4];
#define U_LOAD(A_, B_, H_, IT_) do { _Pragma("unroll") for (int q = 0; q < 4; ++q) { const int t_ = g + 32 * (4 * (IT_) + q); const bf16_t* rp_ = SIDB + ((size_t)eb * NTOK + t_) * 16; \
            A_[q] = *(const u32x4*)rp_; B_[q] = *(const u32x4*)(rp_ + 8); H_[q] = *(const u32x4*)(H2S + ((size_t)ds * NTOK + t_) * 128 + 8 * l16); } } while (0)
        U_LOAD(ra, rb, hq, 0);
        U_LOAD(na, nb, nh, 1);
        for (int it = 0; it < 256; ++it) {
            u32x4 fa[4], fb[4], fh[4];
            const int itn = (it + 2 < 256) ? it + 2 : 255;
            if (variant != 2 && variant != 4 && variant != 5) U_LOAD(fa, fb, fh, itn);
            else {
#pragma unroll
                for (int q = 0; q < 4; ++q) { fa[q] = ra[q]; fb[q] = rb[q]; fh[q] = hq[q]; }
            }
            unsigned cnt[4], lo[4]; float myd[4];
            if (variant == 2) {
#pragma unroll
                for (int q = 0; q < 4; ++q) { const unsigned idb = (unsigned)((it * 37 + g * 11 + q * 5) & 511); ra[q].x = 4u | (idb << 16); ra[q].y = (idb + 7u) | ((idb + 13u) << 16); ra[q].z = (idb + 29u) | ((idb + 31u) << 16); }
            }
            if (variant == 4 || variant == 5) {
#pragma unroll
                for (int q = 0; q < 4; ++q) {
                    unsigned hsh = (unsigned)(it * 4 + q) * 2654435761u + (unsigned)g * 40503u + (unsigned)blockIdx.x * 97u; hsh ^= hsh >> 15; hsh *= 2246822519u; hsh ^= hsh >> 13;
                    const unsigned c = variant == 4 ? (unsigned)__builtin_popcount(hsh & 0xffu) : 4u;
                    unsigned h2 = hsh * 3266489917u; h2 ^= h2 >> 16;
                    ra[q].x = c | ((h2 & 511u) << 16); ra[q].y = ((h2 >> 9) & 511u) | (((h2 >> 18) & 511u) << 16);
                    unsigned h3 = h2 * 668265263u; h3 ^= h3 >> 15;
                    ra[q].z = (h3 & 511u) | (((h3 >> 9) & 511u) << 16); ra[q].w = ((h3 >> 18) & 511u) | (((h3 >> 23) & 511u) << 16);
                }
            }
            int nmq[4]; int nmax = 0;
#pragma unroll
            for (int q = 0; q < 4; ++q) {
                cnt[q] = ra[q].x & 0xffu; lo[q] = (ra[q].x >> 8) & 0xffu; myd[q] = 0.f;
                const int c0 = __builtin_amdgcn_readlane((int)cnt[q], 0), c1 = __builtin_amdgcn_readlane((int)cnt[q], 16), c2 = __builtin_amdgcn_readlane((int)cnt[q], 32), c3 = __builtin_amdgcn_readlane((int)cnt[q], 48);
                nmq[q] = max(max(c0, c1), max(c2, c3)); nmax = max(nmax, nmq[q]);
            }
#pragma unroll
            for (int j = 0; j < 15; ++j) {
                if (j < nmax && variant != 1) {
#pragma unroll
                    for (int q = 0; q < 4; ++q) {
                        if (j < nmq[q]) {
                            const unsigned w8[8] = {ra[q].x, ra[q].y, ra[q].z, ra[q].w, rb[q].x, rb[q].y, rb[q].z, rb[q].w};
                            const unsigned id = (w8[(j + 1) >> 1] >> (16 * ((j + 1) & 1))) & 0x1ffu;
                            const u32x4 u = *(const LAS u32x4*)(tab + id * 128 + 8 * l16);
                            float d = dot2bf(u.x, hq[q].x, 0.f); d = dot2bf(u.y, hq[q].y, d); d = dot2bf(u.z, hq[q].z, d); d = dot2bf(u.w, hq[q].w, d);
                            d = dpp_sum16(d);
                            myd[q] = (j == l16) ? d : myd[q];
                        }
                    }
                }
            }
#pragma unroll
            for (int q = 0; q < 4; ++q) {
                const int t = g + 32 * (4 * it + q);
                float* pp = PART + ((size_t)ds * NTOK + t) * 128 + lo[q];
                if ((unsigned)l16 < cnt[q] && l16 < 15) pp[l16] = myd[q];
            }
            if (nmax > 15) {
#pragma unroll
                for (int q = 0; q < 4; ++q) {
                    const int t = g + 32 * (4 * it + q);
                    float* pp = PART + ((size_t)ds * NTOK + t) * 128 + lo[q];
                    for (int j = 15; j < nmax; ++j) {
                        const bool act = (unsigned)j < cnt[q];
                        const unsigned id = act ? (unsigned)SID[(size_t)t * 128 + lo[q] + j] : 0u;
                        const u32x4 u = *(const LAS u32x4*)(tab + (id & 511u) * 128 + 8 * l16);
                        float d = dot2bf(u.x, hq[q].x, 0.f); d = dot2bf(u.y, hq[q].y, d); d = dot2bf(u.z, hq[q].z, d); d = dot2bf(u.w, hq[q].w, d);
                        d = dpp_sum16(d);
                        if (act && l16 == 0) pp[j] = d;
                    }
                }
            }
#pragma unroll
            for (int q = 0; q < 4; ++q) { ra[q] = na[q]; rb[q] = nb[q]; hq[q] = nh[q]; na[q] = fa[q]; nb[q] = fb[q]; nh[q] = fh[q]; }
        }
#undef U_LOAD
        TS_END(2);
    }
}

DI void phase9(const Params& P, LAS unsigned char* lds) {
    const int tid = threadIdx.x;
    LAS unsigned* stage = (LAS unsigned*)lds;
    const float* PART = (const float*)(P.ws + WS_PART); const float* SWT = (const float*)(P.ws + WS_SWT); const bf16_t* SID = (const bf16_t*)(P.ws + WS_SID);
    unsigned* CIT = (unsigned*)(P.ws + WS_CIT);
    for (int tile = blockIdx.x; tile < 512; tile += gridDim.x) {
        const int t0 = tile * 64;
        __syncthreads();
#pragma unroll 4
        for (int it = 0; it < 16; ++it) {
            const int tl = (tid >> 7) + 4 * it, s = tid & 127; const size_t pi = (size_t)(t0 + tl) * 128 + s;
            float act = 0.f;
#pragma unroll
            for (int d = 0; d < 8; ++d) act += PART[(size_t)d * NTOK * 128 + pi];
            const float coef = SWT[pi] * gelu_erf(act);
            stage[tl * 132 + s] = ((unsigned)SID[pi] << 16) | (unsigned)f2bf(coef);
        }
        __syncthreads();
        {
            const int sg = tid >> 4, tq = (tid & 15) * 4;
#pragma unroll
            for (int q = 0; q < 4; ++q) *(u32x4*)(CIT + ((size_t)sg * NTOK + t0 + tq + q) * 4) = *(const LAS u32x4*)(stage + (tq + q) * 132 + sg * 4);
        }
    }
}

DI void phase10(const Params& P, LAS unsigned char* lds) {
    const int tid = threadIdx.x, lane = tid & 63, wave = tid >> 6;
    LAS unsigned char* tab = lds;
    const unsigned* CIT = (const unsigned*)(P.ws + WS_CIT);
    float* POUT = (float*)(P.ws + WS_POUT);
    for (int role = blockIdx.x; role < 256; role += gridDim.x) {
        const int c = (role & 7) * 32 + (role >> 3);
        __syncthreads();
#pragma unroll 8
        for (int e = tid; e < 16384; e += NTHREADS) {
            const f32x4 v = *(const f32x4*)(P.in[I_V] + (size_t)e * DM + 4 * c);
            u32x2 o; o.x = pk2(v.x, v.y); o.y = pk2(v.z, v.w);
            *(LAS u32x2*)(tab + e * 8) = o;
        }
        __syncthreads();
        for (int grp = wave; grp < 512; grp += NWAVES) {
            const int t = grp * 64 + lane;
            float a0 = 0.f, a1 = 0.f, a2 = 0.f, a3 = 0.f;
#pragma unroll 8
            for (int sg = 0; sg < 32; ++sg) {
                const u32x4 c4 = *(const u32x4*)(CIT + ((size_t)sg * NTOK + t) * 4);
                const unsigned cw[4] = {c4.x, c4.y, c4.z, c4.w};
#pragma unroll
                for (int q = 0; q < 4; ++q) {
                    const float coef = __uint_as_float(cw[q] << 16);
                    const u32x2 v = *(const LAS u32x2*)(tab + (cw[q] >> 16) * 8);
                    a0 += coef * bflo(v.x); a1 += coef * bfhi(v.x); a2 += coef * bflo(v.y); a3 += coef * bfhi(v.y);
                }
            }
            *(f32x4*)(POUT + ((size_t)(c >> 5) * NTOK + t) * 128 + 4 * (c & 31)) = (f32x4){a0, a1, a2, a3};
        }
    }
}

DI void phase11(const Params& P) {
    const int lane = threadIdx.x & 63, wave = threadIdx.x >> 6;
    const int gw = blockIdx.x * NWAVES + wave, NGW = gridDim.x * NWAVES;
    const float* MOD = (const float*)(P.ws + WS_MOD);
    const float* POUT = (const float*)(P.ws + WS_POUT);
    for (int t = gw; t < NTOK; t += NGW) {
        const int b = t >> 11; const float* m = MOD + (size_t)b * 6144;
        f32x4 acc[4]; float ss = 0.f;
#pragma unroll
        for (int j = 0; j < 4; ++j) { acc[j] = *(const f32x4*)(POUT + ((size_t)(2 * j + (lane >> 5)) * NTOK + t) * 128 + 4 * (lane & 31)); ss += (acc[j].x * acc[j].x + acc[j].y * acc[j].y) + (acc[j].z * acc[j].z + acc[j].w * acc[j].w); }
        const float rstd = rsqrtf(wave_sum(ss) * (1.0f / DM) + EPSV);
#pragma unroll
        for (int j = 0; j < 4; ++j) {
            const f32x4 gn = ((const f32x4*)P.in[I_NPOSTFFN])[64 * j + lane], g2 = ((const f32x4*)(m + 5120))[64 * j + lane];
            f32x4* op = (f32x4*)(P.out + (size_t)t * DM) + 64 * j + lane;
            *op = *op + g2 * (acc[j] * rstd * gn);
        }
    }
}

template <int PLO, int PHI> __global__ void __launch_bounds__(NTHREADS, 2) fwd_megakernel(Params P) {
    extern __shared__ __attribute__((aligned(16))) unsigned char lds_raw[];
    LAS unsigned char* lds = (LAS unsigned char*)lds_raw;
    cg::grid_group grid = cg::this_grid();
    volatile LAS unsigned* xst = (volatile LAS unsigned*)(lds + LDS_BYTES - 16);
    if (threadIdx.x == 0) { xst[0] = 0u; xst[1] = 0u; }
    __syncthreads();
    XcdBarrier xbar = xcd_barrier_post((unsigned*)P.ws + (PLO > 0 ? 4096 : 0), xst);
    unsigned char* ws = P.ws;
    const int lo = P.ph_lo, hi = P.ph_hi;
    if (TIMESEC && PLO > 0 && blockIdx.x == 0 && threadIdx.x == 0) ((volatile unsigned long long*)(P.ws + 32768))[1] = 0ull;
#define IN(k) (PLO <= (k) && (k) < PHI && lo <= (k) && (k) < hi)
#define SEAM(k) do { if (IN(k) && IN((k) + 1)) { if ((k) == PLO) grid.sync(); else xcd_barrier(xbar); } } while (0)
#define RUN(k, ...) do { if (IN(k)) { __VA_ARGS__; } SEAM(k); } while (0)
    RUN(0, phase0(P, lds));
    RUN(1, phase1(P));
    RUN(2, {
        run_gemm(lds, (const bf16_t*)(ws + WS_HC), (const bf16_t*)(ws + WS_WIN) + (size_t)512 * 1024, NCTX, 1024, 1024, FPlain{(bf16_t*)(ws + WS_CKV), 1024});
        run_gemm(lds, (const bf16_t*)(ws + WS_HX), (const bf16_t*)(ws + WS_WIN), NTOK, 2048, 1024, FQkvg{(bf16_t*)(ws + WS_QKVG), (const float*)(ws + WS_ROPE), (const float*)(ws + WS_ROPE) + 2048 * 32});
        run_gemm(lds, (const bf16_t*)(ws + WS_WF), (const bf16_t*)(ws + WS_HX), 1024, NTOK, 1024, FFnetT{(bf16_t*)(ws + WS_FT)});
    });
    RUN(3, {
        run_gemm(lds, (const bf16_t*)(ws + WS_DFT), (const bf16_t*)(ws + WS_FT), 2048, 8192, 4096, FFnetOut{(bf16_t*)(ws + WS_MIX)});
        for (int item = blockIdx.x; item < 256; item += gridDim.x) retention_item(P, lds, item);
    });
    RUN(4, {
        pg8::Gemm g{(const bf16_t*)(ws + WS_MIX), (const bf16_t*)(ws + WS_WOUT), NTOK, 1024, 1024}; pg8::StaticOrder S; S.init(NTOK, 1024, (int)gridDim.x, (int)blockIdx.x);
        pg8::EpiF32 E{(float*)(ws + WS_QKVG), 1024};
        pg8::gemm_phase<pg8::EpiF32, pg8::StaticOrder>(lds, g, S, E);
    });
    RUN(5, phase5(P));
    RUN(6, run_gemm(lds, (const bf16_t*)(ws + WS_HX), (const bf16_t*)(ws + WS_WQ), NTOK, 2048, 1024, FPlain{(bf16_t*)(ws + WS_FT), 2048}));
    RUN(7, phase7(P, lds));
    RUN(8, phase8<0>(P, lds, (float*)(ws + WS_PART)));
    if (TIMESEC == 3 && SPLITK > 0 && IN(8)) { grid.sync(); TS_BEGIN(3); phase8<VARIANT>(P, lds, (float*)(ws + WS_POUT)); TS_END(3); grid.sync(); }
    RUN(9, phase9(P, lds));
    RUN(10, phase10(P, lds));
    if (IN(11)) phase11(P);
    if (TIMESEC && PLO > 0 && PHI == 12 && blockIdx.x == 0 && threadIdx.x == 0) {
        const unsigned long long dt = ((volatile unsigned long long*)(P.ws + 32768))[1] * TSK, t0 = __builtin_amdgcn_s_memrealtime();
        while (__builtin_amdgcn_s_memrealtime() - t0 < dt) __builtin_amdgcn_s_sleep(16);
    }
#undef RUN
#undef IN
#undef SEAM
}

template <int PLO, int PHI> static hipError_t launch_range(const Params& p0, int lo, int hi, int variant, int grid, hipStream_t stream) {
    Params p = p0; p.ph_lo = lo; p.ph_hi = hi; p.variant = variant;
    void* args[] = {&p};
    return hipLaunchCooperativeKernel((const void*)fwd_megakernel<PLO, PHI>, dim3(grid), dim3(NTHREADS), args, LDS_BYTES, stream);
}
extern "C" void kernel_launch(void* const* d_in, const int* in_sizes, int n_in, void* d_out, int out_size, void* d_ws, size_t ws_size, hipStream_t stream) {
    static int grid = 0;
    if (grid == 0) {
        int dev = 0, cus = 0;
        (void)hipGetDevice(&dev);
        (void)hipDeviceGetAttribute(&cus, hipDeviceAttributeMultiprocessorCount, dev);
        if (SPLITK == 0) (void)hipFuncSetAttribute((const void*)fwd_megakernel<0, (SPLITK > 0 ? SPLITK : 12)>, hipFuncAttributeMaxDynamicSharedMemorySize, LDS_BYTES);
        if (SPLITK > 0) {
            (void)hipFuncSetAttribute((const void*)fwd_megakernel<0, (SPLITK > 0 ? SPLITK : 12)>, hipFuncAttributeMaxDynamicSharedMemorySize, LDS_BYTES);
            (void)hipFuncSetAttribute((const void*)fwd_megakernel<(SPLITK > 0 ? SPLITK : 0), 12>, hipFuncAttributeMaxDynamicSharedMemorySize, LDS_BYTES);
        }
        grid = cus;
        if (ws_size < WS_END || n_in != 20) fprintf(stderr, "kernel_launch: unexpected ws_size %zu / n_in %d\n", ws_size, n_in);
        (void)hipGetLastError();
    }
    Params p{};
    for (int i = 0; i < 20; ++i) p.in[i] = (const float*)d_in[i];
    p.out = (float*)d_out; p.ws = (unsigned char*)d_ws;
    hipError_t e = hipMemsetAsync(d_ws, 0, 32768, stream);
    if (e != hipSuccess) fprintf(stderr, "memset failed\n");
    if (SPLITK > 0) {
        e = launch_range<0, (SPLITK > 0 ? SPLITK : 12)>(p, 0, 12, 0, grid, stream);
        if (e == hipSuccess) e = launch_range<(SPLITK > 0 ? SPLITK : 0), 12>(p, 0, 12, 0, grid, stream);
    } else if (DUPK >= 0) {
        e = launch_range<0, (SPLITK > 0 ? SPLITK : 12)>(p, 0, DUPK + 1, 0, grid, stream);
        if (e == hipSuccess) e = launch_range<0, (SPLITK > 0 ? SPLITK : 12)>(p, DUPK, 12, VARIANT, grid, stream);
    } else {
        e = launch_range<0, (SPLITK > 0 ? SPLITK : 12)>(p, 0, 12, 0, grid, stream);
    }
    if (e != hipSuccess) fprintf(stderr, "cooperative launch failed: %s (grid %d)\n", hipGetErrorString(e), grid);
}
```

```cpp
#include <hip/hip_runtime.h>
#include <hip/hip_cooperative_groups.h>
#include <cstdio>
namespace cg = cooperative_groups;
#define VARIANT 0
#define SPLITK 0
#define TIMESEC 0
#define TSK 20
#define TS_BEGIN(id) do { if (TIMESEC == (id) && SPLITK > 0 && blockIdx.x == 0 && threadIdx.x == 0) ((volatile unsigned long long*)(P.ws + 32768))[0] = __builtin_amdgcn_s_memrealtime(); } while (0)
#define TS_END(id) do { if (TIMESEC == (id) && SPLITK > 0 && blockIdx.x == 0 && threadIdx.x == 0) { volatile unsigned long long* _p = (volatile unsigned long long*)(P.ws + 32768); _p[1] = _p[1] + (__builtin_amdgcn_s_memrealtime() - _p[0]); } } while (0)
#define DUPK -1

#define DI __device__ __forceinline__
#define LAS __attribute__((address_space(3)))
typedef unsigned short bf16_t;
typedef short bf16x8 __attribute__((ext_vector_type(8)));
typedef float f32x4 __attribute__((ext_vector_type(4)));
typedef float f32x16 __attribute__((ext_vector_type(16)));
typedef unsigned u32x4 __attribute__((ext_vector_type(4)));
typedef unsigned u32x2 __attribute__((ext_vector_type(2)));

constexpr int NB = 16, SEQ = 2048, DM = 1024, NTOK = NB * SEQ, CTXL = 256, NCTX = NB * CTXL;
constexpr int INW = 2560, F_OFF = 2048;
constexpr float EPSV = 1e-6f;
constexpr int NTHREADS = 512, NWAVES = 8;
constexpr int LDS_BYTES = 160 * 1024;

constexpr size_t MB = 1024 * 1024;
constexpr size_t WS_MOD = 64 * 1024;
constexpr size_t WS_ROPE = 512 * 1024;
constexpr size_t WS_KEYS = 1 * MB;
constexpr size_t WS_WIN = 2 * MB;
constexpr size_t WS_WF = 6 * MB;
constexpr size_t WS_WOUT = 8 * MB;
constexpr size_t WS_WQ = 10 * MB;
constexpr size_t WS_DFT = 14 * MB;
constexpr size_t WS_HC = 30 * MB;
constexpr size_t WS_CKV = 38 * MB;
constexpr size_t WS_IDS = 46 * MB;
constexpr size_t WS_WTS = 62 * MB;
constexpr size_t WS_HX = 80 * MB;
constexpr size_t WS_QKVG = 144 * MB;
constexpr size_t WS_FT = 272 * MB;
constexpr size_t WS_MIX = 336 * MB;
constexpr size_t WS_SB = 400 * MB;
constexpr size_t WS_H2S = 416 * MB;
constexpr size_t WS_END = 480 * MB;
constexpr size_t WS_SID = 30 * MB;
constexpr size_t WS_SIDB = 46 * MB;
constexpr size_t WS_SWT = 400 * MB;
constexpr size_t WS_CIT = 14 * MB;
constexpr size_t WS_PART = 144 * MB;
constexpr size_t WS_POUT = 272 * MB;

namespace pg8 {
#define PG8_LAS __attribute__((address_space(3)))
constexpr int BM = 256, BK = 64, HALF = 128, HTB = HALF * BK * 2, STAGE_BYTES = 8 * HTB, NXCD = 8, WGM = 8;
__host__ __device__ __forceinline__ int lds_byte(int r, int c) { const int st = (r >> 4) * 2 + (c >> 5), rr = r & 15, cc = c & 31, ob = rr * 64 + cc * 2; return st * 1024 + (ob ^ (((ob >> 9) & 1) << 5)); }
__host__ __device__ __forceinline__ void stage_rc(int b, int& R, int& C) { const int st = b / 1024, sb = b % 1024, swz = sb ^ (((sb >> 9) & 1) << 5); R = (st >> 1) * 16 + swz / 64; C = (st & 1) * 32 + (swz % 64) / 2; }
__host__ __device__ __forceinline__ int perm32(int rho) { const int n = rho >> 4, i = rho & 15; return 8 * (i >> 2) + 4 * n + (i & 3); }
struct Unit { int pm, pn; };
struct Gemm { const bf16_t* A; const bf16_t* Bt; int M, N, K; };
struct StaticOrder {
    int nM, nN, nwg, G, c;
    __host__ __device__ void init(int M, int N, int G_, int c_) { nM = M / BM; nN = N / BM; nwg = nM * nN; G = G_; c = c_; }
    __host__ __device__ bool next(int i, Unit& u) const {
        const long L = (long)i * G + c; if (L >= nwg) return false;
        int wgid = (int)L; { const int q = nwg / NXCD, r = nwg % NXCD, xcd = wgid % NXCD, off = wgid / NXCD; wgid = (xcd < r ? xcd * (q + 1) : r * (q + 1) + (xcd - r) * q) + off; }
        const int nig = WGM * nN, gid = wgid / nig, fm = gid * WGM, gsz = (nM - fm) < WGM ? (nM - fm) : WGM;
        u.pm = fm + ((wgid % nig) % gsz); u.pn = (wgid % nig) / gsz; return true;
    }
    __device__ __forceinline__ void a_ready(const Unit&) const {}
    __device__ __forceinline__ void done(const Unit&) const {}
};
__device__ __forceinline__ unsigned cvt_pk_bf16(float lo, float hi) { unsigned r; asm volatile("v_cvt_pk_bf16_f32 %0, %1, %2" : "=v"(r) : "v"(lo), "v"(hi)); return r; }

struct EpiF32 {
    static constexpr bool PERM = false;
    float* C; int ldc;
    __device__ __forceinline__ void operator()(const f32x4 (&acc)[2][2][4][2], const Unit& u, int wr, int wc, int fr, int fq) const {
        const int row0 = u.pm * BM + wr * 64 + fr, col0 = u.pn * BM + wc * 32 + 4 * fq;
#pragma unroll
        for (int ai = 0; ai < 2; ++ai)
#pragma unroll
            for (int m = 0; m < 4; ++m) { float* rowp = C + (size_t)(row0 + ai * HALF + m * 16) * ldc + col0;
#pragma unroll
                for (int bj = 0; bj < 2; ++bj)
#pragma unroll
                    for (int n = 0; n < 2; ++n) *(f32x4*)(rowp + bj * HALF + n * 16) = acc[ai][bj][m][n]; }
    }
};
template <class F> struct EpiBf16F {
    static constexpr bool PERM = true;
    F f;
    __device__ __forceinline__ void operator()(const f32x4 (&acc)[2][2][4][2], const Unit& u, int wr, int wc, int fr, int fq) const {
        const int row0 = u.pm * BM + wr * 64 + fr, col0 = u.pn * BM + wc * 32 + 8 * fq;
#pragma unroll
        for (int ai = 0; ai < 2; ++ai)
#pragma unroll
            for (int m = 0; m < 4; ++m)
#pragma unroll
                for (int bj = 0; bj < 2; ++bj) f(row0 + ai * HALF + m * 16, col0 + bj * HALF, acc[ai][bj][m][0], acc[ai][bj][m][1]);
    }
};

template <class Epi, class Sched>
__device__ __forceinline__ void gemm_phase(PG8_LAS unsigned char* lds, const Gemm g, const Sched& S, const Epi& E) {
    const int tid = threadIdx.x, wid = __builtin_amdgcn_readfirstlane(tid >> 6), lane = tid & 63, wr = wid >> 2, wc = wid & 3, fr = lane & 15, fq = lane >> 4;
    const int K = g.K, nt = K / BK;
    unsigned voffA[2], voffB[2];
#pragma unroll
    for (int i = 0; i < 2; ++i) { int R, C; stage_rc(tid * 16 + i * 8192, R, C); const int Rb = Epi::PERM ? ((R & ~31) + perm32(R & 31)) : R;
        voffA[i] = (unsigned)(R * K + C) * 2u; voffB[i] = (unsigned)(Rb * K + C) * 2u; }
    const size_t kstep = (size_t)(BK * 2);
    const size_t hstep = (size_t)HALF * K * 2;
    const size_t tstep = 2 * hstep;
    const unsigned ldsw = (unsigned)wid * 1024u;
    const int aoff = lds_byte(wr * 64 + fr, fq * 8), boff = lds_byte(wc * 32 + fr, fq * 8);
#define PG8_SA(b, h) (((b) * 2 + (h)) * HTB)
#define PG8_SB(b, h) ((4 + (b) * 2 + (h)) * HTB)
#define PG8_STAGE(bufoff, gbase, voff) do { _Pragma("unroll") for (int _i = 0; _i < 2; ++_i) \
        __builtin_amdgcn_global_load_lds((const unsigned*)((const char*)(gbase) + (voff)[_i]), (PG8_LAS unsigned*)(lds + (bufoff) + ldsw + _i * 8192), 16, 0, 0); } while (0)
#define PG8_LDA(dst, b, h) do { _Pragma("unroll") for (int m = 0; m < 4; ++m) _Pragma("unroll") for (int k = 0; k < 2; ++k) dst[m][k] = *(const PG8_LAS bf16x8*)(lds + PG8_SA(b, h) + aoff + m * 2048 + k * 1024); } while (0)
#define PG8_LDB(dst, b, h) do { _Pragma("unroll") for (int n = 0; n < 2; ++n) _Pragma("unroll") for (int k = 0; k < 2; ++k) dst[n][k] = *(const PG8_LAS bf16x8*)(lds + PG8_SB(b, h) + boff + n * 2048 + k * 1024); } while (0)
#define PG8_MMA(ai, bj, At, Bt) do { __builtin_amdgcn_s_setprio(1); _Pragma("unroll") for (int m = 0; m < 4; ++m) _Pragma("unroll") for (int n = 0; n < 2; ++n) _Pragma("unroll") for (int k = 0; k < 2; ++k) \
        acc[ai][bj][m][n] = __builtin_amdgcn_mfma_f32_16x16x32_bf16(Bt[n][k], At[m][k], acc[ai][bj][m][n], 0, 0, 0); __builtin_amdgcn_s_setprio(0); } while (0)
#define PG8_WAIT_V(n) asm volatile("s_waitcnt vmcnt(" #n ")" ::: "memory")
#define PG8_WAIT_L(n) asm volatile("s_waitcnt lgkmcnt(" #n ")" ::: "memory")
#define PG8_BAR __builtin_amdgcn_s_barrier()
#define PG8_SCHED __builtin_amdgcn_sched_barrier(0)
    Unit cur, nxt; int ui = 0;
    if (!S.next(0, cur)) return;
    f32x4 acc[2][2][4][2];
#pragma unroll
    for (int a = 0; a < 2; ++a)
#pragma unroll
        for (int b = 0; b < 2; ++b)
#pragma unroll
            for (int m = 0; m < 4; ++m)
#pragma unroll
                for (int n = 0; n < 2; ++n) acc[a][b][m][n] = (f32x4){0.f, 0.f, 0.f, 0.f};
    bf16x8 At[4][2], B0[2][2], B1[2][2];
    const char* cA = (const char*)g.A + (size_t)cur.pm * tstep; const char* cB = (const char*)g.Bt + (size_t)cur.pn * tstep;
    S.a_ready(cur);
    PG8_STAGE(PG8_SB(0, 0), cB, voffB); PG8_STAGE(PG8_SA(0, 0), cA, voffA); PG8_STAGE(PG8_SB(0, 1), cB + hstep, voffB); PG8_STAGE(PG8_SA(0, 1), cA + hstep, voffA);
    if (wr == 1) PG8_BAR;
    PG8_WAIT_V(4); PG8_BAR;
    PG8_STAGE(PG8_SB(1, 0), cB + kstep, voffB); PG8_STAGE(PG8_SA(1, 0), cA + kstep, voffA); PG8_STAGE(PG8_SB(1, 1), cB + hstep + kstep, voffB);
    PG8_WAIT_V(6); PG8_BAR;
    for (;;) {
        const bool has_next = S.next(ui + 1, nxt);
        const char* nA = has_next ? (const char*)g.A + (size_t)nxt.pm * tstep : cA; const char* nB = has_next ? (const char*)g.Bt + (size_t)nxt.pn * tstep : cB;
        for (int t = 0; t < nt; t += 2) {
            const bool last = (t == nt - 2);
            const char* a1 = cA + (size_t)(t + 1) * kstep;
            const char* a2 = last ? nA : cA + (size_t)(t + 2) * kstep; const char* b2 = last ? nB : cB + (size_t)(t + 2) * kstep;
            const char* a3 = a2 + kstep; const char* b3 = b2 + kstep;
            if (last && has_next) S.a_ready(nxt);
            PG8_LDB(B0, 0, 0); PG8_SCHED; PG8_LDA(At, 0, 0); PG8_STAGE(PG8_SA(1, 1), a1 + hstep, voffA);
            PG8_WAIT_L(8); PG8_BAR; PG8_WAIT_L(0); PG8_MMA(0, 0, At, B0); PG8_BAR; PG8_SCHED;
            PG8_LDB(B1, 0, 1); PG8_STAGE(PG8_SB(0, 0), b2, voffB);
            PG8_BAR; PG8_WAIT_L(0); PG8_MMA(0, 1, At, B1); PG8_BAR;
            PG8_LDA(At, 0, 1); PG8_STAGE(PG8_SA(0, 0), a2, voffA);
            PG8_BAR; PG8_WAIT_L(0); PG8_MMA(1, 0, At, B0); PG8_BAR; PG8_SCHED;
            PG8_STAGE(PG8_SB(0, 1), b2 + hstep, voffB);
            PG8_WAIT_V(6); PG8_BAR; PG8_MMA(1, 1, At, B1); PG8_BAR;
            PG8_LDB(B0, 1, 0); PG8_SCHED; PG8_LDA(At, 1, 0); PG8_STAGE(PG8_SA(0, 1), a2 + hstep, voffA);
            PG8_WAIT_L(8); PG8_BAR; PG8_WAIT_L(0); PG8_MMA(0, 0, At, B0); PG8_BAR; PG8_SCHED;
            PG8_LDB(B1, 1, 1); PG8_STAGE(PG8_SB(1, 0), b3, voffB);
            PG8_BAR; PG8_WAIT_L(0); PG8_MMA(0, 1, At, B1); PG8_BAR;
            PG8_LDA(At, 1, 1); PG8_STAGE(PG8_SA(1, 0), a3, voffA);
            PG8_BAR; PG8_WAIT_L(0); PG8_MMA(1, 0, At, B0); PG8_BAR; PG8_SCHED;
            PG8_STAGE(PG8_SB(1, 1), b3 + hstep, voffB);
            PG8_WAIT_V(6); PG8_BAR; PG8_MMA(1, 1, At, B1); PG8_BAR;
        }
        E(acc, cur, wr, wc, fr, fq); S.done(cur);
        if (!has_next) break;
#pragma unroll
        for (int a = 0; a < 2; ++a)
#pragma unroll
            for (int b = 0; b < 2; ++b)
#pragma unroll
                for (int m = 0; m < 4; ++m)
#pragma unroll
                    for (int n = 0; n < 2; ++n) acc[a][b][m][n] = (f32x4){0.f, 0.f, 0.f, 0.f};
        cur = nxt; cA = nA; cB = nB; ++ui;
    }
    PG8_WAIT_V(0);
    if (wr == 0) PG8_BAR;
    PG8_BAR;
#undef PG8_SA
#undef PG8_SB
#undef PG8_STAGE
#undef PG8_LDA
#undef PG8_LDB
#undef PG8_MMA
#undef PG8_WAIT_V
#undef PG8_WAIT_L
#undef PG8_BAR
#undef PG8_SCHED
}
}

DI unsigned pk2(float lo, float hi) { return pg8::cvt_pk_bf16(lo, hi); }
DI bf16_t f2bf(float f) { return (bf16_t)(pk2(f, 0.f) & 0xffffu); }
DI float bf2f(bf16_t b) { return __uint_as_float(((unsigned)b) << 16); }
DI float bflo(unsigned w) { return __uint_as_float(w << 16); }
DI float bfhi(unsigned w) { return __uint_as_float(w & 0xffff0000u); }
DI float wave_sum(float v) {
#pragma unroll
    for (int o = 1; o < 64; o <<= 1) v += __shfl_xor(v, o);
    return v;
}
DI float siluf(float x) { return x / (1.f + __expf(-x)); }
DI float gelu_erf(float a) { return 0.5f * a * (1.f + erff(a * 0.70710678118654752f)); }
#define LDS_WAIT() asm volatile("s_waitcnt lgkmcnt(0)" ::: "memory")
#define MFMA32(a, b, c) __builtin_amdgcn_mfma_f32_32x32x16_bf16((a), (b), (c), 0, 0, 0)
DI int crow(int reg, int h) { return (reg & 3) + 8 * (reg >> 2) + 4 * h; }
DI f32x16 zero16() { f32x16 z;
#pragma unroll
    for (int i = 0; i < 16; ++i) z[i] = 0.f;
    return z; }


#define XB_TMO      128
#define XB_XCNT(j)  (256  + 64 * (j))
#define XB_XSUB(j)  (1280 + 64 * (j))
#define XB_XGEN(j)  (2304 + 64 * (j))
#define XB_TOP      3328
#define XB_TOPGEN   3392
#define XCD_BAR_WORDS 3456
#define XB_SPIN_CAP (1u << 22)
DI unsigned xb_ld(unsigned* p)              { return __hip_atomic_load(p, __ATOMIC_RELAXED, __HIP_MEMORY_SCOPE_AGENT); }
DI unsigned xb_add(unsigned* p, unsigned v) { return __hip_atomic_fetch_add(p, v, __ATOMIC_RELAXED, __HIP_MEMORY_SCOPE_AGENT); }
DI unsigned xb_xcc_id() { return (unsigned)__builtin_amdgcn_s_getreg((3 << 11) | 20) & 0xFu; }
#define XB_SPIN(cond, bar) do { unsigned _sp = 0; while (cond) { __builtin_amdgcn_s_sleep(1); \
    if ((++_sp & 255u) == 0u) { if (xb_ld(&(bar)[XB_TMO])) break; if (_sp > XB_SPIN_CAP) { atomicAdd(&(bar)[XB_TMO], 1u); break; } } } } while (0)
struct XcdBarrier { unsigned* bar; unsigned x; volatile LAS unsigned* st; };
DI XcdBarrier xcd_barrier_post(unsigned* bar, volatile LAS unsigned* st) {
    XcdBarrier b; b.bar = bar; b.x = xb_xcc_id(); b.st = st;
    if (threadIdx.x == 0) (void)xb_add(&bar[XB_XCNT(b.x)], 1u);
    return b;
}
DI void xcd_barrier_complete(unsigned* bar, unsigned x, unsigned& nloc, unsigned& nx) {
    const unsigned G = gridDim.x * gridDim.y * gridDim.z;
    unsigned sum, cnt, mine, sp = 0u;
    for (;;) {
        sum = 0u; cnt = 0u; mine = 0u;
#pragma unroll
        for (unsigned j = 0; j < 16; ++j) { const unsigned c = xb_ld(&bar[XB_XCNT(j)]); sum += c; cnt += (c > 0u) ? 1u : 0u; mine = (j == x) ? c : mine; }
        if (sum == G) break;
        __builtin_amdgcn_s_sleep(1);
        if ((++sp & 255u) == 0u) { if (xb_ld(&bar[XB_TMO])) break; if (sp > XB_SPIN_CAP) { atomicAdd(&bar[XB_TMO], 1u); break; } }
    }
    nloc = mine > 0u ? mine : 1u; nx = cnt > 0u ? cnt : 1u;
}
DI void xcd_barrier(const XcdBarrier& b) {
    asm volatile("s_waitcnt vmcnt(0)" ::: "memory");
    __syncthreads();
    if (threadIdx.x == 0) {
        unsigned* bar = b.bar;
        __builtin_amdgcn_s_waitcnt(0);
        unsigned nloc = b.st[0], nx = b.st[1];
        if (nloc == 0u) { xcd_barrier_complete(bar, b.x, nloc, nx); b.st[0] = nloc; b.st[1] = nx; }
        const unsigned old = xb_add(&bar[XB_XSUB(b.x)], 1u);
        const unsigned gen = old / nloc;
        if (old + 1u == (gen + 1u) * nloc) {
            __builtin_amdgcn_fence(__ATOMIC_RELEASE, "agent");
            asm volatile("s_waitcnt vmcnt(0)" ::: "memory");
            const unsigned og = xb_add(&bar[XB_TOP], 1u);
            const unsigned tg = og / nx;
            if (og + 1u == (tg + 1u) * nx) xb_add(&bar[XB_TOPGEN], 1u);
            else XB_SPIN(xb_ld(&bar[XB_TOPGEN]) == tg, bar);
            __builtin_amdgcn_fence(__ATOMIC_ACQUIRE, "agent");
            xb_add(&bar[XB_XGEN(b.x)], 1u);
            asm volatile("s_waitcnt vmcnt(0)" ::: "memory");
        } else {
            XB_SPIN(xb_ld(&bar[XB_XGEN(b.x)]) == gen, bar);
            __builtin_amdgcn_fence(__ATOMIC_ACQUIRE, "agent");
            asm volatile("s_waitcnt vmcnt(0)" ::: "memory");
        }
    }
    __syncthreads();
}

struct Params { const float* in[20]; float* out; unsigned char* ws; int ph_lo, ph_hi, variant, pad; };
enum { I_X = 0, I_C, I_CTX, I_CCTX, I_WADA, I_BADA, I_NPREMIX, I_NPOSTMIX, I_WIN, I_DECF, I_DECB, I_RETGAIN, I_WOUT, I_NPREFFN, I_NPOSTFFN, I_WQ, I_KEYS1, I_KEYS2, I_U, I_V };

DI int win_srccol(int n) { if (n < 1024) { const int p = n & 63; return (n & ~63) + (p >> 1) + 32 * (p & 1); } return n; }
DI void p0_transpose_item(const float* W, int ldw, int nout, bf16_t* WT, int mode, LAS float* scr, int item, int lane) {
    const int nblk = nout / 32, kb = item / nblk, nb = item % nblk, k0 = 64 * kb, n0 = 32 * nb;
    const int nn = n0 + (lane & 31);
    const int sc = mode ? win_srccol(nn) : nn;
    const float scale = (mode && nn >= 512 && nn < 1024) ? 0.125f : 1.0f;
#pragma unroll 8
    for (int i = 0; i < 32; ++i) { const int kk = 2 * i + (lane >> 5); scr[kk * 33 + (lane & 31)] = W[(size_t)(k0 + kk) * ldw + sc] * scale; }
    LDS_WAIT();
    const int c = lane & 7;
#pragma unroll
    for (int j = 0; j < 4; ++j) { const int n = (lane >> 3) + 8 * j; const LAS float* s = scr + (8 * c) * 33 + n;
        u32x4 o; o.x = pk2(s[0 * 33], s[1 * 33]); o.y = pk2(s[2 * 33], s[3 * 33]); o.z = pk2(s[4 * 33], s[5 * 33]); o.w = pk2(s[6 * 33], s[7 * 33]);
        *(u32x4*)(WT + (size_t)(n0 + n) * 1024 + k0 + 8 * c) = o; }
    LDS_WAIT();
}

DI void phase0(const Params& P, LAS unsigned char* lds) {
    const int tid = threadIdx.x, lane = tid & 63, wave = tid >> 6;
    const int gw = blockIdx.x * NWAVES + wave, NGW = gridDim.x * NWAVES;
    const int gt = blockIdx.x * NTHREADS + tid, NGT = gridDim.x * NTHREADS;
    unsigned char* ws = P.ws;
    LAS float* scr = (LAS float*)(lds + wave * 8704);
    LAS float* ctab = (LAS float*)(lds + 69632);
    LAS float* stab = ctab + 128;
    LAS float* svec = (LAS float*)(lds + 71680);
    if (tid < 128) { float s, c; sincospif((float)tid * (1.0f / 64.0f), &s, &c); ctab[tid] = c; stab[tid] = s; }
    for (int i = tid; i < 17 * 1024; i += NTHREADS) { const float v = (i < 16384) ? P.in[I_C][i] : P.in[I_CCTX][i - 16384]; svec[i] = siluf(v); }
    __syncthreads();
    {
        bf16_t* WIN = (bf16_t*)(ws + WS_WIN); bf16_t* WOUT = (bf16_t*)(ws + WS_WOUT); bf16_t* WQ = (bf16_t*)(ws + WS_WQ);
        constexpr int I1 = 16 * 64, I2 = 16 * 32, I3 = 16 * 64;
        for (int it = gw; it < I1 + I2 + I3; it += NGW) {
            int r = it;
            if (r < I1) { p0_transpose_item(P.in[I_WIN], INW, 2048, WIN, 1, scr, r, lane); continue; } r -= I1;
            if (r < I2) { p0_transpose_item(P.in[I_WOUT], 1024, 1024, WOUT, 0, scr, r, lane); continue; } r -= I2;
            p0_transpose_item(P.in[I_WQ], 2048, 2048, WQ, 0, scr, r, lane);
        }
    }
    {
        bf16_t* WF = (bf16_t*)(ws + WS_WF);
        for (int it = gw; it < 4096; it += NGW) {
            const int kk = it >> 2, g = it & 3;
            const float* src = P.in[I_WIN] + (size_t)kk * INW + F_OFF + g * 128;
            scr[lane] = src[lane]; scr[lane + 64] = src[lane + 64];
            LDS_WAIT();
#pragma unroll
            for (int q = 0; q < 2; ++q) {
                const int l = lane + 64 * q; float ac = 0.f, as = 0.f;
                for (int c = 0; c < 128; ++c) { const float f = scr[c]; const int m = (c * l) & 127; ac += f * ctab[m]; as += f * stab[m]; }
                WF[(size_t)((g * 2 + 0) * 128 + l) * 1024 + kk] = f2bf(ac);
                WF[(size_t)((g * 2 + 1) * 128 + l) * 1024 + kk] = f2bf(as);
            }
            LDS_WAIT();
        }
    }
    {
        bf16_t* DFT = (bf16_t*)(ws + WS_DFT);
        for (int idx = gt; idx < 2048 * 2048; idx += NGT) {
            const int k = idx >> 11, c2 = (idx & 2047) * 2, p = c2 >> 11, n0 = c2 & 2047;
            float s0, c0, s1, c1;
            sincospif((float)((n0 * k) & 2047) * (1.0f / 1024.0f), &s0, &c0);
            sincospif((float)(((n0 + 1) * k) & 2047) * (1.0f / 1024.0f), &s1, &c1);
            const float v0 = (p ? -s0 : c0) * (1.0f / 512.0f), v1 = (p ? -s1 : c1) * (1.0f / 512.0f);
            *(unsigned*)(DFT + (size_t)k * 4096 + c2) = pk2(v0, v1);
        }
    }
    {
        float* RC = (float*)(ws + WS_ROPE); float* RS = RC + 2048 * 32;
        for (int idx = gt; idx < 2048 * 32; idx += NGT) {
            const int n = idx >> 5, j = idx & 31; const float pos = (float)((j < 16) ? (n >> 6) : (n & 63));
            const float freq = powf(10000.0f, -(float)(j & 15) * (1.0f / 16.0f)); const float ang = pos * freq;
            RC[idx] = cosf(ang); RS[idx] = sinf(ang);
        }
        bf16_t* KEYS = (bf16_t*)(ws + WS_KEYS);
        for (int idx = gt; idx < 2 * 128 * 128; idx += NGT) KEYS[idx] = f2bf(idx < 16384 ? P.in[I_KEYS1][idx] : P.in[I_KEYS2][idx - 16384]);
    }
    {
        float* MOD = (float*)(ws + WS_MOD);
        for (int cb = blockIdx.x; cb < 256; cb += gridDim.x) {
            if (wave < 6) {
                const int col = cb * 24 + wave * 4;
                f32x4 acc[17];
#pragma unroll
                for (int r = 0; r < 17; ++r) acc[r] = (f32x4){0.f, 0.f, 0.f, 0.f};
#pragma unroll 1
                for (int i = 0; i < 16; ++i) {
                    const int k = lane + 64 * i;
                    const f32x4 w = *(const f32x4*)(P.in[I_WADA] + (size_t)k * 6144 + col);
#pragma unroll
                    for (int r = 0; r < 17; ++r) { const float s = svec[r * 1024 + k]; acc[r] += w * s; }
                }
#pragma unroll
                for (int r = 0; r < 17; ++r) {
                    f32x4 a = acc[r];
#pragma unroll
                    for (int o = 1; o < 64; o <<= 1) { a.x += __shfl_xor(a.x, o); a.y += __shfl_xor(a.y, o); a.z += __shfl_xor(a.z, o); a.w += __shfl_xor(a.w, o); }
                    if (lane == 0) { const f32x4 bb = *(const f32x4*)(P.in[I_BADA] + col); *(f32x4*)(MOD + (size_t)r * 6144 + col) = a + bb; }
                }
            }
        }
    }
}

DI void norm_mod_row(const float* xrow, const float* gain, const float* sh, const float* sc, bf16_t* orow, int lane) {
    const f32x4* xr = (const f32x4*)xrow + lane;
    f32x4 v[4]; float ss = 0.f;
#pragma unroll
    for (int j = 0; j < 4; ++j) { v[j] = xr[64 * j]; ss += (v[j].x * v[j].x + v[j].y * v[j].y) + (v[j].z * v[j].z + v[j].w * v[j].w); }
    const float rstd = rsqrtf(wave_sum(ss) * (1.0f / DM) + EPSV);
#pragma unroll
    for (int j = 0; j < 4; ++j) {
        const f32x4 g = ((const f32x4*)gain)[64 * j + lane], s = ((const f32x4*)sc)[64 * j + lane], h = ((const f32x4*)sh)[64 * j + lane];
        const f32x4 y = v[j] * rstd * g * (s + 1.0f) + h;
        u32x2 o; o.x = pk2(y.x, y.y); o.y = pk2(y.z, y.w);
        ((u32x2*)orow)[64 * j + lane] = o;
    }
}
DI void phase1(const Params& P) {
    const int lane = threadIdx.x & 63, wave = threadIdx.x >> 6;
    const int gw = blockIdx.x * NWAVES + wave, NGW = gridDim.x * NWAVES;
    const float* MOD = (const float*)(P.ws + WS_MOD);
    bf16_t* HX = (bf16_t*)(P.ws + WS_HX); bf16_t* HC = (bf16_t*)(P.ws + WS_HC);
    for (int r = gw; r < NTOK + NCTX; r += NGW) {
        if (r < NTOK) { const int b = r >> 11; const float* m = MOD + (size_t)b * 6144;
            norm_mod_row(P.in[I_X] + (size_t)r * DM, P.in[I_NPREMIX], m, m + 1024, HX + (size_t)r * DM, lane); }
        else { const int rc = r - NTOK; const float* m = MOD + (size_t)16 * 6144;
            norm_mod_row(P.in[I_CTX] + (size_t)rc * DM, P.in[I_NPREMIX], m, m + 1024, HC + (size_t)rc * DM, lane); }
    }
}

struct FPlain { bf16_t* O; int ldc;
    DI void operator()(int row, int col0, const f32x4& v0, const f32x4& v1) const {
        u32x4 w; w.x = pk2(v0[0], v0[1]); w.y = pk2(v0[2], v0[3]); w.z = pk2(v1[0], v1[1]); w.w = pk2(v1[2], v1[3]);
        *(u32x4*)(O + (size_t)row * ldc + col0) = w; } };
struct FQkvg { bf16_t* O; const float* RC; const float* RS;
    DI void operator()(int row, int col0, const f32x4& a0, const f32x4& a1) const {
        f32x4 v0 = a0, v1 = a1;
        if (col0 < 1024) {
            const int n = row & 2047, j0 = (col0 & 63) >> 1;
            const f32x4 cs = *(const f32x4*)(RC + n * 32 + j0), sn = *(const f32x4*)(RS + n * 32 + j0);
            f32x4 r0, r1;
            r0[0] = v0[0] * cs[0] - v0[1] * sn[0]; r0[1] = v0[1] * cs[0] + v0[0] * sn[0];
            r0[2] = v0[2] * cs[1] - v0[3] * sn[1]; r0[3] = v0[3] * cs[1] + v0[2] * sn[1];
            r1[0] = v1[0] * cs[2] - v1[1] * sn[2]; r1[1] = v1[1] * cs[2] + v1[0] * sn[2];
            r1[2] = v1[2] * cs[3] - v1[3] * sn[3]; r1[3] = v1[3] * cs[3] + v1[2] * sn[3];
            v0 = r0; v1 = r1;
        }
        u32x4 w; w.x = pk2(v0[0], v0[1]); w.y = pk2(v0[2], v0[3]); w.z = pk2(v1[0], v1[1]); w.w = pk2(v1[2], v1[3]);
        *(u32x4*)(O + (size_t)row * 2048 + col0) = w; } };
struct FFnetT { bf16_t* FT;
    DI void operator()(int row, int col0, const f32x4& v0, const f32x4& v1) const {
        const int g = row >> 8, p = (row >> 7) & 1, l = row & 127, b = col0 >> 11, n = col0 & 2047;
        u32x4 w; w.x = pk2(v0[0], v0[1]); w.y = pk2(v0[2], v0[3]); w.z = pk2(v1[0], v1[1]); w.w = pk2(v1[2], v1[3]);
        *(u32x4*)(FT + (size_t)((b * 4 + g) * 128 + l) * 4096 + p * 2048 + n) = w; } };
struct FFnetOut { bf16_t* MIX;
    DI void operator()(int row, int col0, const f32x4& v0, const f32x4& v1) const {
        const int b = col0 >> 9, gc = col0 & 511;
        u32x4 w; w.x = pk2(v0[0], v0[1]); w.y = pk2(v0[2], v0[3]); w.z = pk2(v1[0], v1[1]); w.w = pk2(v1[2], v1[3]);
        *(u32x4*)(MIX + (size_t)(b * 2048 + row) * 1024 + 512 + gc) = w; } };

template <class F> DI void run_gemm(LAS unsigned char* lds, const bf16_t* A, const bf16_t* Bt, int M, int N, int K, const F& f) {
    pg8::Gemm g{A, Bt, M, N, K}; pg8::StaticOrder S; S.init(M, N, (int)gridDim.x, (int)blockIdx.x);
    pg8::EpiBf16F<F> E{f};
    pg8::gemm_phase<pg8::EpiBf16F<F>, pg8::StaticOrder>(lds, g, S, E);
}

constexpr int R_Q = 0, R_K = 18432, R_KFT = 36864, R_KBT = 54272, R_VT = 71680, R_P = 89088, R_SFT = 123904, R_SBT = 133120;
constexpr int LQ = 72, LT = 136, LO = 65;
constexpr int R_DTAB = 142336;

DI f32x16 mma_tile(const LAS bf16_t* A, int lda, const LAS bf16_t* Bt, int ldb, int K, f32x16 acc, int lane) {
    const int r = lane & 31, hh = lane >> 5;
    const LAS bf16_t* ap = A + r * lda + 8 * hh; const LAS bf16_t* bp = Bt + r * ldb + 8 * hh;
#pragma unroll 4
    for (int k0 = 0; k0 < K; k0 += 16) { const bf16x8 a = *(const LAS bf16x8*)(ap + k0); const bf16x8 b = *(const LAS bf16x8*)(bp + k0); acc = MFMA32(a, b, acc); }
    return acc;
}
DI void stage_chunk(LAS unsigned char* lds, const bf16_t* src, int stride, int colQ, int colK, int colV, float lgf, float ef0, float lgb, float eb0) {
    const int tid = threadIdx.x, j = tid >> 2, c0 = (tid & 3) * 16;
    const bf16_t* rowp = src + (size_t)j * stride;
    const u32x4 k0 = *(const u32x4*)(rowp + colK + c0), k1 = *(const u32x4*)(rowp + colK + c0 + 8);
    const u32x4 v0 = *(const u32x4*)(rowp + colV + c0), v1 = *(const u32x4*)(rowp + colV + c0 + 8);
    LAS bf16_t* Ks = (LAS bf16_t*)(lds + R_K); LAS bf16_t* KfT = (LAS bf16_t*)(lds + R_KFT); LAS bf16_t* KbT = (LAS bf16_t*)(lds + R_KBT); LAS bf16_t* VT = (LAS bf16_t*)(lds + R_VT);
    *(LAS u32x4*)(Ks + j * LQ + c0) = k0; *(LAS u32x4*)(Ks + j * LQ + c0 + 8) = k1;
    if (colQ >= 0) { const u32x4 q0 = *(const u32x4*)(rowp + colQ + c0), q1 = *(const u32x4*)(rowp + colQ + c0 + 8);
        LAS bf16_t* Qs = (LAS bf16_t*)(lds + R_Q); *(LAS u32x4*)(Qs + j * LQ + c0) = q0; *(LAS u32x4*)(Qs + j * LQ + c0 + 8) = q1; }
    const float wf = __expf(lgf * (ef0 - (float)j)), wb = __expf(lgb * (eb0 + (float)j));
    const unsigned kw[8] = {k0.x, k0.y, k0.z, k0.w, k1.x, k1.y, k1.z, k1.w};
    const unsigned vw[8] = {v0.x, v0.y, v0.z, v0.w, v1.x, v1.y, v1.z, v1.w};
#pragma unroll
    for (int i = 0; i < 8; ++i) {
        const float ka = bflo(kw[i]), kb = bfhi(kw[i]);
        const int d = c0 + 2 * i;
        KfT[d * LT + j] = f2bf(ka * wf); KfT[(d + 1) * LT + j] = f2bf(kb * wf);
        KbT[d * LT + j] = f2bf(ka * wb); KbT[(d + 1) * LT + j] = f2bf(kb * wb);
        VT[d * LT + j] = (bf16_t)(vw[i] & 0xffffu); VT[(d + 1) * LT + j] = (bf16_t)(vw[i] >> 16);
    }
}
DI void store_state_T(bf16_t* ST, int ld, const f32x16& s, int dkb, int dvb, int lane) {
    const int dv = 32 * dvb + (lane & 31), hh = lane >> 5;
#pragma unroll
    for (int g = 0; g < 4; ++g) { u32x2 o; o.x = pk2(s[4 * g], s[4 * g + 1]); o.y = pk2(s[4 * g + 2], s[4 * g + 3]);
        *(u32x2*)(ST + dv * ld + 32 * dkb + 8 * g + 4 * hh) = o; }
}
DI void store_state_T(LAS bf16_t* ST, int ld, const f32x16& s, int dkb, int dvb, int lane) {
    const int dv = 32 * dvb + (lane & 31), hh = lane >> 5;
#pragma unroll
    for (int g = 0; g < 4; ++g) { u32x2 o; o.x = pk2(s[4 * g], s[4 * g + 1]); o.y = pk2(s[4 * g + 2], s[4 * g + 3]);
        *(LAS u32x2*)(ST + dv * ld + 32 * dkb + 8 * g + 4 * hh) = o; }
}

DI void retention_item(const Params& P, LAS unsigned char* lds, int item) {
    const int tid = threadIdx.x, lane = tid & 63, wave = __builtin_amdgcn_readfirstlane(tid >> 6), hh = lane >> 5;
    const int b = item >> 4, h = (item >> 1) & 7, hf = item & 1;
    const float lgf = log1pf(-expf(P.in[I_DECF][h])), lgb = log1pf(-expf(P.in[I_DECB][h]));
    const bf16_t* QKVG = (const bf16_t*)(P.ws + WS_QKVG) + (size_t)b * SEQ * 2048;
    const bf16_t* CKV = (const bf16_t*)(P.ws + WS_CKV) + (size_t)b * CTXL * 1024;
    bf16_t* SBST = (bf16_t*)(P.ws + WS_SB) + (size_t)item * 8 * 4096;
    bf16_t* MIX = (bf16_t*)(P.ws + WS_MIX) + (size_t)b * SEQ * 1024;
    const int c0 = 8 * hf, clast = c0 + 7; const float P0 = 128.f * c0, Pend = 128.f * (clast + 1);
    LAS bf16_t* Qs = (LAS bf16_t*)(lds + R_Q); LAS bf16_t* Ks = (LAS bf16_t*)(lds + R_K); LAS bf16_t* KfT = (LAS bf16_t*)(lds + R_KFT); LAS bf16_t* KbT = (LAS bf16_t*)(lds + R_KBT);
    LAS bf16_t* VT = (LAS bf16_t*)(lds + R_VT); LAS bf16_t* Ps = (LAS bf16_t*)(lds + R_P); LAS float* Os = (LAS float*)(lds + R_P);
    LAS bf16_t* SfT = (LAS bf16_t*)(lds + R_SFT); LAS bf16_t* SbT = (LAS bf16_t*)(lds + R_SBT);
    const int sdk = (wave >> 1) & 1, sdv = wave & 1;
    const bool isF = wave < 4;
    f32x16 Sacc;
#pragma unroll
    for (int i = 0; i < 16; ++i) Sacc[i] = 0.f;
    LAS float* dtab = (LAS float*)(lds + R_DTAB);
    { const int k = tid & 127, which = tid >> 7;
      dtab[tid] = which == 0 ? __expf(lgf * (float)k) : which == 1 ? __expf(lgb * (float)k) : which == 2 ? __expf(lgf * (float)(k + 1)) : __expf(lgb * (float)(128 - k)); }

    for (int x = 0; x < 10; ++x) {
        const bf16_t* src; int stride, colK, colV; float pos0f, pos0b; bool cf, cb;
        if (x < 2) { src = CKV + (size_t)(128 * x) * 1024; stride = 1024; colK = h * 64; colV = 512 + h * 64; pos0f = -256.f + 128.f * x; pos0b = 2048.f + 128.f * x; cf = true; cb = true; }
        else { const int c = (hf ? 0 : 8) + (x - 2); src = QKVG + (size_t)(128 * c) * 2048; stride = 2048; colK = 512 + h * 64; colV = 1024 + h * 64; pos0f = 128.f * c; pos0b = pos0f; cf = (hf == 1); cb = (hf == 0); }
        const float ef0 = cf ? (P0 - 1.f - pos0f) : 0.f, eb0 = cb ? (pos0b - Pend) : 0.f;
        __syncthreads();
        stage_chunk(lds, src, stride, -1, colK, colV, lgf, ef0, lgb, eb0);
        __syncthreads();
        if (isF) { if (cf) Sacc = mma_tile(KfT + 32 * sdk * LT, LT, VT + 32 * sdv * LT, LT, 128, Sacc, lane); }
        else { if (cb) Sacc = mma_tile(KbT + 32 * sdk * LT, LT, VT + 32 * sdv * LT, LT, 128, Sacc, lane); }
    }
    const float gb128 = __expf(lgb * 128.f), gf128 = __expf(lgf * 128.f);
    for (int c = clast; c >= c0; --c) {
        if (!isF) store_state_T(SBST + (size_t)(c - c0) * 4096, 64, Sacc, sdk, sdv, lane);
        if (c > c0) {
            __syncthreads();
            stage_chunk(lds, QKVG + (size_t)(128 * c) * 2048, 2048, -1, 512 + h * 64, 1024 + h * 64, lgf, 127.f, lgb, 0.f);
            __syncthreads();
            if (!isF) { Sacc = Sacc * gb128; Sacc = mma_tile(KbT + 32 * sdk * LT, LT, VT + 32 * sdv * LT, LT, 128, Sacc, lane); }
        }
    }
    for (int c = c0; c <= clast; ++c) {
        __syncthreads();
        stage_chunk(lds, QKVG + (size_t)(128 * c) * 2048, 2048, h * 64, 512 + h * 64, 1024 + h * 64, lgf, 127.f, lgb, 0.f);
        if (isF) store_state_T(SfT, LQ, Sacc, sdk, sdv, lane);
        {
            const int r = tid >> 3, pc = tid & 7; const u32x4 w = *(const u32x4*)(SBST + (size_t)(c - c0) * 4096 + r * 64 + pc * 8);
            *(LAS u32x4*)(SbT + r * LQ + pc * 8) = w; }
        __syncthreads();
        const int ib = wave >> 1, db = wave & 1;
#pragma unroll
        for (int t = 0; t < 2; ++t) {
            const int jb = 2 * db + t;
            f32x16 s = mma_tile(Qs + 32 * ib * LQ, LQ, Ks + 32 * jb * LQ, LQ, 64, zero16(), lane);
            const int j = 32 * jb + (lane & 31);
#pragma unroll
            for (int r = 0; r < 16; ++r) { const int i = 32 * ib + crow(r, hh); const int dlt = i - j;
                const float dec = dtab[dlt >= 0 ? dlt : 128 - dlt];
                Ps[i * LT + j] = f2bf(s[r] * dec); }
        }
        __syncthreads();
        f32x16 o = mma_tile(Ps + 32 * ib * LT, LT, VT + 32 * db * LT, LT, 128, zero16(), lane);
        f32x16 tf = mma_tile(Qs + 32 * ib * LQ, LQ, SfT + 32 * db * LQ, LQ, 64, zero16(), lane);
        f32x16 tb = mma_tile(Qs + 32 * ib * LQ, LQ, SbT + 32 * db * LQ, LQ, 64, zero16(), lane);
#pragma unroll
        for (int r = 0; r < 16; ++r) { const int i = 32 * ib + crow(r, hh); o[r] += dtab[256 + i] * tf[r] + dtab[384 + i] * tb[r]; }
        __syncthreads();
#pragma unroll
        for (int r = 0; r < 16; ++r) Os[(32 * ib + crow(r, hh)) * LO + 32 * db + (lane & 31)] = o[r];
        if (isF) { Sacc = Sacc * gf128; Sacc = mma_tile(KfT + 32 * sdk * LT, LT, VT + 32 * sdv * LT, LT, 128, Sacc, lane); }
        __syncthreads();
        {
            const int i = tid >> 2, q4 = tid & 3; float ov[16]; float ss = 0.f;
#pragma unroll
            for (int e = 0; e < 16; ++e) { ov[e] = Os[i * LO + 16 * q4 + e]; ss += ov[e] * ov[e]; }
            ss += __shfl_xor(ss, 1); ss += __shfl_xor(ss, 2);
            const float rstd = rsqrtf(ss * (1.0f / 64.0f) + EPSV);
            const bf16_t* gp = QKVG + (size_t)(128 * c + i) * 2048 + 1536 + h * 64 + 16 * q4;
            const u32x4 g0 = *(const u32x4*)gp, g1 = *(const u32x4*)(gp + 8);
            const unsigned gw_[8] = {g0.x, g0.y, g0.z, g0.w, g1.x, g1.y, g1.z, g1.w};
            const float* gn = P.in[I_RETGAIN] + h * 64 + 16 * q4;
            unsigned ow[8];
#pragma unroll
            for (int e = 0; e < 8; ++e) {
                const float ya = ov[2 * e] * rstd * gn[2 * e] * siluf(bflo(gw_[e])), yb = ov[2 * e + 1] * rstd * gn[2 * e + 1] * siluf(bfhi(gw_[e]));
                ow[e] = pk2(ya, yb);
            }
            bf16_t* mp = MIX + (size_t)(128 * c + i) * 1024 + h * 64 + 16 * q4;
            *(u32x4*)mp = (u32x4){ow[0], ow[1], ow[2], ow[3]}; *(u32x4*)(mp + 8) = (u32x4){ow[4], ow[5], ow[6], ow[7]};
        }
    }
    __syncthreads();
}

DI void phase5(const Params& P) {
    const int lane = threadIdx.x & 63, wave = threadIdx.x >> 6;
    const int gw = blockIdx.x * NWAVES + wave, NGW = gridDim.x * NWAVES;
    const float* MOD = (const float*)(P.ws + WS_MOD);
    const float* O = (const float*)(P.ws + WS_QKVG);
    bf16_t* H2 = (bf16_t*)(P.ws + WS_HX); bf16_t* H2S = (bf16_t*)(P.ws + WS_H2S);
    for (int r = gw; r < NTOK; r += NGW) {
        const int b = r >> 11; const float* m = MOD + (size_t)b * 6144;
        const f32x4* orow = (const f32x4*)(O + (size_t)r * DM) + lane; const f32x4* xrow = (const f32x4*)(P.in[I_X] + (size_t)r * DM) + lane;
        f32x4 ov[4], xv[4]; float ss = 0.f;
#pragma unroll
        for (int j = 0; j < 4; ++j) { ov[j] = orow[64 * j]; xv[j] = xrow[64 * j]; ss += (ov[j].x * ov[j].x + ov[j].y * ov[j].y) + (ov[j].z * ov[j].z + ov[j].w * ov[j].w); }
        const float rstd = rsqrtf(wave_sum(ss) * (1.0f / DM) + EPSV);
        float ss2 = 0.f;
#pragma unroll
        for (int j = 0; j < 4; ++j) {
            const f32x4 gn = ((const f32x4*)P.in[I_NPOSTMIX])[64 * j + lane], g1 = ((const f32x4*)(m + 2048))[64 * j + lane];
            xv[j] = xv[j] + g1 * (ov[j] * rstd * gn);
            ((f32x4*)(P.out + (size_t)r * DM))[64 * j + lane] = xv[j];
            ss2 += (xv[j].x * xv[j].x + xv[j].y * xv[j].y) + (xv[j].z * xv[j].z + xv[j].w * xv[j].w);
        }
        const float rstd2 = rsqrtf(wave_sum(ss2) * (1.0f / DM) + EPSV);
#pragma unroll
        for (int j = 0; j < 4; ++j) {
            const f32x4 gn = ((const f32x4*)P.in[I_NPREFFN])[64 * j + lane], sh = ((const f32x4*)(m + 3072))[64 * j + lane], sc = ((const f32x4*)(m + 4096))[64 * j + lane];
            const f32x4 y = xv[j] * rstd2 * gn * (sc + 1.0f) + sh;
            u32x2 o; o.x = pk2(y.x, y.y); o.y = pk2(y.z, y.w);
            ((u32x2*)(H2 + (size_t)r * DM))[64 * j + lane] = o;
            *(u32x2*)(H2S + ((size_t)(2 * j + (lane >> 5)) * NTOK + r) * 128 + 4 * (lane & 31)) = o;
        }
    }
}

#define INS16(L, xx) do { float _x = (xx); _Pragma("unroll") for (int _i = 0; _i < 16; ++_i) { const float _t = fmaxf(L[_i], _x); _x = fminf(L[_i], _x); L[_i] = _t; } } while (0)
constexpr int KLD = 136;
DI void topk_half(const LAS bf16_t* keys  , const bf16_t* qrow  , float (&L)[16], int lane) {
    const int r = lane & 31, hh = lane >> 5;
    f32x16 acc[4];
#pragma unroll
    for (int t = 0; t < 4; ++t)
#pragma unroll
        for (int i = 0; i < 16; ++i) acc[t][i] = 0.f;
#pragma unroll 2
    for (int k0 = 0; k0 < 128; k0 += 16) {
        const bf16x8 bq = *(const bf16x8*)(qrow + k0 + 8 * hh);
#pragma unroll
        for (int t = 0; t < 4; ++t) { const bf16x8 a = *(const LAS bf16x8*)(keys + (32 * t + r) * KLD + k0 + 8 * hh); acc[t] = MFMA32(a, bq, acc[t]); }
    }
#pragma unroll
    for (int i = 0; i < 16; ++i) L[i] = -3.0e38f;
#pragma unroll
    for (int t = 0; t < 4; ++t)
#pragma unroll
        for (int i = 0; i < 16; ++i) {
            const unsigned idx = 32u * t + (unsigned)((i & 3) + 8 * (i >> 2));
            const float pv = __uint_as_float((__float_as_uint(acc[t][i]) & 0xFFFFFF80u) | idx);
            INS16(L, pv);
        }
#pragma unroll
    for (int i = 0; i < 16; ++i) L[i] = __uint_as_float(__float_as_uint(L[i]) | ((unsigned)hh << 2));
    float Pn[16];
#pragma unroll
    for (int i = 0; i < 16; ++i) Pn[i] = __shfl_xor(L[i], 32);
#pragma unroll
    for (int i = 0; i < 16; ++i) INS16(L, Pn[i]);
}
DI unsigned pack4idx(float a, float b, float c, float d) { return (__float_as_uint(a) & 127u) | ((__float_as_uint(b) & 127u) << 8) | ((__float_as_uint(c) & 127u) << 16) | ((__float_as_uint(d) & 127u) << 24); }
DI unsigned pick_idx(unsigned w0, unsigned w1, unsigned w2, unsigned w3, unsigned a) {
    const unsigned lo = (a & 4u) ? w1 : w0, hi = (a & 4u) ? w3 : w2, w = (a & 8u) ? hi : lo;
    return (w >> (8u * (a & 3u))) & 127u;
}
typedef __bf16 bf16x2_t __attribute__((ext_vector_type(2)));
DI float dot2bf(unsigned a, unsigned b, float acc) { return __builtin_amdgcn_fdot2_f32_bf16(__builtin_bit_cast(bf16x2_t, a), __builtin_bit_cast(bf16x2_t, b), acc, false); }
#define DPP_ADD(x, ctrl) ((x) + __int_as_float(__builtin_amdgcn_update_dpp(0, __float_as_int(x), (ctrl), 0xf, 0xf, true)))
DI float dpp_sum16(float x) {
    x = DPP_ADD(x, 0x128);
    x = DPP_ADD(x, 0x141);
    x = DPP_ADD(x, 0x4E);
    x = DPP_ADD(x, 0xB1);
    return x;
}

#define DPP_MOV(x, ctrl) __int_as_float(__builtin_amdgcn_update_dpp(0, __float_as_int(x), (ctrl), 0xf, 0xf, true))
DI float dpp_sum16x4(float d0, float d1, float d2, float d3, int l16) {
    const bool hi = (l16 & 8) != 0;
    float k0 = hi ? d2 : d0, k1 = hi ? d3 : d1; const float g0 = hi ? d0 : d2, g1 = hi ? d1 : d3;
    k0 += DPP_MOV(g0, 0x128); k1 += DPP_MOV(g1, 0x128);
    const bool b2 = (l16 & 4) != 0;
    float k = b2 ? k1 : k0; const float gv = b2 ? k0 : k1;
    k += DPP_MOV(gv, 0x141);
    k += DPP_MOV(k, 0xB1);
    k += DPP_MOV(k, 0x4E);
    return k;
}

DI unsigned peer_blk(unsigned e) { return ((e >> 7) + (e & 31u)) & 31u; }
DI unsigned peer_row(unsigned e) { return ((e >> 7) << 2) | ((e >> 5) & 3u); }
DI unsigned peer_expert(unsigned blk, unsigned row) { const unsigned e1 = row >> 2; return e1 * 128u + (row & 3u) * 32u + ((blk - e1) & 31u); }

constexpr int P7_IDS = 69632, P7_WTS = 77952, P7_SID = 94336, P7_SWT = 102528, P7_CUM = 118912;
DI void phase7(const Params& P, LAS unsigned char* lds) {
    const int tid = threadIdx.x, lane = tid & 63, wave = tid >> 6;
    LAS bf16_t* keys = (LAS bf16_t*)lds;
    LAS bf16_t* ids_l = (LAS bf16_t*)(lds + P7_IDS);
    LAS float* wts_l = (LAS float*)(lds + P7_WTS);
    LAS bf16_t* sid_l = (LAS bf16_t*)(lds + P7_SID);
    LAS float* swt_l = (LAS float*)(lds + P7_SWT);
    LAS unsigned char* cum_l = (LAS unsigned char*)(lds + P7_CUM);
    const bf16_t* KEYS = (const bf16_t*)(P.ws + WS_KEYS);
    for (int i = tid; i < 256 * 16; i += NTHREADS) { const int r = i >> 4, pc = i & 15; *(LAS u32x4*)(keys + r * KLD + pc * 8) = *(const u32x4*)(KEYS + r * 128 + pc * 8); }
    __syncthreads();
    const bf16_t* PQ = (const bf16_t*)(P.ws + WS_FT);
    bf16_t* SID = (bf16_t*)(P.ws + WS_SID); bf16_t* SIDB = (bf16_t*)(P.ws + WS_SIDB); float* SWT = (float*)(P.ws + WS_SWT);
    for (int tile = blockIdx.x; tile < 1024; tile += gridDim.x) {
        const int t0 = tile * 32;
        {
            const int h = wave, tl = lane & 31, tok = t0 + tl, hh = lane >> 5;
            const bf16_t* qrow = PQ + (size_t)tok * 2048 + h * 256;
            float L1[16], L2[16];
            topk_half(keys, qrow, L1, lane);
            topk_half(keys + 128 * KLD, qrow + 128, L2, lane);
            const unsigned w10 = pack4idx(L1[0], L1[1], L1[2], L1[3]), w11 = pack4idx(L1[4], L1[5], L1[6], L1[7]), w12 = pack4idx(L1[8], L1[9], L1[10], L1[11]), w13 = pack4idx(L1[12], L1[13], L1[14], L1[15]);
            const unsigned w20 = pack4idx(L2[0], L2[1], L2[2], L2[3]), w21 = pack4idx(L2[4], L2[5], L2[6], L2[7]), w22 = pack4idx(L2[8], L2[9], L2[10], L2[11]), w23 = pack4idx(L2[12], L2[13], L2[14], L2[15]);
            float C[16];
#pragma unroll
            for (int i = 0; i < 16; ++i) C[i] = -3.0e38f;
#pragma unroll
            for (int a = 0; a < 16; ++a)
#pragma unroll
                for (int bq = 0; bq < 16; ++bq)
                    if ((a + 1) * (bq + 1) <= 16) { const float sm = L1[a] + L2[bq]; const float pv = __uint_as_float((__float_as_uint(sm) & 0xFFFFFF00u) | (unsigned)(a * 16 + bq)); INS16(C, pv); }
            float e[16], sum = 0.f;
#pragma unroll
            for (int i = 0; i < 16; ++i) { e[i] = __expf(C[i] - C[0]); sum += e[i]; }
            const float inv = 1.0f / sum;
            if (hh == 0) {
#pragma unroll
                for (int i = 0; i < 16; ++i) { const unsigned code = __float_as_uint(C[i]) & 255u;
                    ids_l[tl * 130 + h * 16 + i] = (bf16_t)(pick_idx(w10, w11, w12, w13, code >> 4) * 128u + pick_idx(w20, w21, w22, w23, code & 15u)); }
            } else {
#pragma unroll
                for (int i = 0; i < 16; ++i) wts_l[tl * 128 + h * 16 + i] = e[i] * inv;
            }
        }
        __syncthreads();
        {
            const int tl = tid >> 4, j = tid & 15;
            unsigned key[8], rank[8], myid[8];
#pragma unroll
            for (int m = 0; m < 8; ++m) { myid[m] = ids_l[tl * 130 + 8 * j + m]; key[m] = (peer_blk(myid[m]) << 7) | (unsigned)(8 * j + m); rank[m] = 0; }
            unsigned cumA = 0, cumB = 0;
            for (int i = 0; i < 128; ++i) {
                const unsigned idv = ids_l[tl * 130 + i], ebv = peer_blk(idv), kv = (ebv << 7) | (unsigned)i;
#pragma unroll
                for (int m = 0; m < 8; ++m) rank[m] += (kv < key[m]) ? 1u : 0u;
                cumA += (ebv < (unsigned)j) ? 1u : 0u; cumB += (ebv < (unsigned)(j + 16)) ? 1u : 0u;
            }
#pragma unroll
            for (int m = 0; m < 8; ++m) { sid_l[tl * 128 + rank[m]] = (bf16_t)myid[m]; swt_l[tl * 128 + rank[m]] = wts_l[tl * 128 + 8 * j + m]; }
            cum_l[tl * 40 + j] = (unsigned char)cumA; cum_l[tl * 40 + 16 + j] = (unsigned char)cumB; if (j == 0) cum_l[tl * 40 + 32] = 128;
        }
        __syncthreads();
        {
            const int tl = tid >> 4, pc = tid & 15;
            *(u32x4*)(SID + (size_t)(t0 + tl) * 128 + pc * 8) = *(const LAS u32x4*)(sid_l + tl * 128 + pc * 8);
            *(u32x4*)(SWT + (size_t)(t0 + tl) * 128 + pc * 8) = *(const LAS u32x4*)(swt_l + tl * 128 + pc * 8);
            *(u32x4*)(SWT + (size_t)(t0 + tl) * 128 + pc * 8 + 4) = *(const LAS u32x4*)(swt_l + tl * 128 + pc * 8 + 4);
#pragma unroll
            for (int rr = 0; rr < 2; ++rr) {
                const int rec = tid + rr * NTHREADS, eb = rec >> 5, tk = rec & 31;
                const unsigned lo = cum_l[tk * 40 + eb], hi = cum_l[tk * 40 + eb + 1], cnt = hi - lo;
                unsigned w[8];
#pragma unroll
                for (int q = 0; q < 8; ++q) {
                    unsigned a, b;
                    if (q == 0) a = cnt | (lo << 8); else { const unsigned k = 2 * q - 1; a = (k < cnt) ? peer_row((unsigned)sid_l[tk * 128 + ((lo + k) & 127)]) : 0u; }
                    { const unsigned k = 2 * q; b = (k < cnt) ? peer_row((unsigned)sid_l[tk * 128 + ((lo + k) & 127)]) : 0u; }
                    w[q] = a | (b << 16);
                }
                bf16_t* rp = SIDB + ((size_t)eb * NTOK + t0 + tk) * 16;
                *(u32x4*)rp = (u32x4){w[0], w[1], w[2], w[3]}; *(u32x4*)(rp + 8) = (u32x4){w[4], w[5], w[6], w[7]};
            }
        }
        __syncthreads();
    }
}

constexpr int U_TAB = 131072, U_HST = 3072, U_LST = 960, U_TOK = 96, U_NIT = (NTOK + U_TOK - 1) / U_TOK;
template <int VAR> DI void phase8(const Params& P, LAS unsigned char* lds, float* PART) {
    const int tid = threadIdx.x, lane = tid & 63, wave = __builtin_amdgcn_readfirstlane(tid >> 6), g4 = lane >> 4, l16 = lane & 15;
    LAS bf16_t* tab = (LAS bf16_t*)lds;
    LAS unsigned char* hst = lds + U_TAB + wave * U_HST;
    LAS unsigned* lst = (LAS unsigned*)(lds + U_TAB + 8 * U_HST + wave * U_LST);
    const bf16_t* H2S = (const bf16_t*)(P.ws + WS_H2S);
    const bf16_t* SIDB = (const bf16_t*)(P.ws + WS_SIDB); const bf16_t* SID = (const bf16_t*)(P.ws + WS_SID);
    for (int role = blockIdx.x; role < 256; role += gridDim.x) {
        const int ds = role & 7, eb = role >> 3;
        __syncthreads();
        TS_BEGIN(1);
#pragma unroll 8
        for (int idx = tid; idx < 512 * 32; idx += NTHREADS) {
            const int row = idx >> 5, c4 = idx & 31;
            const f32x4 v = *(const f32x4*)(P.in[I_U] + (size_t)peer_expert((unsigned)eb, (unsigned)row) * DM + 128 * ds + 4 * c4);
            u32x2 o; o.x = pk2(v.x, v.y); o.y = pk2(v.z, v.w);
            *(LAS u32x2*)(tab + row * 128 + 4 * c4) = o;
        }
        __syncthreads();
        TS_END(1);
        TS_BEGIN(2);
        const bf16_t* recs = SIDB + (size_t)eb * NTOK * 16;
        const bf16_t* hpl = H2S + (size_t)ds * NTOK * 128;
        float* ppl = PART + (size_t)ds * NTOK * 128;
        unsigned hd0[3], en0[3], hd1[3], en1[3]; u32x4 hh0[3], hh1[3];
#define U_LOAD(HD_, EN_, HH_, IT_) do { _Pragma("unroll") for (int q = 0; q < 3; ++q) { const int t_ = (IT_) * U_TOK + 12 * wave + 3 * g4 + q; const int tt_ = t_ < NTOK ? t_ : NTOK - 1; \
            const bf16_t* rp_ = recs + (size_t)tt_ * 16; HD_[q] = t_ < NTOK ? (unsigned)rp_[0] : 0u; EN_[q] = (unsigned)rp_[1 + l16]; HH_[q] = *(const u32x4*)(hpl + (size_t)tt_ * 128 + 8 * l16); } } while (0)
        U_LOAD(hd0, en0, hh0, 0);
        U_LOAD(hd1, en1, hh1, 1);
        for (int it = 0; it < U_NIT; ++it) {
            unsigned hd2[3], en2[3]; u32x4 hh2[3];
            { const int itn = (it + 2 < U_NIT) ? it + 2 : U_NIT - 1; U_LOAD(hd2, en2, hh2, itn); }
            const int tile = it * U_TOK + 12 * wave;
            unsigned c15[3], lo[3], cn[3]; unsigned sg = 0, anyover = 0;
#pragma unroll
            for (int q = 0; q < 3; ++q) {
                *(LAS u32x4*)(hst + (3 * g4 + q) * 256 + 16 * l16) = hh0[q];
                cn[q] = hd0[q] & 0xffu; lo[q] = (hd0[q] >> 8) & 0xffu; c15[q] = cn[q] < 15u ? cn[q] : 15u; sg += c15[q]; anyover |= (cn[q] > 15u) ? 1u : 0u;
            }
            const int s0 = __builtin_amdgcn_readlane((int)sg, 0), s1 = __builtin_amdgcn_readlane((int)sg, 16), s2 = __builtin_amdgcn_readlane((int)sg, 32), s3 = __builtin_amdgcn_readlane((int)sg, 48);
            const int b1 = s0, b2 = s0 + s1, b3 = b2 + s2, total = b3 + s3;
            unsigned myoff = g4 == 0 ? 0u : g4 == 1 ? (unsigned)b1 : g4 == 2 ? (unsigned)b2 : (unsigned)b3;
#pragma unroll
            for (int q = 0; q < 3; ++q) {
                if ((unsigned)l16 < c15[q]) lst[myoff + l16] = (lo[q] + (unsigned)l16) | ((en0[q] & 511u) << 7) | ((unsigned)(3 * g4 + q) << 16);
                myoff += c15[q];
            }
            LDS_WAIT();
            if (VAR != 1) {
                const int chunk = ((total + 15) >> 4) << 2;
                for (int c0 = 0; c0 < chunk; c0 += 4) {
                    const int kb = g4 * chunk + c0;
                    const u32x4 e4 = *(const LAS u32x4*)(lst + kb);
                    const unsigned ev[4] = {e4.x, e4.y, e4.z, e4.w};
                    u32x4 hv[4], uv[4]; unsigned dst[4];
#pragma unroll
                    for (int u = 0; u < 4; ++u) {
                        const unsigned e = (kb + u < total) ? ev[u] : 0u;
                        const unsigned slot = e >> 16, id = (e >> 7) & 511u;
                        hv[u] = *(const LAS u32x4*)(hst + slot * 256 + 16 * l16);
                        uv[u] = *(const LAS u32x4*)(tab + id * 128 + 8 * l16);
                        dst[u] = (kb + u < total) ? (slot * 128u + (e & 127u)) : 0xffffffffu;
                    }
                    float d[4];
#pragma unroll
                    for (int u = 0; u < 4; ++u) { float a = dot2bf(uv[u].x, hv[u].x, 0.f); a = dot2bf(uv[u].y, hv[u].y, a); a = dot2bf(uv[u].z, hv[u].z, a); a = dot2bf(uv[u].w, hv[u].w, a); d[u] = a; }
                    const float r = dpp_sum16x4(d[0], d[1], d[2], d[3], l16);
                    const int uq = l16 >> 2;
                    const unsigned mydst = uq == 0 ? dst[0] : uq == 1 ? dst[1] : uq == 2 ? dst[2] : dst[3];
                    if ((l16 & 3) == 0 && mydst != 0xffffffffu) ppl[(size_t)tile * 128 + mydst] = r;
                }
            }
            if (__builtin_amdgcn_readfirstlane((int)__builtin_popcountll(__ballot(anyover != 0))) != 0) {
#pragma unroll
                for (int q = 0; q < 3; ++q) {
                    const int t = tile + 3 * g4 + q;
                    const int c0 = __builtin_amdgcn_readlane((int)cn[q], 0), c1 = __builtin_amdgcn_readlane((int)cn[q], 16), c2 = __builtin_amdgcn_readlane((int)cn[q], 32), c3 = __builtin_amdgcn_readlane((int)cn[q], 48);
                    const int nmax = max(max(c0, c1), max(c2, c3));
                    for (int j = 15; j < nmax; ++j) {
                        const bool act = (unsigned)j < cn[q];
                        const unsigned id = act ? (unsigned)SID[(size_t)t * 128 + lo[q] + j] : 0u;
                        const u32x4 u = *(const LAS u32x4*)(tab + peer_row(id) * 128 + 8 * l16);
                        float d = dot2bf(u.x, hh0[q].x, 0.f); d = dot2bf(u.y, hh0[q].y, d); d = dot2bf(u.z, hh0[q].z, d); d = dot2bf(u.w, hh0[q].w, d);
                        d = dpp_sum16(d);
                        if (act && l16 == 0) ppl[(size_t)t * 128 + lo[q] + j] = d;
                    }
                }
            }
#pragma unroll
            for (int q = 0; q < 3; ++q) { hd0[q] = hd1[q]; en0[q] = en1[q]; hh0[q] = hh1[q]; hd1[q] = hd2[q]; en1[q] = en2[q]; hh1[q] = hh2[q]; }
        }
#undef U_LOAD
        TS_END(2);
    }
}

DI void phase9(const Params& P, LAS unsigned char* lds) {
    const int tid = threadIdx.x;
    LAS unsigned* stage = (LAS unsigned*)lds;
    const float* PART = (const float*)(P.ws + WS_PART); const float* SWT = (const float*)(P.ws + WS_SWT); const bf16_t* SID = (const bf16_t*)(P.ws + WS_SID);
    unsigned* CIT = (unsigned*)(P.ws + WS_CIT);
    for (int tile = blockIdx.x; tile < 512; tile += gridDim.x) {
        const int t0 = tile * 64;
        __syncthreads();
#pragma unroll 4
        for (int it = 0; it < 16; ++it) {
            const int tl = (tid >> 7) + 4 * it, s = tid & 127; const size_t pi = (size_t)(t0 + tl) * 128 + s;
            float act = 0.f;
#pragma unroll
            for (int d = 0; d < 8; ++d) act += PART[(size_t)d * NTOK * 128 + pi];
            const float coef = SWT[pi] * gelu_erf(act);
            stage[tl * 132 + s] = ((unsigned)SID[pi] << 16) | (unsigned)f2bf(coef);
        }
        __syncthreads();
        {
            const int sg = tid >> 4, tq = (tid & 15) * 4;
#pragma unroll
            for (int q = 0; q < 4; ++q) *(u32x4*)(CIT + ((size_t)sg * NTOK + t0 + tq + q) * 4) = *(const LAS u32x4*)(stage + (tq + q) * 132 + sg * 4);
        }
    }
}

typedef float f32x2v __attribute__((ext_vector_type(2)));
DI float clamp448(float x) { return fminf(fmaxf(x, -448.f), 448.f); }
DI void phase10(const Params& P, LAS unsigned char* lds) {
    const int tid = threadIdx.x, lane = tid & 63, wave = tid >> 6;
    LAS unsigned char* tab = lds;
    const unsigned* CIT = (const unsigned*)(P.ws + WS_CIT);
    float* POUT = (float*)(P.ws + WS_POUT);
    for (int role = blockIdx.x; role < 256; role += gridDim.x) {
        const int xl = role & 7, r = role >> 3, c = xl * 16 + (r & 15), half = r >> 4;
        __syncthreads();
#pragma unroll 4
        for (int e = tid; e < 16384; e += NTHREADS) {
            const f32x4 v0 = *(const f32x4*)(P.in[I_V] + (size_t)e * DM + 8 * c), v1 = *(const f32x4*)(P.in[I_V] + (size_t)e * DM + 8 * c + 4);
            int w0 = 0, w1 = 0;
            w0 = __builtin_amdgcn_cvt_pk_fp8_f32(clamp448(v0.x * 512.f), clamp448(v0.y * 512.f), w0, false); w0 = __builtin_amdgcn_cvt_pk_fp8_f32(clamp448(v0.z * 512.f), clamp448(v0.w * 512.f), w0, true);
            w1 = __builtin_amdgcn_cvt_pk_fp8_f32(clamp448(v1.x * 512.f), clamp448(v1.y * 512.f), w1, false); w1 = __builtin_amdgcn_cvt_pk_fp8_f32(clamp448(v1.z * 512.f), clamp448(v1.w * 512.f), w1, true);
            *(LAS u32x2*)(tab + e * 8) = (u32x2){(unsigned)w0, (unsigned)w1};
        }
        __syncthreads();
        for (int grp = wave; grp < 256; grp += NWAVES) {
            const int t = half * (NTOK / 2) + grp * 64 + lane;
            float a[8];
#pragma unroll
            for (int i = 0; i < 8; ++i) a[i] = 0.f;
#pragma unroll 4
            for (int sg = 0; sg < 32; ++sg) {
                const u32x4 c4 = *(const u32x4*)(CIT + ((size_t)sg * NTOK + t) * 4);
                const unsigned cw[4] = {c4.x, c4.y, c4.z, c4.w};
#pragma unroll
                for (int q = 0; q < 4; ++q) {
                    const float coef = __uint_as_float(cw[q] << 16);
                    const u32x2 v = *(const LAS u32x2*)(tab + (cw[q] >> 16) * 8);
                    const f32x2v p0 = __builtin_amdgcn_cvt_pk_f32_fp8((int)v.x, false), p1 = __builtin_amdgcn_cvt_pk_f32_fp8((int)v.x, true);
                    const f32x2v p2 = __builtin_amdgcn_cvt_pk_f32_fp8((int)v.y, false), p3 = __builtin_amdgcn_cvt_pk_f32_fp8((int)v.y, true);
                    a[0] += coef * p0.x; a[1] += coef * p0.y; a[2] += coef * p1.x; a[3] += coef * p1.y;
                    a[4] += coef * p2.x; a[5] += coef * p2.y; a[6] += coef * p3.x; a[7] += coef * p3.y;
                }
            }
            const float sc = 1.0f / 512.0f;
            float* op = POUT + ((size_t)xl * NTOK + t) * 128 + 8 * (c & 15);
            *(f32x4*)op = (f32x4){a[0] * sc, a[1] * sc, a[2] * sc, a[3] * sc}; *(f32x4*)(op + 4) = (f32x4){a[4] * sc, a[5] * sc, a[6] * sc, a[7] * sc};
        }
    }
}

DI void phase11(const Params& P) {
    const int lane = threadIdx.x & 63, wave = threadIdx.x >> 6;
    const int gw = blockIdx.x * NWAVES + wave, NGW = gridDim.x * NWAVES;
    const float* MOD = (const float*)(P.ws + WS_MOD);
    const float* POUT = (const float*)(P.ws + WS_POUT);
    for (int t = gw; t < NTOK; t += NGW) {
        const int b = t >> 11; const float* m = MOD + (size_t)b * 6144;
        f32x4 acc[4]; float ss = 0.f;
#pragma unroll
        for (int j = 0; j < 4; ++j) { acc[j] = *(const f32x4*)(POUT + ((size_t)(2 * j + (lane >> 5)) * NTOK + t) * 128 + 4 * (lane & 31)); ss += (acc[j].x * acc[j].x + acc[j].y * acc[j].y) + (acc[j].z * acc[j].z + acc[j].w * acc[j].w); }
        const float rstd = rsqrtf(wave_sum(ss) * (1.0f / DM) + EPSV);
#pragma unroll
        for (int j = 0; j < 4; ++j) {
            const f32x4 gn = ((const f32x4*)P.in[I_NPOSTFFN])[64 * j + lane], g2 = ((const f32x4*)(m + 5120))[64 * j + lane];
            f32x4* op = (f32x4*)(P.out + (size_t)t * DM) + 64 * j + lane;
            *op = *op + g2 * (acc[j] * rstd * gn);
        }
    }
}

template <int PLO, int PHI> __global__ void __launch_bounds__(NTHREADS, 2) fwd_megakernel(Params P) {
    extern __shared__ __attribute__((aligned(16))) unsigned char lds_raw[];
    LAS unsigned char* lds = (LAS unsigned char*)lds_raw;
    cg::grid_group grid = cg::this_grid();
    volatile LAS unsigned* xst = (volatile LAS unsigned*)(lds + LDS_BYTES - 16);
    if (threadIdx.x == 0) { xst[0] = 0u; xst[1] = 0u; }
    __syncthreads();
    XcdBarrier xbar = xcd_barrier_post((unsigned*)P.ws + (PLO > 0 ? 4096 : 0), xst);
    unsigned char* ws = P.ws;
    const int lo = P.ph_lo, hi = P.ph_hi;
    if (TIMESEC && PLO > 0 && blockIdx.x == 0 && threadIdx.x == 0) ((volatile unsigned long long*)(P.ws + 32768))[1] = 0ull;
#define IN(k) (PLO <= (k) && (k) < PHI && lo <= (k) && (k) < hi)
#define SEAM(k) do { if (IN(k) && IN((k) + 1)) { if ((k) == PLO) grid.sync(); else xcd_barrier(xbar); } } while (0)
#define RUN(k, ...) do { if (IN(k)) { TS_BEGIN(100 + (k)); TS_BEGIN(200 + (k)); __VA_ARGS__; TS_END(100 + (k)); } SEAM(k); if (IN(k)) TS_END(200 + (k)); } while (0)
    RUN(0, phase0(P, lds));
    RUN(1, phase1(P));
    RUN(2, {
        run_gemm(lds, (const bf16_t*)(ws + WS_HC), (const bf16_t*)(ws + WS_WIN) + (size_t)512 * 1024, NCTX, 1024, 1024, FPlain{(bf16_t*)(ws + WS_CKV), 1024});
        run_gemm(lds, (const bf16_t*)(ws + WS_HX), (const bf16_t*)(ws + WS_WIN), NTOK, 2048, 1024, FQkvg{(bf16_t*)(ws + WS_QKVG), (const float*)(ws + WS_ROPE), (const float*)(ws + WS_ROPE) + 2048 * 32});
        run_gemm(lds, (const bf16_t*)(ws + WS_WF), (const bf16_t*)(ws + WS_HX), 1024, NTOK, 1024, FFnetT{(bf16_t*)(ws + WS_FT)});
    });
    RUN(3, {
        run_gemm(lds, (const bf16_t*)(ws + WS_DFT), (const bf16_t*)(ws + WS_FT), 2048, 8192, 4096, FFnetOut{(bf16_t*)(ws + WS_MIX)});
        for (int item = blockIdx.x; item < 256; item += gridDim.x) retention_item(P, lds, item);
    });
    RUN(4, {
        pg8::Gemm g{(const bf16_t*)(ws + WS_MIX), (const bf16_t*)(ws + WS_WOUT), NTOK, 1024, 1024}; pg8::StaticOrder S; S.init(NTOK, 1024, (int)gridDim.x, (int)blockIdx.x);
        pg8::EpiF32 E{(float*)(ws + WS_QKVG), 1024};
        pg8::gemm_phase<pg8::EpiF32, pg8::StaticOrder>(lds, g, S, E);
    });
    RUN(5, phase5(P));
    RUN(6, run_gemm(lds, (const bf16_t*)(ws + WS_HX), (const bf16_t*)(ws + WS_WQ), NTOK, 2048, 1024, FPlain{(bf16_t*)(ws + WS_FT), 2048}));
    RUN(7, phase7(P, lds));
    RUN(8, phase8<0>(P, lds, (float*)(ws + WS_PART)));
    if (TIMESEC == 3 && SPLITK > 0 && IN(8)) { grid.sync(); TS_BEGIN(3); phase8<VARIANT>(P, lds, (float*)(ws + WS_POUT)); TS_END(3); grid.sync(); }
    RUN(9, phase9(P, lds));
    RUN(10, phase10(P, lds));
    if (IN(11)) phase11(P);
    if (TIMESEC && PLO > 0 && PHI == 12 && blockIdx.x == 0 && threadIdx.x == 0) {
        const unsigned long long dt = ((volatile unsigned long long*)(P.ws + 32768))[1] * TSK, t0 = __builtin_amdgcn_s_memrealtime();
        while (__builtin_amdgcn_s_memrealtime() - t0 < dt) __builtin_amdgcn_s_sleep(16);
    }
#undef RUN
#undef IN
#undef SEAM
}

template <int PLO, int PHI> static hipError_t launch_range(const Params& p0, int lo, int hi, int variant, int grid, hipStream_t stream) {
    Params p = p0; p.ph_lo = lo; p.ph_hi = hi; p.variant = variant;
    void* args[] = {&p};
    return hipLaunchCooperativeKernel((const void*)fwd_megakernel<PLO, PHI>, dim3(grid), dim3(NTHREADS), args, LDS_BYTES, stream);
}
extern "C" void kernel_launch(void* const* d_in, const int* in_sizes, int n_in, void* d_out, int out_size, void* d_ws, size_t ws_size, hipStream_t stream) {
    static int grid = 0;
    if (grid == 0) {
        int dev = 0, cus = 0;
        (void)hipGetDevice(&dev);
        (void)hipDeviceGetAttribute(&cus, hipDeviceAttributeMultiprocessorCount, dev);
        if (SPLITK == 0) (void)hipFuncSetAttribute((const void*)fwd_megakernel<0, (SPLITK > 0 ? SPLITK : 12)>, hipFuncAttributeMaxDynamicSharedMemorySize, LDS_BYTES);
        if (SPLITK > 0) {
            (void)hipFuncSetAttribute((const void*)fwd_megakernel<0, (SPLITK > 0 ? SPLITK : 12)>, hipFuncAttributeMaxDynamicSharedMemorySize, LDS_BYTES);
            (void)hipFuncSetAttribute((const void*)fwd_megakernel<(SPLITK > 0 ? SPLITK : 0), 12>, hipFuncAttributeMaxDynamicSharedMemorySize, LDS_BYTES);
        }
        grid = cus;
        if (ws_size < WS_END || n_in != 20) fprintf(stderr, "kernel_launch: unexpected ws_size %zu / n_in %d\n", ws_size, n_in);
        (void)hipGetLastError();
    }
    Params p{};
    for (int i = 0; i < 20; ++i) p.in[i] = (const float*)d_in[i];
    p.out = (float*)d_out; p.ws = (unsigned char*)d_ws;
    hipError_t e = hipMemsetAsync(d_ws, 0, 32768, stream);
    if (e != hipSuccess) fprintf(stderr, "memset failed\n");
    if (SPLITK > 0) {
        e = launch_range<0, (SPLITK > 0 ? SPLITK : 12)>(p, 0, 12, 0, grid, stream);
        if (e == hipSuccess) e = launch_range<(SPLITK > 0 ? SPLITK : 0), 12>(p, 0, 12, 0, grid, stream);
    } else if (DUPK >= 0) {
        e = launch_range<0, (SPLITK > 0 ? SPLITK : 12)>(p, 0, DUPK + 1, 0, grid, stream);
        if (e == hipSuccess) e = launch_range<0, (SPLITK > 0 ? SPLITK : 12)>(p, DUPK, 12, VARIANT, grid, stream);
    } else {
        e = launch_range<0, (SPLITK > 0 ? SPLITK : 12)>(p, 0, 12, 0, grid, stream);
    }
    if (e != hipSuccess) fprintf(stderr, "cooperative launch failed: %s (grid %d)\n", hipGetErrorString(e), grid);
}
```

```cpp
#include <hip/hip_runtime.h>
#include <hip/hip_cooperative_groups.h>
#include <cstdio>
namespace cg = cooperative_groups;
#define VARIANT 0
#define SPLITK 0
#define TIMESEC 0
#define TSK 20
#define TS_BEGIN(id) do { if (TIMESEC == (id) && SPLITK > 0 && blockIdx.x == 0 && threadIdx.x == 0) ((volatile unsigned long long*)(P.ws + 32768))[0] = __builtin_amdgcn_s_memrealtime(); } while (0)
#define TS_END(id) do { if (TIMESEC == (id) && SPLITK > 0 && blockIdx.x == 0 && threadIdx.x == 0) { volatile unsigned long long* _p = (volatile unsigned long long*)(P.ws + 32768); _p[1] = _p[1] + (__builtin_amdgcn_s_memrealtime() - _p[0]); } } while (0)
#define DUPK -1

#define DI __device__ __forceinline__
#define LAS __attribute__((address_space(3)))
typedef unsigned short bf16_t;
typedef short bf16x8 __attribute__((ext_vector_type(8)));
typedef float f32x4 __attribute__((ext_vector_type(4)));
typedef float f32x16 __attribute__((ext_vector_type(16)));
typedef unsigned u32x4 __attribute__((ext_vector_type(4)));
typedef unsigned u32x2 __attribute__((ext_vector_type(2)));

constexpr int NB = 16, SEQ = 2048, DM = 1024, NTOK = NB * SEQ, CTXL = 256, NCTX = NB * CTXL;
constexpr int INW = 2560, F_OFF = 2048;
constexpr float EPSV = 1e-6f;
constexpr int NTHREADS = 512, NWAVES = 8;
constexpr int LDS_BYTES = 160 * 1024;
constexpr int U_TAB = 131072, U_HST = 3072, U_LST = 960, U_TOK = 96, U_NIT = (NTOK + U_TOK - 1) / U_TOK;
constexpr int NTOKP = U_NIT * U_TOK;

constexpr size_t MB = 1024 * 1024;
constexpr size_t WS_MOD = 64 * 1024;
constexpr size_t WS_ROPE = 512 * 1024;
constexpr size_t WS_KEYS = 1 * MB;
constexpr size_t WS_WIN = 2 * MB;
constexpr size_t WS_WF = 6 * MB;
constexpr size_t WS_WOUT = 8 * MB;
constexpr size_t WS_WQ = 10 * MB;
constexpr size_t WS_DFT = 14 * MB;
constexpr size_t WS_HC = 30 * MB;
constexpr size_t WS_CKV = 38 * MB;
constexpr size_t WS_IDS = 46 * MB;
constexpr size_t WS_WTS = 62 * MB;
constexpr size_t WS_HX = 80 * MB;
constexpr size_t WS_QKVG = 144 * MB;
constexpr size_t WS_FT = 272 * MB;
constexpr size_t WS_MIX = 336 * MB;
constexpr size_t WS_SB = 400 * MB;
constexpr size_t WS_H2S = 416 * MB;
constexpr size_t WS_END = 484 * MB;
constexpr size_t WS_SID = 30 * MB;
constexpr size_t WS_SIDB = 46 * MB;
constexpr size_t WS_SWT = 400 * MB;
constexpr size_t WS_CIT = 14 * MB;
constexpr size_t WS_PART = 144 * MB;
constexpr size_t WS_POUT = 272 * MB;

namespace pg8 {
#define PG8_LAS __attribute__((address_space(3)))
constexpr int BM = 256, BK = 64, HALF = 128, HTB = HALF * BK * 2, STAGE_BYTES = 8 * HTB, NXCD = 8, WGM = 8;
__host__ __device__ __forceinline__ int lds_byte(int r, int c) { const int st = (r >> 4) * 2 + (c >> 5), rr = r & 15, cc = c & 31, ob = rr * 64 + cc * 2; return st * 1024 + (ob ^ (((ob >> 9) & 1) << 5)); }
__host__ __device__ __forceinline__ void stage_rc(int b, int& R, int& C) { const int st = b / 1024, sb = b % 1024, swz = sb ^ (((sb >> 9) & 1) << 5); R = (st >> 1) * 16 + swz / 64; C = (st & 1) * 32 + (swz % 64) / 2; }
__host__ __device__ __forceinline__ int perm32(int rho) { const int n = rho >> 4, i = rho & 15; return 8 * (i >> 2) + 4 * n + (i & 3); }
struct Unit { int pm, pn; };
struct Gemm { const bf16_t* A; const bf16_t* Bt; int M, N, K; };
struct StaticOrder {
    int nM, nN, nwg, G, c;
    __host__ __device__ void init(int M, int N, int G_, int c_) { nM = M / BM; nN = N / BM; nwg = nM * nN; G = G_; c = c_; }
    __host__ __device__ bool next(int i, Unit& u) const {
        const long L = (long)i * G + c; if (L >= nwg) return false;
        int wgid = (int)L; { const int q = nwg / NXCD, r = nwg % NXCD, xcd = wgid % NXCD, off = wgid / NXCD; wgid = (xcd < r ? xcd * (q + 1) : r * (q + 1) + (xcd - r) * q) + off; }
        const int nig = WGM * nN, gid = wgid / nig, fm = gid * WGM, gsz = (nM - fm) < WGM ? (nM - fm) : WGM;
        u.pm = fm + ((wgid % nig) % gsz); u.pn = (wgid % nig) / gsz; return true;
    }
    __device__ __forceinline__ void a_ready(const Unit&) const {}
    __device__ __forceinline__ void done(const Unit&) const {}
};
__device__ __forceinline__ unsigned cvt_pk_bf16(float lo, float hi) { unsigned r; asm volatile("v_cvt_pk_bf16_f32 %0, %1, %2" : "=v"(r) : "v"(lo), "v"(hi)); return r; }

struct EpiF32 {
    static constexpr bool PERM = false;
    float* C; int ldc;
    __device__ __forceinline__ void operator()(const f32x4 (&acc)[2][2][4][2], const Unit& u, int wr, int wc, int fr, int fq) const {
        const int row0 = u.pm * BM + wr * 64 + fr, col0 = u.pn * BM + wc * 32 + 4 * fq;
#pragma unroll
        for (int ai = 0; ai < 2; ++ai)
#pragma unroll
            for (int m = 0; m < 4; ++m) { float* rowp = C + (size_t)(row0 + ai * HALF + m * 16) * ldc + col0;
#pragma unroll
                for (int bj = 0; bj < 2; ++bj)
#pragma unroll
                    for (int n = 0; n < 2; ++n) *(f32x4*)(rowp + bj * HALF + n * 16) = acc[ai][bj][m][n]; }
    }
};
template <class F> struct EpiBf16F {
    static constexpr bool PERM = true;
    F f;
    __device__ __forceinline__ void operator()(const f32x4 (&acc)[2][2][4][2], const Unit& u, int wr, int wc, int fr, int fq) const {
        const int row0 = u.pm * BM + wr * 64 + fr, col0 = u.pn * BM + wc * 32 + 8 * fq;
#pragma unroll
        for (int ai = 0; ai < 2; ++ai)
#pragma unroll
            for (int m = 0; m < 4; ++m)
#pragma unroll
                for (int bj = 0; bj < 2; ++bj) f(row0 + ai * HALF + m * 16, col0 + bj * HALF, acc[ai][bj][m][0], acc[ai][bj][m][1]);
    }
};

template <class Epi, class Sched>
__device__ __forceinline__ void gemm_phase(PG8_LAS unsigned char* lds, const Gemm g, const Sched& S, const Epi& E) {
    const int tid = threadIdx.x, wid = __builtin_amdgcn_readfirstlane(tid >> 6), lane = tid & 63, wr = wid >> 2, wc = wid & 3, fr = lane & 15, fq = lane >> 4;
    const int K = g.K, nt = K / BK;
    unsigned voffA[2], voffB[2];
#pragma unroll
    for (int i = 0; i < 2; ++i) { int R, C; stage_rc(tid * 16 + i * 8192, R, C); const int Rb = Epi::PERM ? ((R & ~31) + perm32(R & 31)) : R;
        voffA[i] = (unsigned)(R * K + C) * 2u; voffB[i] = (unsigned)(Rb * K + C) * 2u; }
    const size_t kstep = (size_t)(BK * 2);
    const size_t hstep = (size_t)HALF * K * 2;
    const size_t tstep = 2 * hstep;
    const unsigned ldsw = (unsigned)wid * 1024u;
    const int aoff = lds_byte(wr * 64 + fr, fq * 8), boff = lds_byte(wc * 32 + fr, fq * 8);
#define PG8_SA(b, h) (((b) * 2 + (h)) * HTB)
#define PG8_SB(b, h) ((4 + (b) * 2 + (h)) * HTB)
#define PG8_STAGE(bufoff, gbase, voff) do { _Pragma("unroll") for (int _i = 0; _i < 2; ++_i) \
        __builtin_amdgcn_global_load_lds((const unsigned*)((const char*)(gbase) + (voff)[_i]), (PG8_LAS unsigned*)(lds + (bufoff) + ldsw + _i * 8192), 16, 0, 0); } while (0)
#define PG8_LDA(dst, b, h) do { _Pragma("unroll") for (int m = 0; m < 4; ++m) _Pragma("unroll") for (int k = 0; k < 2; ++k) dst[m][k] = *(const PG8_LAS bf16x8*)(lds + PG8_SA(b, h) + aoff + m * 2048 + k * 1024); } while (0)
#define PG8_LDB(dst, b, h) do { _Pragma("unroll") for (int n = 0; n < 2; ++n) _Pragma("unroll") for (int k = 0; k < 2; ++k) dst[n][k] = *(const PG8_LAS bf16x8*)(lds + PG8_SB(b, h) + boff + n * 2048 + k * 1024); } while (0)
#define PG8_MMA(ai, bj, At, Bt) do { __builtin_amdgcn_s_setprio(1); _Pragma("unroll") for (int m = 0; m < 4; ++m) _Pragma("unroll") for (int n = 0; n < 2; ++n) _Pragma("unroll") for (int k = 0; k < 2; ++k) \
        acc[ai][bj][m][n] = __builtin_amdgcn_mfma_f32_16x16x32_bf16(Bt[n][k], At[m][k], acc[ai][bj][m][n], 0, 0, 0); __builtin_amdgcn_s_setprio(0); } while (0)
#define PG8_WAIT_V(n) asm volatile("s_waitcnt vmcnt(" #n ")" ::: "memory")
#define PG8_WAIT_L(n) asm volatile("s_waitcnt lgkmcnt(" #n ")" ::: "memory")
#define PG8_BAR __builtin_amdgcn_s_barrier()
#define PG8_SCHED __builtin_amdgcn_sched_barrier(0)
    Unit cur, nxt; int ui = 0;
    if (!S.next(0, cur)) return;
    f32x4 acc[2][2][4][2];
#pragma unroll
    for (int a = 0; a < 2; ++a)
#pragma unroll
        for (int b = 0; b < 2; ++b)
#pragma unroll
            for (int m = 0; m < 4; ++m)
#pragma unroll
                for (int n = 0; n < 2; ++n) acc[a][b][m][n] = (f32x4){0.f, 0.f, 0.f, 0.f};
    bf16x8 At[4][2], B0[2][2], B1[2][2];
    const char* cA = (const char*)g.A + (size_t)cur.pm * tstep; const char* cB = (const char*)g.Bt + (size_t)cur.pn * tstep;
    S.a_ready(cur);
    PG8_STAGE(PG8_SB(0, 0), cB, voffB); PG8_STAGE(PG8_SA(0, 0), cA, voffA); PG8_STAGE(PG8_SB(0, 1), cB + hstep, voffB); PG8_STAGE(PG8_SA(0, 1), cA + hstep, voffA);
    if (wr == 1) PG8_BAR;
    PG8_WAIT_V(4); PG8_BAR;
    PG8_STAGE(PG8_SB(1, 0), cB + kstep, voffB); PG8_STAGE(PG8_SA(1, 0), cA + kstep, voffA); PG8_STAGE(PG8_SB(1, 1), cB + hstep + kstep, voffB);
    PG8_WAIT_V(6); PG8_BAR;
    for (;;) {
        const bool has_next = S.next(ui + 1, nxt);
        const char* nA = has_next ? (const char*)g.A + (size_t)nxt.pm * tstep : cA; const char* nB = has_next ? (const char*)g.Bt + (size_t)nxt.pn * tstep : cB;
        for (int t = 0; t < nt; t += 2) {
            const bool last = (t == nt - 2);
            const char* a1 = cA + (size_t)(t + 1) * kstep;
            const char* a2 = last ? nA : cA + (size_t)(t + 2) * kstep; const char* b2 = last ? nB : cB + (size_t)(t + 2) * kstep;
            const char* a3 = a2 + kstep; const char* b3 = b2 + kstep;
            if (last && has_next) S.a_ready(nxt);
            PG8_LDB(B0, 0, 0); PG8_SCHED; PG8_LDA(At, 0, 0); PG8_STAGE(PG8_SA(1, 1), a1 + hstep, voffA);
            PG8_WAIT_L(8); PG8_BAR; PG8_WAIT_L(0); PG8_MMA(0, 0, At, B0); PG8_BAR; PG8_SCHED;
            PG8_LDB(B1, 0, 1); PG8_STAGE(PG8_SB(0, 0), b2, voffB);
            PG8_BAR; PG8_WAIT_L(0); PG8_MMA(0, 1, At, B1); PG8_BAR;
            PG8_LDA(At, 0, 1); PG8_STAGE(PG8_SA(0, 0), a2, voffA);
            PG8_BAR; PG8_WAIT_L(0); PG8_MMA(1, 0, At, B0); PG8_BAR; PG8_SCHED;
            PG8_STAGE(PG8_SB(0, 1), b2 + hstep, voffB);
            PG8_WAIT_V(6); PG8_BAR; PG8_MMA(1, 1, At, B1); PG8_BAR;
            PG8_LDB(B0, 1, 0); PG8_SCHED; PG8_LDA(At, 1, 0); PG8_STAGE(PG8_SA(0, 1), a2 + hstep, voffA);
            PG8_WAIT_L(8); PG8_BAR; PG8_WAIT_L(0); PG8_MMA(0, 0, At, B0); PG8_BAR; PG8_SCHED;
            PG8_LDB(B1, 1, 1); PG8_STAGE(PG8_SB(1, 0), b3, voffB);
            PG8_BAR; PG8_WAIT_L(0); PG8_MMA(0, 1, At, B1); PG8_BAR;
            PG8_LDA(At, 1, 1); PG8_STAGE(PG8_SA(1, 0), a3, voffA);
            PG8_BAR; PG8_WAIT_L(0); PG8_MMA(1, 0, At, B0); PG8_BAR; PG8_SCHED;
            PG8_STAGE(PG8_SB(1, 1), b3 + hstep, voffB);
            PG8_WAIT_V(6); PG8_BAR; PG8_MMA(1, 1, At, B1); PG8_BAR;
        }
        E(acc, cur, wr, wc, fr, fq); S.done(cur);
        if (!has_next) break;
#pragma unroll
        for (int a = 0; a < 2; ++a)
#pragma unroll
            for (int b = 0; b < 2; ++b)
#pragma unroll
                for (int m = 0; m < 4; ++m)
#pragma unroll
                    for (int n = 0; n < 2; ++n) acc[a][b][m][n] = (f32x4){0.f, 0.f, 0.f, 0.f};
        cur = nxt; cA = nA; cB = nB; ++ui;
    }
    PG8_WAIT_V(0);
    if (wr == 0) PG8_BAR;
    PG8_BAR;
#undef PG8_SA
#undef PG8_SB
#undef PG8_STAGE
#undef PG8_LDA
#undef PG8_LDB
#undef PG8_MMA
#undef PG8_WAIT_V
#undef PG8_WAIT_L
#undef PG8_BAR
#undef PG8_SCHED
}
}

DI unsigned pk2(float lo, float hi) { return pg8::cvt_pk_bf16(lo, hi); }
DI bf16_t f2bf(float f) { return (bf16_t)(pk2(f, 0.f) & 0xffffu); }
DI float bf2f(bf16_t b) { return __uint_as_float(((unsigned)b) << 16); }
DI float bflo(unsigned w) { return __uint_as_float(w << 16); }
DI float bfhi(unsigned w) { return __uint_as_float(w & 0xffff0000u); }
DI float wave_sum(float v) {
#pragma unroll
    for (int o = 1; o < 64; o <<= 1) v += __shfl_xor(v, o);
    return v;
}
DI float siluf(float x) { return x / (1.f + __expf(-x)); }
DI float gelu_erf(float a) { return 0.5f * a * (1.f + erff(a * 0.70710678118654752f)); }
#define LDS_WAIT() asm volatile("s_waitcnt lgkmcnt(0)" ::: "memory")
#define MFMA32(a, b, c) __builtin_amdgcn_mfma_f32_32x32x16_bf16((a), (b), (c), 0, 0, 0)
DI int crow(int reg, int h) { return (reg & 3) + 8 * (reg >> 2) + 4 * h; }
DI f32x16 zero16() { f32x16 z;
#pragma unroll
    for (int i = 0; i < 16; ++i) z[i] = 0.f;
    return z; }


#define XB_TMO      128
#define XB_XCNT(j)  (256  + 64 * (j))
#define XB_XSUB(j)  (1280 + 64 * (j))
#define XB_XGEN(j)  (2304 + 64 * (j))
#define XB_TOP      3328
#define XB_TOPGEN   3392
#define XCD_BAR_WORDS 3456
#define XB_SPIN_CAP (1u << 22)
DI unsigned xb_ld(unsigned* p)              { return __hip_atomic_load(p, __ATOMIC_RELAXED, __HIP_MEMORY_SCOPE_AGENT); }
DI unsigned xb_add(unsigned* p, unsigned v) { return __hip_atomic_fetch_add(p, v, __ATOMIC_RELAXED, __HIP_MEMORY_SCOPE_AGENT); }
DI unsigned xb_xcc_id() { return (unsigned)__builtin_amdgcn_s_getreg((3 << 11) | 20) & 0xFu; }
#define XB_SPIN(cond, bar) do { unsigned _sp = 0; while (cond) { __builtin_amdgcn_s_sleep(1); \
    if ((++_sp & 255u) == 0u) { if (xb_ld(&(bar)[XB_TMO])) break; if (_sp > XB_SPIN_CAP) { atomicAdd(&(bar)[XB_TMO], 1u); break; } } } } while (0)
struct XcdBarrier { unsigned* bar; unsigned x; volatile LAS unsigned* st; };
DI XcdBarrier xcd_barrier_post(unsigned* bar, volatile LAS unsigned* st) {
    XcdBarrier b; b.bar = bar; b.x = xb_xcc_id(); b.st = st;
    if (threadIdx.x == 0) (void)xb_add(&bar[XB_XCNT(b.x)], 1u);
    return b;
}
DI void xcd_barrier_complete(unsigned* bar, unsigned x, unsigned& nloc, unsigned& nx) {
    const unsigned G = gridDim.x * gridDim.y * gridDim.z;
    unsigned sum, cnt, mine, sp = 0u;
    for (;;) {
        sum = 0u; cnt = 0u; mine = 0u;
#pragma unroll
        for (unsigned j = 0; j < 16; ++j) { const unsigned c = xb_ld(&bar[XB_XCNT(j)]); sum += c; cnt += (c > 0u) ? 1u : 0u; mine = (j == x) ? c : mine; }
        if (sum == G) break;
        __builtin_amdgcn_s_sleep(1);
        if ((++sp & 255u) == 0u) { if (xb_ld(&bar[XB_TMO])) break; if (sp > XB_SPIN_CAP) { atomicAdd(&bar[XB_TMO], 1u); break; } }
    }
    nloc = mine > 0u ? mine : 1u; nx = cnt > 0u ? cnt : 1u;
}
DI void xcd_barrier(const XcdBarrier& b) {
    asm volatile("s_waitcnt vmcnt(0)" ::: "memory");
    __syncthreads();
    if (threadIdx.x == 0) {
        unsigned* bar = b.bar;
        __builtin_amdgcn_s_waitcnt(0);
        unsigned nloc = b.st[0], nx = b.st[1];
        if (nloc == 0u) { xcd_barrier_complete(bar, b.x, nloc, nx); b.st[0] = nloc; b.st[1] = nx; }
        const unsigned old = xb_add(&bar[XB_XSUB(b.x)], 1u);
        const unsigned gen = old / nloc;
        if (old + 1u == (gen + 1u) * nloc) {
            __builtin_amdgcn_fence(__ATOMIC_RELEASE, "agent");
            asm volatile("s_waitcnt vmcnt(0)" ::: "memory");
            const unsigned og = xb_add(&bar[XB_TOP], 1u);
            const unsigned tg = og / nx;
            if (og + 1u == (tg + 1u) * nx) xb_add(&bar[XB_TOPGEN], 1u);
            else XB_SPIN(xb_ld(&bar[XB_TOPGEN]) == tg, bar);
            __builtin_amdgcn_fence(__ATOMIC_ACQUIRE, "agent");
            xb_add(&bar[XB_XGEN(b.x)], 1u);
            asm volatile("s_waitcnt vmcnt(0)" ::: "memory");
        } else {
            XB_SPIN(xb_ld(&bar[XB_XGEN(b.x)]) == gen, bar);
            __builtin_amdgcn_fence(__ATOMIC_ACQUIRE, "agent");
            asm volatile("s_waitcnt vmcnt(0)" ::: "memory");
        }
    }
    __syncthreads();
}

struct Params { const float* in[20]; float* out; unsigned char* ws; int ph_lo, ph_hi, variant, pad; };
enum { I_X = 0, I_C, I_CTX, I_CCTX, I_WADA, I_BADA, I_NPREMIX, I_NPOSTMIX, I_WIN, I_DECF, I_DECB, I_RETGAIN, I_WOUT, I_NPREFFN, I_NPOSTFFN, I_WQ, I_KEYS1, I_KEYS2, I_U, I_V };

DI int win_srccol(int n) { if (n < 1024) { const int p = n & 63; return (n & ~63) + (p >> 1) + 32 * (p & 1); } return n; }
DI void p0_transpose_item(const float* W, int ldw, int nout, bf16_t* WT, int mode, LAS float* scr, int item, int lane) {
    const int nblk = nout / 32, kb = item / nblk, nb = item % nblk, k0 = 64 * kb, n0 = 32 * nb;
    const int nn = n0 + (lane & 31);
    const int sc = mode ? win_srccol(nn) : nn;
    const float scale = (mode && nn >= 512 && nn < 1024) ? 0.125f : 1.0f;
#pragma unroll 8
    for (int i = 0; i < 32; ++i) { const int kk = 2 * i + (lane >> 5); scr[kk * 33 + (lane & 31)] = W[(size_t)(k0 + kk) * ldw + sc] * scale; }
    LDS_WAIT();
    const int c = lane & 7;
#pragma unroll
    for (int j = 0; j < 4; ++j) { const int n = (lane >> 3) + 8 * j; const LAS float* s = scr + (8 * c) * 33 + n;
        u32x4 o; o.x = pk2(s[0 * 33], s[1 * 33]); o.y = pk2(s[2 * 33], s[3 * 33]); o.z = pk2(s[4 * 33], s[5 * 33]); o.w = pk2(s[6 * 33], s[7 * 33]);
        *(u32x4*)(WT + (size_t)(n0 + n) * 1024 + k0 + 8 * c) = o; }
    LDS_WAIT();
}

DI void phase0(const Params& P, LAS unsigned char* lds) {
    const int tid = threadIdx.x, lane = tid & 63, wave = tid >> 6;
    const int gw = blockIdx.x * NWAVES + wave, NGW = gridDim.x * NWAVES;
    const int gt = blockIdx.x * NTHREADS + tid, NGT = gridDim.x * NTHREADS;
    unsigned char* ws = P.ws;
    LAS float* scr = (LAS float*)(lds + wave * 8704);
    LAS float* ctab = (LAS float*)(lds + 69632);
    LAS float* stab = ctab + 128;
    LAS float* svec = (LAS float*)(lds + 71680);
    if (tid < 128) { float s, c; sincospif((float)tid * (1.0f / 64.0f), &s, &c); ctab[tid] = c; stab[tid] = s; }
    for (int i = tid; i < 17 * 1024; i += NTHREADS) { const float v = (i < 16384) ? P.in[I_C][i] : P.in[I_CCTX][i - 16384]; svec[i] = siluf(v); }
    __syncthreads();
    {
        bf16_t* WIN = (bf16_t*)(ws + WS_WIN); bf16_t* WOUT = (bf16_t*)(ws + WS_WOUT); bf16_t* WQ = (bf16_t*)(ws + WS_WQ);
        constexpr int I1 = 16 * 64, I2 = 16 * 32, I3 = 16 * 64;
        for (int it = gw; it < I1 + I2 + I3; it += NGW) {
            int r = it;
            if (r < I1) { p0_transpose_item(P.in[I_WIN], INW, 2048, WIN, 1, scr, r, lane); continue; } r -= I1;
            if (r < I2) { p0_transpose_item(P.in[I_WOUT], 1024, 1024, WOUT, 0, scr, r, lane); continue; } r -= I2;
            p0_transpose_item(P.in[I_WQ], 2048, 2048, WQ, 0, scr, r, lane);
        }
    }
    {
        bf16_t* WF = (bf16_t*)(ws + WS_WF);
        for (int it = gw; it < 4096; it += NGW) {
            const int kk = it >> 2, g = it & 3;
            const float* src = P.in[I_WIN] + (size_t)kk * INW + F_OFF + g * 128;
            scr[lane] = src[lane]; scr[lane + 64] = src[lane + 64];
            LDS_WAIT();
#pragma unroll
            for (int q = 0; q < 2; ++q) {
                const int l = lane + 64 * q; float ac = 0.f, as = 0.f;
                for (int c = 0; c < 128; ++c) { const float f = scr[c]; const int m = (c * l) & 127; ac += f * ctab[m]; as += f * stab[m]; }
                WF[(size_t)((g * 2 + 0) * 128 + l) * 1024 + kk] = f2bf(ac);
                WF[(size_t)((g * 2 + 1) * 128 + l) * 1024 + kk] = f2bf(as);
            }
            LDS_WAIT();
        }
    }
    {
        bf16_t* DFT = (bf16_t*)(ws + WS_DFT);
        for (int idx = gt; idx < 2048 * 2048; idx += NGT) {
            const int k = idx >> 11, c2 = (idx & 2047) * 2, p = c2 >> 11, n0 = c2 & 2047;
            float s0, c0, s1, c1;
            sincospif((float)((n0 * k) & 2047) * (1.0f / 1024.0f), &s0, &c0);
            sincospif((float)(((n0 + 1) * k) & 2047) * (1.0f / 1024.0f), &s1, &c1);
            const float v0 = (p ? -s0 : c0) * (1.0f / 512.0f), v1 = (p ? -s1 : c1) * (1.0f / 512.0f);
            *(unsigned*)(DFT + (size_t)k * 4096 + c2) = pk2(v0, v1);
        }
    }
    {
        float* RC = (float*)(ws + WS_ROPE); float* RS = RC + 2048 * 32;
        for (int idx = gt; idx < 2048 * 32; idx += NGT) {
            const int n = idx >> 5, j = idx & 31; const float pos = (float)((j < 16) ? (n >> 6) : (n & 63));
            const float freq = powf(10000.0f, -(float)(j & 15) * (1.0f / 16.0f)); const float ang = pos * freq;
            RC[idx] = cosf(ang); RS[idx] = sinf(ang);
        }
        bf16_t* KEYS = (bf16_t*)(ws + WS_KEYS);
        for (int idx = gt; idx < 2 * 128 * 128; idx += NGT) KEYS[idx] = f2bf(idx < 16384 ? P.in[I_KEYS1][idx] : P.in[I_KEYS2][idx - 16384]);
    }
    {
        float* MOD = (float*)(ws + WS_MOD);
        for (int cb = blockIdx.x; cb < 256; cb += gridDim.x) {
            if (wave < 6) {
                const int col = cb * 24 + wave * 4;
                f32x4 acc[17];
#pragma unroll
                for (int r = 0; r < 17; ++r) acc[r] = (f32x4){0.f, 0.f, 0.f, 0.f};
#pragma unroll 1
                for (int i = 0; i < 16; ++i) {
                    const int k = lane + 64 * i;
                    const f32x4 w = *(const f32x4*)(P.in[I_WADA] + (size_t)k * 6144 + col);
#pragma unroll
                    for (int r = 0; r < 17; ++r) { const float s = svec[r * 1024 + k]; acc[r] += w * s; }
                }
#pragma unroll
                for (int r = 0; r < 17; ++r) {
                    f32x4 a = acc[r];
#pragma unroll
                    for (int o = 1; o < 64; o <<= 1) { a.x += __shfl_xor(a.x, o); a.y += __shfl_xor(a.y, o); a.z += __shfl_xor(a.z, o); a.w += __shfl_xor(a.w, o); }
                    if (lane == 0) { const f32x4 bb = *(const f32x4*)(P.in[I_BADA] + col); *(f32x4*)(MOD + (size_t)r * 6144 + col) = a + bb; }
                }
            }
        }
    }
}

DI void norm_mod_row2(const float* xrow0, const float* xrow1, const float* gain, const float* sh0, const float* sc0, const float* sh1, const float* sc1, bf16_t* orow0, bf16_t* orow1, int lane) {
    const f32x4* xr0 = (const f32x4*)xrow0 + lane; const f32x4* xr1 = (const f32x4*)xrow1 + lane;
    f32x4 v0[4], v1[4]; float ss0 = 0.f, ss1 = 0.f;
#pragma unroll
    for (int j = 0; j < 4; ++j) { v0[j] = xr0[64 * j]; v1[j] = xr1[64 * j]; }
#pragma unroll
    for (int j = 0; j < 4; ++j) { ss0 += (v0[j].x * v0[j].x + v0[j].y * v0[j].y) + (v0[j].z * v0[j].z + v0[j].w * v0[j].w); ss1 += (v1[j].x * v1[j].x + v1[j].y * v1[j].y) + (v1[j].z * v1[j].z + v1[j].w * v1[j].w); }
    const float rstd0 = rsqrtf(wave_sum(ss0) * (1.0f / DM) + EPSV), rstd1 = rsqrtf(wave_sum(ss1) * (1.0f / DM) + EPSV);
#pragma unroll
    for (int j = 0; j < 4; ++j) {
        const f32x4 g = ((const f32x4*)gain)[64 * j + lane];
        const f32x4 s0 = ((const f32x4*)sc0)[64 * j + lane], h0 = ((const f32x4*)sh0)[64 * j + lane], s1 = ((const f32x4*)sc1)[64 * j + lane], h1 = ((const f32x4*)sh1)[64 * j + lane];
        const f32x4 y0 = v0[j] * rstd0 * g * (s0 + 1.0f) + h0, y1 = v1[j] * rstd1 * g * (s1 + 1.0f) + h1;
        u32x2 o0, o1; o0.x = pk2(y0.x, y0.y); o0.y = pk2(y0.z, y0.w); o1.x = pk2(y1.x, y1.y); o1.y = pk2(y1.z, y1.w);
        ((u32x2*)orow0)[64 * j + lane] = o0; ((u32x2*)orow1)[64 * j + lane] = o1;
    }
}
DI void phase1(const Params& P) {
    const int lane = threadIdx.x & 63, wave = threadIdx.x >> 6;
    const int gw = blockIdx.x * NWAVES + wave, NGW = gridDim.x * NWAVES;
    const float* MOD = (const float*)(P.ws + WS_MOD);
    bf16_t* HX = (bf16_t*)(P.ws + WS_HX); bf16_t* HC = (bf16_t*)(P.ws + WS_HC);
    for (int r = 2 * gw; r < NTOK + NCTX; r += 2 * NGW) {
        const float* x0; const float* x1; const float* m0; const float* m1; bf16_t* o0; bf16_t* o1;
        if (r < NTOK) { x0 = P.in[I_X] + (size_t)r * DM; x1 = x0 + DM; m0 = MOD + (size_t)(r >> 11) * 6144; m1 = MOD + (size_t)((r + 1) >> 11) * 6144; o0 = HX + (size_t)r * DM; o1 = o0 + DM; }
        else { const int rc = r - NTOK; x0 = P.in[I_CTX] + (size_t)rc * DM; x1 = x0 + DM; m0 = m1 = MOD + (size_t)16 * 6144; o0 = HC + (size_t)rc * DM; o1 = o0 + DM; }
        norm_mod_row2(x0, x1, P.in[I_NPREMIX], m0, m0 + 1024, m1, m1 + 1024, o0, o1, lane);
    }
}

struct FPlain { bf16_t* O; int ldc;
    DI void operator()(int row, int col0, const f32x4& v0, const f32x4& v1) const {
        u32x4 w; w.x = pk2(v0[0], v0[1]); w.y = pk2(v0[2], v0[3]); w.z = pk2(v1[0], v1[1]); w.w = pk2(v1[2], v1[3]);
        *(u32x4*)(O + (size_t)row * ldc + col0) = w; } };
struct FQkvg { bf16_t* O; const float* RC; const float* RS;
    DI void operator()(int row, int col0, const f32x4& a0, const f32x4& a1) const {
        f32x4 v0 = a0, v1 = a1;
        if (col0 < 1024) {
            const int n = row & 2047, j0 = (col0 & 63) >> 1;
            const f32x4 cs = *(const f32x4*)(RC + n * 32 + j0), sn = *(const f32x4*)(RS + n * 32 + j0);
            f32x4 r0, r1;
            r0[0] = v0[0] * cs[0] - v0[1] * sn[0]; r0[1] = v0[1] * cs[0] + v0[0] * sn[0];
            r0[2] = v0[2] * cs[1] - v0[3] * sn[1]; r0[3] = v0[3] * cs[1] + v0[2] * sn[1];
            r1[0] = v1[0] * cs[2] - v1[1] * sn[2]; r1[1] = v1[1] * cs[2] + v1[0] * sn[2];
            r1[2] = v1[2] * cs[3] - v1[3] * sn[3]; r1[3] = v1[3] * cs[3] + v1[2] * sn[3];
            v0 = r0; v1 = r1;
        }
        u32x4 w; w.x = pk2(v0[0], v0[1]); w.y = pk2(v0[2], v0[3]); w.z = pk2(v1[0], v1[1]); w.w = pk2(v1[2], v1[3]);
        *(u32x4*)(O + (size_t)row * 2048 + col0) = w; } };
struct FFnetT { bf16_t* FT;
    DI void operator()(int row, int col0, const f32x4& v0, const f32x4& v1) const {
        const int g = row >> 8, p = (row >> 7) & 1, l = row & 127, b = col0 >> 11, n = col0 & 2047;
        u32x4 w; w.x = pk2(v0[0], v0[1]); w.y = pk2(v0[2], v0[3]); w.z = pk2(v1[0], v1[1]); w.w = pk2(v1[2], v1[3]);
        *(u32x4*)(FT + (size_t)((b * 4 + g) * 128 + l) * 4096 + p * 2048 + n) = w; } };
struct FFnetOut { bf16_t* MIX;
    DI void operator()(int row, int col0, const f32x4& v0, const f32x4& v1) const {
        const int b = col0 >> 9, gc = col0 & 511;
        u32x4 w; w.x = pk2(v0[0], v0[1]); w.y = pk2(v0[2], v0[3]); w.z = pk2(v1[0], v1[1]); w.w = pk2(v1[2], v1[3]);
        *(u32x4*)(MIX + (size_t)(b * 2048 + row) * 1024 + 512 + gc) = w; } };

template <class F> DI void run_gemm(LAS unsigned char* lds, const bf16_t* A, const bf16_t* Bt, int M, int N, int K, const F& f) {
    pg8::Gemm g{A, Bt, M, N, K}; pg8::StaticOrder S; S.init(M, N, (int)gridDim.x, (int)blockIdx.x);
    pg8::EpiBf16F<F> E{f};
    pg8::gemm_phase<pg8::EpiBf16F<F>, pg8::StaticOrder>(lds, g, S, E);
}

constexpr int R_Q = 0, R_K = 18432, R_KFT = 36864, R_KBT = 54272, R_VT = 71680, R_P = 89088, R_SFT = 123904, R_SBT = 133120;
constexpr int LQ = 72, LT = 136, LO = 65;
constexpr int R_DTAB = 142336;

DI f32x16 mma_tile(const LAS bf16_t* A, int lda, const LAS bf16_t* Bt, int ldb, int K, f32x16 acc, int lane) {
    const int r = lane & 31, hh = lane >> 5;
    const LAS bf16_t* ap = A + r * lda + 8 * hh; const LAS bf16_t* bp = Bt + r * ldb + 8 * hh;
#pragma unroll 4
    for (int k0 = 0; k0 < K; k0 += 16) { const bf16x8 a = *(const LAS bf16x8*)(ap + k0); const bf16x8 b = *(const LAS bf16x8*)(bp + k0); acc = MFMA32(a, b, acc); }
    return acc;
}
DI void stage_chunk(LAS unsigned char* lds, const bf16_t* src, int stride, int colQ, int colK, int colV, float lgf, float ef0, float lgb, float eb0) {
    const int tid = threadIdx.x, j = tid >> 2, c0 = (tid & 3) * 16;
    const bf16_t* rowp = src + (size_t)j * stride;
    const u32x4 k0 = *(const u32x4*)(rowp + colK + c0), k1 = *(const u32x4*)(rowp + colK + c0 + 8);
    const u32x4 v0 = *(const u32x4*)(rowp + colV + c0), v1 = *(const u32x4*)(rowp + colV + c0 + 8);
    LAS bf16_t* Ks = (LAS bf16_t*)(lds + R_K); LAS bf16_t* KfT = (LAS bf16_t*)(lds + R_KFT); LAS bf16_t* KbT = (LAS bf16_t*)(lds + R_KBT); LAS bf16_t* VT = (LAS bf16_t*)(lds + R_VT);
    *(LAS u32x4*)(Ks + j * LQ + c0) = k0; *(LAS u32x4*)(Ks + j * LQ + c0 + 8) = k1;
    if (colQ >= 0) { const u32x4 q0 = *(const u32x4*)(rowp + colQ + c0), q1 = *(const u32x4*)(rowp + colQ + c0 + 8);
        LAS bf16_t* Qs = (LAS bf16_t*)(lds + R_Q); *(LAS u32x4*)(Qs + j * LQ + c0) = q0; *(LAS u32x4*)(Qs + j * LQ + c0 + 8) = q1; }
    const float wf = __expf(lgf * (ef0 - (float)j)), wb = __expf(lgb * (eb0 + (float)j));
    const unsigned kw[8] = {k0.x, k0.y, k0.z, k0.w, k1.x, k1.y, k1.z, k1.w};
    const unsigned vw[8] = {v0.x, v0.y, v0.z, v0.w, v1.x, v1.y, v1.z, v1.w};
#pragma unroll
    for (int i = 0; i < 8; ++i) {
        const float ka = bflo(kw[i]), kb = bfhi(kw[i]);
        const int d = c0 + 2 * i;
        KfT[d * LT + j] = f2bf(ka * wf); KfT[(d + 1) * LT + j] = f2bf(kb * wf);
        KbT[d * LT + j] = f2bf(ka * wb); KbT[(d + 1) * LT + j] = f2bf(kb * wb);
        VT[d * LT + j] = (bf16_t)(vw[i] & 0xffffu); VT[(d + 1) * LT + j] = (bf16_t)(vw[i] >> 16);
    }
}
DI void store_state_T(bf16_t* ST, int ld, const f32x16& s, int dkb, int dvb, int lane) {
    const int dv = 32 * dvb + (lane & 31), hh = lane >> 5;
#pragma unroll
    for (int g = 0; g < 4; ++g) { u32x2 o; o.x = pk2(s[4 * g], s[4 * g + 1]); o.y = pk2(s[4 * g + 2], s[4 * g + 3]);
        *(u32x2*)(ST + dv * ld + 32 * dkb + 8 * g + 4 * hh) = o; }
}
DI void store_state_T(LAS bf16_t* ST, int ld, const f32x16& s, int dkb, int dvb, int lane) {
    const int dv = 32 * dvb + (lane & 31), hh = lane >> 5;
#pragma unroll
    for (int g = 0; g < 4; ++g) { u32x2 o; o.x = pk2(s[4 * g], s[4 * g + 1]); o.y = pk2(s[4 * g + 2], s[4 * g + 3]);
        *(LAS u32x2*)(ST + dv * ld + 32 * dkb + 8 * g + 4 * hh) = o; }
}

DI void retention_item(const Params& P, LAS unsigned char* lds, int item) {
    const int tid = threadIdx.x, lane = tid & 63, wave = __builtin_amdgcn_readfirstlane(tid >> 6), hh = lane >> 5;
    const int b = item >> 4, h = (item >> 1) & 7, hf = item & 1;
    const float lgf = log1pf(-expf(P.in[I_DECF][h])), lgb = log1pf(-expf(P.in[I_DECB][h]));
    const bf16_t* QKVG = (const bf16_t*)(P.ws + WS_QKVG) + (size_t)b * SEQ * 2048;
    const bf16_t* CKV = (const bf16_t*)(P.ws + WS_CKV) + (size_t)b * CTXL * 1024;
    bf16_t* SBST = (bf16_t*)(P.ws + WS_SB) + (size_t)item * 8 * 4096;
    bf16_t* MIX = (bf16_t*)(P.ws + WS_MIX) + (size_t)b * SEQ * 1024;
    const int c0 = 8 * hf, clast = c0 + 7; const float P0 = 128.f * c0, Pend = 128.f * (clast + 1);
    LAS bf16_t* Qs = (LAS bf16_t*)(lds + R_Q); LAS bf16_t* Ks = (LAS bf16_t*)(lds + R_K); LAS bf16_t* KfT = (LAS bf16_t*)(lds + R_KFT); LAS bf16_t* KbT = (LAS bf16_t*)(lds + R_KBT);
    LAS bf16_t* VT = (LAS bf16_t*)(lds + R_VT); LAS bf16_t* Ps = (LAS bf16_t*)(lds + R_P); LAS float* Os = (LAS float*)(lds + R_P);
    LAS bf16_t* SfT = (LAS bf16_t*)(lds + R_SFT); LAS bf16_t* SbT = (LAS bf16_t*)(lds + R_SBT);
    const int sdk = (wave >> 1) & 1, sdv = wave & 1;
    const bool isF = wave < 4;
    f32x16 Sacc;
#pragma unroll
    for (int i = 0; i < 16; ++i) Sacc[i] = 0.f;
    LAS float* dtab = (LAS float*)(lds + R_DTAB);
    { const int k = tid & 127, which = tid >> 7;
      dtab[tid] = which == 0 ? __expf(lgf * (float)k) : which == 1 ? __expf(lgb * (float)k) : which == 2 ? __expf(lgf * (float)(k + 1)) : __expf(lgb * (float)(128 - k)); }

    for (int x = 0; x < 10; ++x) {
        const bf16_t* src; int stride, colK, colV; float pos0f, pos0b; bool cf, cb;
        if (x < 2) { src = CKV + (size_t)(128 * x) * 1024; stride = 1024; colK = h * 64; colV = 512 + h * 64; pos0f = -256.f + 128.f * x; pos0b = 2048.f + 128.f * x; cf = true; cb = true; }
        else { const int c = (hf ? 0 : 8) + (x - 2); src = QKVG + (size_t)(128 * c) * 2048; stride = 2048; colK = 512 + h * 64; colV = 1024 + h * 64; pos0f = 128.f * c; pos0b = pos0f; cf = (hf == 1); cb = (hf == 0); }
        const float ef0 = cf ? (P0 - 1.f - pos0f) : 0.f, eb0 = cb ? (pos0b - Pend) : 0.f;
        __syncthreads();
        stage_chunk(lds, src, stride, -1, colK, colV, lgf, ef0, lgb, eb0);
        __syncthreads();
        if (isF) { if (cf) Sacc = mma_tile(KfT + 32 * sdk * LT, LT, VT + 32 * sdv * LT, LT, 128, Sacc, lane); }
        else { if (cb) Sacc = mma_tile(KbT + 32 * sdk * LT, LT, VT + 32 * sdv * LT, LT, 128, Sacc, lane); }
    }
    const float gb128 = __expf(lgb * 128.f), gf128 = __expf(lgf * 128.f);
    for (int c = clast; c >= c0; --c) {
        if (!isF) store_state_T(SBST + (size_t)(c - c0) * 4096, 64, Sacc, sdk, sdv, lane);
        if (c > c0) {
            __syncthreads();
            stage_chunk(lds, QKVG + (size_t)(128 * c) * 2048, 2048, -1, 512 + h * 64, 1024 + h * 64, lgf, 127.f, lgb, 0.f);
            __syncthreads();
            if (!isF) { Sacc = Sacc * gb128; Sacc = mma_tile(KbT + 32 * sdk * LT, LT, VT + 32 * sdv * LT, LT, 128, Sacc, lane); }
        }
    }
    for (int c = c0; c <= clast; ++c) {
        __syncthreads();
        stage_chunk(lds, QKVG + (size_t)(128 * c) * 2048, 2048, h * 64, 512 + h * 64, 1024 + h * 64, lgf, 127.f, lgb, 0.f);
        if (isF) store_state_T(SfT, LQ, Sacc, sdk, sdv, lane);
        {
            const int r = tid >> 3, pc = tid & 7; const u32x4 w = *(const u32x4*)(SBST + (size_t)(c - c0) * 4096 + r * 64 + pc * 8);
            *(LAS u32x4*)(SbT + r * LQ + pc * 8) = w; }
        __syncthreads();
        const int ib = wave >> 1, db = wave & 1;
#pragma unroll
        for (int t = 0; t < 2; ++t) {
            const int jb = 2 * db + t;
            f32x16 s = mma_tile(Qs + 32 * ib * LQ, LQ, Ks + 32 * jb * LQ, LQ, 64, zero16(), lane);
            const int j = 32 * jb + (lane & 31);
#pragma unroll
            for (int r = 0; r < 16; ++r) { const int i = 32 * ib + crow(r, hh); const int dlt = i - j;
                const float dec = dtab[dlt >= 0 ? dlt : 128 - dlt];
                Ps[i * LT + j] = f2bf(s[r] * dec); }
        }
        __syncthreads();
        f32x16 o = mma_tile(Ps + 32 * ib * LT, LT, VT + 32 * db * LT, LT, 128, zero16(), lane);
        f32x16 tf = mma_tile(Qs + 32 * ib * LQ, LQ, SfT + 32 * db * LQ, LQ, 64, zero16(), lane);
        f32x16 tb = mma_tile(Qs + 32 * ib * LQ, LQ, SbT + 32 * db * LQ, LQ, 64, zero16(), lane);
#pragma unroll
        for (int r = 0; r < 16; ++r) { const int i = 32 * ib + crow(r, hh); o[r] += dtab[256 + i] * tf[r] + dtab[384 + i] * tb[r]; }
        __syncthreads();
#pragma unroll
        for (int r = 0; r < 16; ++r) Os[(32 * ib + crow(r, hh)) * LO + 32 * db + (lane & 31)] = o[r];
        if (isF) { Sacc = Sacc * gf128; Sacc = mma_tile(KfT + 32 * sdk * LT, LT, VT + 32 * sdv * LT, LT, 128, Sacc, lane); }
        __syncthreads();
        {
            const int i = tid >> 2, q4 = tid & 3; float ov[16]; float ss = 0.f;
#pragma unroll
            for (int e = 0; e < 16; ++e) { ov[e] = Os[i * LO + 16 * q4 + e]; ss += ov[e] * ov[e]; }
            ss += __shfl_xor(ss, 1); ss += __shfl_xor(ss, 2);
            const float rstd = rsqrtf(ss * (1.0f / 64.0f) + EPSV);
            const bf16_t* gp = QKVG + (size_t)(128 * c + i) * 2048 + 1536 + h * 64 + 16 * q4;
            const u32x4 g0 = *(const u32x4*)gp, g1 = *(const u32x4*)(gp + 8);
            const unsigned gw_[8] = {g0.x, g0.y, g0.z, g0.w, g1.x, g1.y, g1.z, g1.w};
            const float* gn = P.in[I_RETGAIN] + h * 64 + 16 * q4;
            unsigned ow[8];
#pragma unroll
            for (int e = 0; e < 8; ++e) {
                const float ya = ov[2 * e] * rstd * gn[2 * e] * siluf(bflo(gw_[e])), yb = ov[2 * e + 1] * rstd * gn[2 * e + 1] * siluf(bfhi(gw_[e]));
                ow[e] = pk2(ya, yb);
            }
            bf16_t* mp = MIX + (size_t)(128 * c + i) * 1024 + h * 64 + 16 * q4;
            *(u32x4*)mp = (u32x4){ow[0], ow[1], ow[2], ow[3]}; *(u32x4*)(mp + 8) = (u32x4){ow[4], ow[5], ow[6], ow[7]};
        }
    }
    __syncthreads();
}

DI void phase5(const Params& P) {
    const int lane = threadIdx.x & 63, wave = threadIdx.x >> 6;
    const int gw = blockIdx.x * NWAVES + wave, NGW = gridDim.x * NWAVES;
    const float* MOD = (const float*)(P.ws + WS_MOD);
    const float* O = (const float*)(P.ws + WS_QKVG);
    bf16_t* H2 = (bf16_t*)(P.ws + WS_HX); bf16_t* H2S = (bf16_t*)(P.ws + WS_H2S);
    for (int r = gw; r < NTOK; r += NGW) {
        const int b = r >> 11; const float* m = MOD + (size_t)b * 6144;
        const f32x4* orow = (const f32x4*)(O + (size_t)r * DM) + lane; const f32x4* xrow = (const f32x4*)(P.in[I_X] + (size_t)r * DM) + lane;
        f32x4 ov[4], xv[4]; float ss = 0.f;
#pragma unroll
        for (int j = 0; j < 4; ++j) { ov[j] = orow[64 * j]; xv[j] = xrow[64 * j]; ss += (ov[j].x * ov[j].x + ov[j].y * ov[j].y) + (ov[j].z * ov[j].z + ov[j].w * ov[j].w); }
        const float rstd = rsqrtf(wave_sum(ss) * (1.0f / DM) + EPSV);
        float ss2 = 0.f;
#pragma unroll
        for (int j = 0; j < 4; ++j) {
            const f32x4 gn = ((const f32x4*)P.in[I_NPOSTMIX])[64 * j + lane], g1 = ((const f32x4*)(m + 2048))[64 * j + lane];
            xv[j] = xv[j] + g1 * (ov[j] * rstd * gn);
            ((f32x4*)(P.out + (size_t)r * DM))[64 * j + lane] = xv[j];
            ss2 += (xv[j].x * xv[j].x + xv[j].y * xv[j].y) + (xv[j].z * xv[j].z + xv[j].w * xv[j].w);
        }
        const float rstd2 = rsqrtf(wave_sum(ss2) * (1.0f / DM) + EPSV);
#pragma unroll
        for (int j = 0; j < 4; ++j) {
            const f32x4 gn = ((const f32x4*)P.in[I_NPREFFN])[64 * j + lane], sh = ((const f32x4*)(m + 3072))[64 * j + lane], sc = ((const f32x4*)(m + 4096))[64 * j + lane];
            const f32x4 y = xv[j] * rstd2 * gn * (sc + 1.0f) + sh;
            u32x2 o; o.x = pk2(y.x, y.y); o.y = pk2(y.z, y.w);
            ((u32x2*)(H2 + (size_t)r * DM))[64 * j + lane] = o;
            *(u32x2*)(H2S + ((size_t)(2 * j + (lane >> 5)) * NTOKP + r) * 128 + 4 * (lane & 31)) = o;
        }
    }
}

#define INS16(L, xx) do { float _x = (xx); _Pragma("unroll") for (int _i = 0; _i < 16; ++_i) { const float _t = fmaxf(L[_i], _x); _x = fminf(L[_i], _x); L[_i] = _t; } } while (0)
constexpr int KLD = 136;
DI void topk_half(const LAS bf16_t* keys  , const bf16x8 (&bq)[8]  , float (&L)[16], int lane) {
    const int r = lane & 31, hh = lane >> 5;
    f32x16 acc[4];
#pragma unroll
    for (int t = 0; t < 4; ++t)
#pragma unroll
        for (int i = 0; i < 16; ++i) acc[t][i] = 0.f;
#pragma unroll
    for (int ks = 0; ks < 8; ++ks) {
#pragma unroll
        for (int t = 0; t < 4; ++t) { const bf16x8 a = *(const LAS bf16x8*)(keys + (32 * t + r) * KLD + 16 * ks + 8 * hh); acc[t] = MFMA32(a, bq[ks], acc[t]); }
        if (ks & 1) __builtin_amdgcn_sched_barrier(0);
    }
#pragma unroll
    for (int i = 0; i < 16; ++i) L[i] = -3.0e38f;
#pragma unroll
    for (int t = 0; t < 4; ++t)
#pragma unroll
        for (int i = 0; i < 16; ++i) {
            const unsigned idx = 32u * t + (unsigned)((i & 3) + 8 * (i >> 2));
            const float pv = __uint_as_float((__float_as_uint(acc[t][i]) & 0xFFFFFF80u) | idx);
            INS16(L, pv);
        }
#pragma unroll
    for (int i = 0; i < 16; ++i) L[i] = __uint_as_float(__float_as_uint(L[i]) | ((unsigned)hh << 2));
    float Pn[16];
#pragma unroll
    for (int i = 0; i < 16; ++i) Pn[i] = __shfl_xor(L[i], 32);
#pragma unroll
    for (int i = 0; i < 16; ++i) INS16(L, Pn[i]);
}
DI unsigned pack4idx(float a, float b, float c, float d) { return (__float_as_uint(a) & 127u) | ((__float_as_uint(b) & 127u) << 8) | ((__float_as_uint(c) & 127u) << 16) | ((__float_as_uint(d) & 127u) << 24); }
DI unsigned pick_idx(unsigned w0, unsigned w1, unsigned w2, unsigned w3, unsigned a) {
    const unsigned lo = (a & 4u) ? w1 : w0, hi = (a & 4u) ? w3 : w2, w = (a & 8u) ? hi : lo;
    return (w >> (8u * (a & 3u))) & 127u;
}
typedef __bf16 bf16x2_t __attribute__((ext_vector_type(2)));
DI float dot2bf(unsigned a, unsigned b, float acc) { return __builtin_amdgcn_fdot2_f32_bf16(__builtin_bit_cast(bf16x2_t, a), __builtin_bit_cast(bf16x2_t, b), acc, false); }
#define DPP_ADD(x, ctrl) ((x) + __int_as_float(__builtin_amdgcn_update_dpp(0, __float_as_int(x), (ctrl), 0xf, 0xf, true)))
DI float dpp_sum16(float x) {
    x = DPP_ADD(x, 0x128);
    x = DPP_ADD(x, 0x141);
    x = DPP_ADD(x, 0x4E);
    x = DPP_ADD(x, 0xB1);
    return x;
}

#define DPP_MOV(x, ctrl) __int_as_float(__builtin_amdgcn_update_dpp(0, __float_as_int(x), (ctrl), 0xf, 0xf, true))
DI float dpp_sum16x4(float d0, float d1, float d2, float d3, int l16) {
    const bool hi = (l16 & 8) != 0;
    float k0 = hi ? d2 : d0, k1 = hi ? d3 : d1; const float g0 = hi ? d0 : d2, g1 = hi ? d1 : d3;
    k0 += DPP_MOV(g0, 0x128); k1 += DPP_MOV(g1, 0x128);
    const bool b2 = (l16 & 4) != 0;
    float k = b2 ? k1 : k0; const float gv = b2 ? k0 : k1;
    k += DPP_MOV(gv, 0x141);
    k += DPP_MOV(k, 0xB1);
    k += DPP_MOV(k, 0x4E);
    return k;
}

DI unsigned peer_blk(unsigned e) { return ((e >> 7) + (e & 31u)) & 31u; }
DI unsigned peer_row(unsigned e) { return ((e >> 7) << 2) | ((e >> 5) & 3u); }
DI unsigned peer_expert(unsigned blk, unsigned row) { const unsigned e1 = row >> 2; return e1 * 128u + (row & 3u) * 32u + ((blk - e1) & 31u); }

constexpr int P7_IDS = 69632, P7_WTS = 77952, P7_SID = 94336, P7_SWT = 102528, P7_CUM = 118912;
DI void phase7(const Params& P, LAS unsigned char* lds) {
    const int tid = threadIdx.x, lane = tid & 63, wave = tid >> 6;
    LAS bf16_t* keys = (LAS bf16_t*)lds;
    LAS bf16_t* ids_l = (LAS bf16_t*)(lds + P7_IDS);
    LAS float* wts_l = (LAS float*)(lds + P7_WTS);
    LAS bf16_t* sid_l = (LAS bf16_t*)(lds + P7_SID);
    LAS float* swt_l = (LAS float*)(lds + P7_SWT);
    LAS unsigned char* cum_l = (LAS unsigned char*)(lds + P7_CUM);
    LAS unsigned* msk_l = (LAS unsigned*)(lds + P7_CUM + 1280);
    const bf16_t* KEYS = (const bf16_t*)(P.ws + WS_KEYS);
    for (int i = tid; i < 256 * 16; i += NTHREADS) { const int r = i >> 4, pc = i & 15; *(LAS u32x4*)(keys + r * KLD + pc * 8) = *(const u32x4*)(KEYS + r * 128 + pc * 8); }
    __syncthreads();
    const bf16_t* PQ = (const bf16_t*)(P.ws + WS_FT);
    bf16_t* SID = (bf16_t*)(P.ws + WS_SID); bf16_t* SIDB = (bf16_t*)(P.ws + WS_SIDB); float* SWT = (float*)(P.ws + WS_SWT);
    for (int i = blockIdx.x * NTHREADS + tid; i < 32 * (NTOKP - NTOK) * 2; i += gridDim.x * NTHREADS) { const int eb = i / ((NTOKP - NTOK) * 2), r = i % ((NTOKP - NTOK) * 2);
        *(u32x4*)(SIDB + ((size_t)eb * NTOKP + NTOK) * 16 + r * 8) = (u32x4){0u, 0u, 0u, 0u}; }
    for (int tile = blockIdx.x; tile < 1024; tile += gridDim.x) {
        const int t0 = tile * 32;
        {
            const int h = wave, tl = lane & 31, tok = t0 + tl, hh = lane >> 5;
            const bf16_t* qrow = PQ + (size_t)tok * 2048 + h * 256;
            float L1[16], L2[16];
            bf16x8 q1[8], q2[8];
#pragma unroll
            for (int ks = 0; ks < 8; ++ks) { q1[ks] = *(const bf16x8*)(qrow + 16 * ks + 8 * hh); q2[ks] = *(const bf16x8*)(qrow + 128 + 16 * ks + 8 * hh); }
            topk_half(keys, q1, L1, lane);
            topk_half(keys + 128 * KLD, q2, L2, lane);
            const unsigned w10 = pack4idx(L1[0], L1[1], L1[2], L1[3]), w11 = pack4idx(L1[4], L1[5], L1[6], L1[7]), w12 = pack4idx(L1[8], L1[9], L1[10], L1[11]), w13 = pack4idx(L1[12], L1[13], L1[14], L1[15]);
            const unsigned w20 = pack4idx(L2[0], L2[1], L2[2], L2[3]), w21 = pack4idx(L2[4], L2[5], L2[6], L2[7]), w22 = pack4idx(L2[8], L2[9], L2[10], L2[11]), w23 = pack4idx(L2[12], L2[13], L2[14], L2[15]);
            float C[16];
#pragma unroll
            for (int i = 0; i < 16; ++i) C[i] = -3.0e38f;
#pragma unroll
            for (int a = 0; a < 16; ++a)
#pragma unroll
                for (int bq = 0; bq < 16; ++bq)
                    if ((a + 1) * (bq + 1) <= 16) { const float sm = L1[a] + L2[bq]; const float pv = __uint_as_float((__float_as_uint(sm) & 0xFFFFFF00u) | (unsigned)(a * 16 + bq)); INS16(C, pv); }
            float e[16], sum = 0.f;
#pragma unroll
            for (int i = 0; i < 16; ++i) { e[i] = __expf(C[i] - C[0]); sum += e[i]; }
            const float inv = 1.0f / sum;
            if (hh == 0) {
#pragma unroll
                for (int i = 0; i < 16; ++i) { const unsigned code = __float_as_uint(C[i]) & 255u;
                    ids_l[tl * 130 + h * 16 + i] = (bf16_t)(pick_idx(w10, w11, w12, w13, code >> 4) * 128u + pick_idx(w20, w21, w22, w23, code & 15u)); }
            } else {
#pragma unroll
                for (int i = 0; i < 16; ++i) wts_l[tl * 128 + h * 16 + i] = e[i] * inv;
            }
        }
        __syncthreads();
        {
            const int tl = tid >> 4, j = tid & 15;
            for (int i = tid; i < 32 * 32 * 4; i += NTHREADS) msk_l[i] = 0u;
            __syncthreads();
            unsigned myid[8], myb[8];
#pragma unroll
            for (int m = 0; m < 8; ++m) { myid[m] = ids_l[tl * 130 + 8 * j + m]; myb[m] = peer_blk(myid[m]); }
#pragma unroll
            for (int m = 0; m < 8; ++m) { const int i = 8 * j + m; atomicOr((unsigned*)&msk_l[(tl * 32 + myb[m]) * 4 + (i >> 5)], 1u << (i & 31)); }
            __syncthreads();
            {
                const u32x4 ma = *(const LAS u32x4*)(msk_l + (tl * 32 + j) * 4), mb = *(const LAS u32x4*)(msk_l + (tl * 32 + 16 + j) * 4);
                const unsigned ca = __builtin_popcount(ma.x) + __builtin_popcount(ma.y) + __builtin_popcount(ma.z) + __builtin_popcount(ma.w);
                const unsigned cb2 = __builtin_popcount(mb.x) + __builtin_popcount(mb.y) + __builtin_popcount(mb.z) + __builtin_popcount(mb.w);
                unsigned sa = ca, sb = cb2;
#pragma unroll
                for (int o = 1; o < 16; o <<= 1) { const unsigned ua = __shfl_up(sa, o, 16), ub = __shfl_up(sb, o, 16); if (j >= o) { sa += ua; sb += ub; } }
                const unsigned tot_a = __shfl(sa, 15, 16);
                cum_l[tl * 40 + j] = (unsigned char)(sa - ca); cum_l[tl * 40 + 16 + j] = (unsigned char)(tot_a + sb - cb2); if (j == 0) cum_l[tl * 40 + 32] = 128;
            }
            __syncthreads();
#pragma unroll
            for (int m = 0; m < 8; ++m) {
                const int i = 8 * j + m; const LAS unsigned* mk = msk_l + (tl * 32 + myb[m]) * 4;
                unsigned before = 0;
#pragma unroll
                for (int w = 0; w < 4; ++w) { const unsigned mw = mk[w]; const unsigned sel = (w < (i >> 5)) ? mw : (w == (i >> 5)) ? (mw & ((1u << (i & 31)) - 1u)) : 0u; before += __builtin_popcount(sel); }
                const unsigned rank = (unsigned)cum_l[tl * 40 + myb[m]] + before;
                sid_l[tl * 128 + rank] = (bf16_t)myid[m]; swt_l[tl * 128 + rank] = wts_l[tl * 128 + i];
            }
        }
        __syncthreads();
        {
            const int tl = tid >> 4, pc = tid & 15;
            *(u32x4*)(SID + (size_t)(t0 + tl) * 128 + pc * 8) = *(const LAS u32x4*)(sid_l + tl * 128 + pc * 8);
            *(u32x4*)(SWT + (size_t)(t0 + tl) * 128 + pc * 8) = *(const LAS u32x4*)(swt_l + tl * 128 + pc * 8);
            *(u32x4*)(SWT + (size_t)(t0 + tl) * 128 + pc * 8 + 4) = *(const LAS u32x4*)(swt_l + tl * 128 + pc * 8 + 4);
#pragma unroll
            for (int rr = 0; rr < 2; ++rr) {
                const int rec = tid + rr * NTHREADS, eb = rec >> 5, tk = rec & 31;
                const unsigned lo = cum_l[tk * 40 + eb], hi = cum_l[tk * 40 + eb + 1], cnt = hi - lo;
                unsigned w[8];
#pragma unroll
                for (int q = 0; q < 8; ++q) {
                    unsigned a, b;
                    if (q == 0) a = cnt | (lo << 8); else { const unsigned k = 2 * q - 1; a = (k < cnt) ? peer_row((unsigned)sid_l[tk * 128 + ((lo + k) & 127)]) : 0u; }
                    { const unsigned k = 2 * q; b = (k < cnt) ? peer_row((unsigned)sid_l[tk * 128 + ((lo + k) & 127)]) : 0u; }
                    w[q] = a | (b << 16);
                }
                bf16_t* rp = SIDB + ((size_t)eb * NTOKP + t0 + tk) * 16;
                *(u32x4*)rp = (u32x4){w[0], w[1], w[2], w[3]}; *(u32x4*)(rp + 8) = (u32x4){w[4], w[5], w[6], w[7]};
            }
        }
        __syncthreads();
    }
}

DI int peer_role(const unsigned* xctr, int my_xcc, int my_xrank) {
    bool ok = (gridDim.x == 256) && my_xcc < 8 && my_xrank < 32;
#pragma unroll
    for (int j = 0; j < 8; ++j) ok = ok && (__hip_atomic_load(&xctr[64 * j], __ATOMIC_RELAXED, __HIP_MEMORY_SCOPE_AGENT) == 32u);
    return ok ? (my_xrank * 8 + my_xcc) : (int)blockIdx.x;
}

template <int VAR> DI void phase8(const Params& P, LAS unsigned char* lds, float* PART, const int role0) {
    const int tid = threadIdx.x, lane = tid & 63, wave = __builtin_amdgcn_readfirstlane(tid >> 6), g4 = lane >> 4, l16 = lane & 15;
    LAS bf16_t* tab = (LAS bf16_t*)lds;
    LAS unsigned char* hst = lds + U_TAB + wave * U_HST;
    LAS unsigned* lst = (LAS unsigned*)(lds + U_TAB + 8 * U_HST + wave * U_LST);
    const bf16_t* H2S = (const bf16_t*)(P.ws + WS_H2S);
    const bf16_t* SIDB = (const bf16_t*)(P.ws + WS_SIDB); const bf16_t* SID = (const bf16_t*)(P.ws + WS_SID);
    for (int role = role0; role < 256; role += gridDim.x) {
        const int ds = role & 7, eb = role >> 3;
        __syncthreads();
        TS_BEGIN(1);
#pragma unroll 8
        for (int idx = tid; idx < 512 * 32; idx += NTHREADS) {
            const int row = idx >> 5, c4 = idx & 31;
            const f32x4 v = *(const f32x4*)(P.in[I_U] + (size_t)peer_expert((unsigned)eb, (unsigned)row) * DM + 128 * ds + 4 * c4);
            u32x2 o; o.x = pk2(v.x, v.y); o.y = pk2(v.z, v.w);
            *(LAS u32x2*)(tab + row * 128 + 4 * c4) = o;
        }
        __syncthreads();
        TS_END(1);
        TS_BEGIN(2);
        const bf16_t* recs = SIDB + (size_t)eb * NTOKP * 16;
        const bf16_t* hpl = H2S + (size_t)ds * NTOKP * 128;
        float* ppl = PART + (size_t)ds * NTOK * 128;
        unsigned hd0[3], en0[3], hd1[3], en1[3]; u32x4 hh0[3], hh1[3];
#define U_LOAD(HD_, EN_, HH_, IT_) do { const bf16_t* rp_ = recs + (size_t)((IT_) * U_TOK + 12 * wave + 3 * g4) * 16; const bf16_t* hp_ = hpl + (size_t)((IT_) * U_TOK + 12 * wave + 3 * g4) * 128 + 8 * l16; \
            _Pragma("unroll") for (int q = 0; q < 3; ++q) { HD_[q] = (unsigned)rp_[16 * q]; EN_[q] = (unsigned)rp_[16 * q + 1 + l16]; HH_[q] = *(const u32x4*)(hp_ + 128 * q); } } while (0)
        U_LOAD(hd0, en0, hh0, 0);
        U_LOAD(hd1, en1, hh1, 1);
        for (int it = 0; it < U_NIT; ++it) {
            unsigned hd2[3], en2[3]; u32x4 hh2[3];
            { const int itn = (it + 2 < U_NIT) ? it + 2 : U_NIT - 1; U_LOAD(hd2, en2, hh2, itn); }
            const int tile = it * U_TOK + 12 * wave;
            unsigned c15[3], lo[3], cn[3]; unsigned sg = 0, anyover = 0;
#pragma unroll
            for (int q = 0; q < 3; ++q) {
                *(LAS u32x4*)(hst + (3 * g4 + q) * 256 + 16 * l16) = hh0[q];
                cn[q] = hd0[q] & 0xffu; lo[q] = (hd0[q] >> 8) & 0xffu; c15[q] = cn[q] < 15u ? cn[q] : 15u; sg += c15[q]; anyover |= (cn[q] > 15u) ? 1u : 0u;
            }
            const int s0 = __builtin_amdgcn_readlane((int)sg, 0), s1 = __builtin_amdgcn_readlane((int)sg, 16), s2 = __builtin_amdgcn_readlane((int)sg, 32), s3 = __builtin_amdgcn_readlane((int)sg, 48);
            const int b1 = s0, b2 = s0 + s1, b3 = b2 + s2, total = b3 + s3;
            unsigned myoff = g4 == 0 ? 0u : g4 == 1 ? (unsigned)b1 : g4 == 2 ? (unsigned)b2 : (unsigned)b3;
#pragma unroll
            for (int q = 0; q < 3; ++q) {
                if ((unsigned)l16 < c15[q]) lst[myoff + l16] = (lo[q] + (unsigned)l16) | ((en0[q] & 511u) << 7) | ((unsigned)(3 * g4 + q) << 16);
                myoff += c15[q];
            }
            if (lane < 32) lst[total + lane] = 0u;
            LDS_WAIT();
            if (VAR != 1) {
                const int qd = lane >> 2;
                const unsigned g0 = (unsigned)((lane & 15) * 16);
                for (int k0 = 0; k0 < total; k0 += 32) {
                    const unsigned e0 = lst[k0 + qd], e1 = lst[k0 + 16 + qd];
                    const LAS unsigned char* hb0 = hst + (e0 >> 16) * 256; const LAS unsigned char* ub0 = (const LAS unsigned char*)tab + ((e0 >> 7) & 511u) * 256;
                    const LAS unsigned char* hb1 = hst + (e1 >> 16) * 256; const LAS unsigned char* ub1 = (const LAS unsigned char*)tab + ((e1 >> 7) & 511u) * 256;
                    u32x4 hv0[4], uv0[4], hv1[4], uv1[4];
#pragma unroll
                    for (int m = 0; m < 4; ++m) { const unsigned gm = g0 ^ (unsigned)(64 * m); hv0[m] = *(const LAS u32x4*)(hb0 + gm); uv0[m] = *(const LAS u32x4*)(ub0 + gm); }
#pragma unroll
                    for (int m = 0; m < 4; ++m) { const unsigned gm = g0 ^ (unsigned)(64 * m); hv1[m] = *(const LAS u32x4*)(hb1 + gm); uv1[m] = *(const LAS u32x4*)(ub1 + gm); }
                    float a0[4], a1[4];
#pragma unroll
                    for (int m = 0; m < 4; ++m) { float t = dot2bf(uv0[m].x, hv0[m].x, 0.f); t = dot2bf(uv0[m].y, hv0[m].y, t); t = dot2bf(uv0[m].z, hv0[m].z, t); t = dot2bf(uv0[m].w, hv0[m].w, t); a0[m] = t; }
#pragma unroll
                    for (int m = 0; m < 4; ++m) { float t = dot2bf(uv1[m].x, hv1[m].x, 0.f); t = dot2bf(uv1[m].y, hv1[m].y, t); t = dot2bf(uv1[m].z, hv1[m].z, t); t = dot2bf(uv1[m].w, hv1[m].w, t); a1[m] = t; }
                    float r0 = (a0[0] + a0[1]) + (a0[2] + a0[3]), r1 = (a1[0] + a1[1]) + (a1[2] + a1[3]);
                    r0 += DPP_MOV(r0, 0xB1); r1 += DPP_MOV(r1, 0xB1);
                    r0 += DPP_MOV(r0, 0x4E); r1 += DPP_MOV(r1, 0x4E);
                    const bool second = (lane & 1) != 0;
                    const unsigned es = second ? e1 : e0; const float rs = second ? r1 : r0;
                    const int ks = k0 + qd + (second ? 16 : 0);
                    if ((lane & 2) == 0 && ks < total) ppl[(size_t)(tile + (int)(es >> 16)) * 128 + (es & 127u)] = rs;
                }
            }
            if (__builtin_amdgcn_readfirstlane((int)__builtin_popcountll(__ballot(anyover != 0))) != 0) {
#pragma unroll
                for (int q = 0; q < 3; ++q) {
                    const int t = tile + 3 * g4 + q;
                    const int c0 = __builtin_amdgcn_readlane((int)cn[q], 0), c1 = __builtin_amdgcn_readlane((int)cn[q], 16), c2 = __builtin_amdgcn_readlane((int)cn[q], 32), c3 = __builtin_amdgcn_readlane((int)cn[q], 48);
                    const int nmax = max(max(c0, c1), max(c2, c3));
                    for (int j = 15; j < nmax; ++j) {
                        const bool act = (unsigned)j < cn[q];
                        const unsigned id = act ? (unsigned)SID[(size_t)t * 128 + lo[q] + j] : 0u;
                        const u32x4 u = *(const LAS u32x4*)(tab + peer_row(id) * 128 + 8 * l16);
                        float d = dot2bf(u.x, hh0[q].x, 0.f); d = dot2bf(u.y, hh0[q].y, d); d = dot2bf(u.z, hh0[q].z, d); d = dot2bf(u.w, hh0[q].w, d);
                        d = dpp_sum16(d);
                        if (act && l16 == 0) ppl[(size_t)t * 128 + lo[q] + j] = d;
                    }
                }
            }
#pragma unroll
            for (int q = 0; q < 3; ++q) { hd0[q] = hd1[q]; en0[q] = en1[q]; hh0[q] = hh1[q]; hd1[q] = hd2[q]; en1[q] = en2[q]; hh1[q] = hh2[q]; }
        }
#undef U_LOAD
        TS_END(2);
    }
}

DI void phase9(const Params& P, LAS unsigned char* lds) {
    const int tid = threadIdx.x;
    LAS unsigned* stage = (LAS unsigned*)lds;
    const float* PART = (const float*)(P.ws + WS_PART); const float* SWT = (const float*)(P.ws + WS_SWT); const bf16_t* SID = (const bf16_t*)(P.ws + WS_SID);
    unsigned* CIT = (unsigned*)(P.ws + WS_CIT);
    for (int tile = blockIdx.x; tile < 512; tile += gridDim.x) {
        const int t0 = tile * 64;
        __syncthreads();
#pragma unroll 4
        for (int it = 0; it < 16; ++it) {
            const int tl = (tid >> 7) + 4 * it, s = tid & 127; const size_t pi = (size_t)(t0 + tl) * 128 + s;
            float act = 0.f;
#pragma unroll
            for (int d = 0; d < 8; ++d) act += PART[(size_t)d * NTOK * 128 + pi];
            const float coef = SWT[pi] * gelu_erf(act);
            stage[tl * 132 + s] = ((unsigned)SID[pi] << 16) | (unsigned)f2bf(coef);
        }
        __syncthreads();
        {
            const int sg = tid >> 4, tq = (tid & 15) * 4;
#pragma unroll
            for (int q = 0; q < 4; ++q) *(u32x4*)(CIT + ((size_t)sg * NTOK + t0 + tq + q) * 4) = *(const LAS u32x4*)(stage + (tq + q) * 132 + sg * 4);
        }
    }
}

typedef float f32x2v __attribute__((ext_vector_type(2)));
DI float clamp448(float x) { return fminf(fmaxf(x, -448.f), 448.f); }
DI void phase10(const Params& P, LAS unsigned char* lds, const int role0) {
    const int tid = threadIdx.x, lane = tid & 63, wave = tid >> 6;
    LAS unsigned char* tab = lds;
    const unsigned* CIT = (const unsigned*)(P.ws + WS_CIT);
    float* POUT = (float*)(P.ws + WS_POUT);
    for (int role = role0; role < 256; role += gridDim.x) {
        const int xl = role & 7, r = role >> 3, c = xl * 16 + (r & 15), half = r >> 4;
        __syncthreads();
#pragma unroll 4
        for (int e = tid; e < 16384; e += NTHREADS) {
            const f32x4 v0 = *(const f32x4*)(P.in[I_V] + (size_t)e * DM + 8 * c), v1 = *(const f32x4*)(P.in[I_V] + (size_t)e * DM + 8 * c + 4);
            int w0 = 0, w1 = 0;
            w0 = __builtin_amdgcn_cvt_pk_fp8_f32(clamp448(v0.x * 512.f), clamp448(v0.y * 512.f), w0, false); w0 = __builtin_amdgcn_cvt_pk_fp8_f32(clamp448(v0.z * 512.f), clamp448(v0.w * 512.f), w0, true);
            w1 = __builtin_amdgcn_cvt_pk_fp8_f32(clamp448(v1.x * 512.f), clamp448(v1.y * 512.f), w1, false); w1 = __builtin_amdgcn_cvt_pk_fp8_f32(clamp448(v1.z * 512.f), clamp448(v1.w * 512.f), w1, true);
            *(LAS u32x2*)(tab + e * 8) = (u32x2){(unsigned)w0, (unsigned)w1};
        }
        __syncthreads();
        for (int grp = wave; grp < 256; grp += NWAVES) {
            const int t = half * (NTOK / 2) + grp * 64 + lane;
            float a[8];
#pragma unroll
            for (int i = 0; i < 8; ++i) a[i] = 0.f;
            u32x4 cb[8];
#pragma unroll
            for (int i = 0; i < 8; ++i) cb[i] = *(const u32x4*)(CIT + ((size_t)i * NTOK + t) * 4);
#pragma unroll 1
            for (int sg0 = 0; sg0 < 32; sg0 += 8) {
                u32x4 nb[8];
                const int sgn = (sg0 + 8 < 32) ? sg0 + 8 : sg0;
#pragma unroll
                for (int i = 0; i < 8; ++i) nb[i] = *(const u32x4*)(CIT + ((size_t)(sgn + i) * NTOK + t) * 4);
#pragma unroll
                for (int i = 0; i < 8; ++i) {
                    const unsigned cw[4] = {cb[i].x, cb[i].y, cb[i].z, cb[i].w};
#pragma unroll
                    for (int q = 0; q < 4; ++q) {
                        const float coef = __uint_as_float(cw[q] << 16);
                        const u32x2 v = *(const LAS u32x2*)(tab + (cw[q] >> 16) * 8);
                        const f32x2v p0 = __builtin_amdgcn_cvt_pk_f32_fp8((int)v.x, false), p1 = __builtin_amdgcn_cvt_pk_f32_fp8((int)v.x, true);
                        const f32x2v p2 = __builtin_amdgcn_cvt_pk_f32_fp8((int)v.y, false), p3 = __builtin_amdgcn_cvt_pk_f32_fp8((int)v.y, true);
                        a[0] += coef * p0.x; a[1] += coef * p0.y; a[2] += coef * p1.x; a[3] += coef * p1.y;
                        a[4] += coef * p2.x; a[5] += coef * p2.y; a[6] += coef * p3.x; a[7] += coef * p3.y;
                    }
                    if (i & 1) __builtin_amdgcn_sched_barrier(0);
                }
#pragma unroll
                for (int i = 0; i < 8; ++i) cb[i] = nb[i];
            }
            const float sc = 1.0f / 512.0f;
            float* op = POUT + ((size_t)xl * NTOK + t) * 128 + 8 * (c & 15);
            *(f32x4*)op = (f32x4){a[0] * sc, a[1] * sc, a[2] * sc, a[3] * sc}; *(f32x4*)(op + 4) = (f32x4){a[4] * sc, a[5] * sc, a[6] * sc, a[7] * sc};
        }
    }
}

DI void phase11(const Params& P) {
    const int lane = threadIdx.x & 63, wave = threadIdx.x >> 6;
    const int gw = blockIdx.x * NWAVES + wave, NGW = gridDim.x * NWAVES;
    const float* MOD = (const float*)(P.ws + WS_MOD);
    const float* POUT = (const float*)(P.ws + WS_POUT);
    for (int t = gw; t < NTOK; t += NGW) {
        const int b = t >> 11; const float* m = MOD + (size_t)b * 6144;
        f32x4 acc[4]; float ss = 0.f;
#pragma unroll
        for (int j = 0; j < 4; ++j) { acc[j] = *(const f32x4*)(POUT + ((size_t)(2 * j + (lane >> 5)) * NTOK + t) * 128 + 4 * (lane & 31)); ss += (acc[j].x * acc[j].x + acc[j].y * acc[j].y) + (acc[j].z * acc[j].z + acc[j].w * acc[j].w); }
        const float rstd = rsqrtf(wave_sum(ss) * (1.0f / DM) + EPSV);
#pragma unroll
        for (int j = 0; j < 4; ++j) {
            const f32x4 gn = ((const f32x4*)P.in[I_NPOSTFFN])[64 * j + lane], g2 = ((const f32x4*)(m + 5120))[64 * j + lane];
            f32x4* op = (f32x4*)(P.out + (size_t)t * DM) + 64 * j + lane;
            *op = *op + g2 * (acc[j] * rstd * gn);
        }
    }
}

template <int PLO, int PHI> __global__ void __launch_bounds__(NTHREADS, 2) fwd_megakernel(Params P) {
    extern __shared__ __attribute__((aligned(16))) unsigned char lds_raw[];
    LAS unsigned char* lds = (LAS unsigned char*)lds_raw;
    cg::grid_group grid = cg::this_grid();
    volatile LAS unsigned* xst = (volatile LAS unsigned*)(lds + LDS_BYTES - 16);
    if (threadIdx.x == 0) { xst[0] = 0u; xst[1] = 0u; }
    __syncthreads();
    XcdBarrier xbar = xcd_barrier_post((unsigned*)P.ws + (PLO > 0 ? 8192 : 0), xst);
    unsigned* xctr = (unsigned*)P.ws + 3584 + (PLO > 0 ? 8192 : 0);
    if (threadIdx.x == 0) xst[2] = xb_add(&xctr[64 * xbar.x], 1u);
    __syncthreads();
    const int my_xrank = __builtin_amdgcn_readfirstlane((int)xst[2]);
    const int my_xcc = (int)xbar.x;
    unsigned char* ws = P.ws;
    const int lo = P.ph_lo, hi = P.ph_hi;
    if (TIMESEC && PLO > 0 && blockIdx.x == 0 && threadIdx.x == 0) ((volatile unsigned long long*)(P.ws + 32768))[1] = 0ull;
#define IN(k) (PLO <= (k) && (k) < PHI && lo <= (k) && (k) < hi)
#define SEAM(k) do { if (IN(k) && IN((k) + 1)) { if ((k) == PLO) grid.sync(); else xcd_barrier(xbar); } } while (0)
#define RUN(k, ...) do { if (IN(k)) { TS_BEGIN(100 + (k)); TS_BEGIN(200 + (k)); __VA_ARGS__; TS_END(100 + (k)); } SEAM(k); if (IN(k)) TS_END(200 + (k)); } while (0)
    RUN(0, phase0(P, lds));
    RUN(1, phase1(P));
    RUN(2, {
        run_gemm(lds, (const bf16_t*)(ws + WS_HC), (const bf16_t*)(ws + WS_WIN) + (size_t)512 * 1024, NCTX, 1024, 1024, FPlain{(bf16_t*)(ws + WS_CKV), 1024});
        run_gemm(lds, (const bf16_t*)(ws + WS_HX), (const bf16_t*)(ws + WS_WIN), NTOK, 2048, 1024, FQkvg{(bf16_t*)(ws + WS_QKVG), (const float*)(ws + WS_ROPE), (const float*)(ws + WS_ROPE) + 2048 * 32});
        run_gemm(lds, (const bf16_t*)(ws + WS_WF), (const bf16_t*)(ws + WS_HX), 1024, NTOK, 1024, FFnetT{(bf16_t*)(ws + WS_FT)});
    });
    RUN(3, {
        run_gemm(lds, (const bf16_t*)(ws + WS_DFT), (const bf16_t*)(ws + WS_FT), 2048, 8192, 4096, FFnetOut{(bf16_t*)(ws + WS_MIX)});
        for (int item = blockIdx.x; item < 256; item += gridDim.x) retention_item(P, lds, item);
    });
    RUN(4, {
        pg8::Gemm g{(const bf16_t*)(ws + WS_MIX), (const bf16_t*)(ws + WS_WOUT), NTOK, 1024, 1024}; pg8::StaticOrder S; S.init(NTOK, 1024, (int)gridDim.x, (int)blockIdx.x);
        pg8::EpiF32 E{(float*)(ws + WS_QKVG), 1024};
        pg8::gemm_phase<pg8::EpiF32, pg8::StaticOrder>(lds, g, S, E);
    });
    RUN(5, phase5(P));
    RUN(6, run_gemm(lds, (const bf16_t*)(ws + WS_HX), (const bf16_t*)(ws + WS_WQ), NTOK, 2048, 1024, FPlain{(bf16_t*)(ws + WS_FT), 2048}));
    RUN(7, phase7(P, lds));
    const int prole = (IN(8) || IN(10)) ? peer_role(xctr, my_xcc, my_xrank) : 0;
    RUN(8, phase8<0>(P, lds, (float*)(ws + WS_PART), prole));
    if (TIMESEC == 3 && SPLITK > 0 && IN(8)) { grid.sync(); TS_BEGIN(3); phase8<VARIANT>(P, lds, (float*)(ws + WS_POUT), prole); TS_END(3); grid.sync(); }
    RUN(9, phase9(P, lds));
    RUN(10, phase10(P, lds, prole));
    if (IN(11)) phase11(P);
    if (TIMESEC && PLO > 0 && PHI == 12 && blockIdx.x == 0 && threadIdx.x == 0) {
        const unsigned long long dt = ((volatile unsigned long long*)(P.ws + 32768))[1] * TSK, t0 = __builtin_amdgcn_s_memrealtime();
        while (__builtin_amdgcn_s_memrealtime() - t0 < dt) __builtin_amdgcn_s_sleep(16);
    }
#undef RUN
#undef IN
#undef SEAM
}

template <int PLO, int PHI> static hipError_t launch_range(const Params& p0, int lo, int hi, int variant, int grid, hipStream_t stream) {
    Params p = p0; p.ph_lo = lo; p.ph_hi = hi; p.variant = variant;
    void* args[] = {&p};
    return hipLaunchCooperativeKernel((const void*)fwd_megakernel<PLO, PHI>, dim3(grid), dim3(NTHREADS), args, LDS_BYTES, stream);
}
extern "C" void kernel_launch(void* const* d_in, const int* in_sizes, int n_in, void* d_out, int out_size, void* d_ws, size_t ws_size, hipStream_t stream) {
    static int grid = 0;
    if (grid == 0) {
        int dev = 0, cus = 0;
        (void)hipGetDevice(&dev);
        (void)hipDeviceGetAttribute(&cus, hipDeviceAttributeMultiprocessorCount, dev);
        if (SPLITK == 0) (void)hipFuncSetAttribute((const void*)fwd_megakernel<0, (SPLITK > 0 ? SPLITK : 12)>, hipFuncAttributeMaxDynamicSharedMemorySize, LDS_BYTES);
        if (SPLITK > 0) {
            (void)hipFuncSetAttribute((const void*)fwd_megakernel<0, (SPLITK > 0 ? SPLITK : 12)>, hipFuncAttributeMaxDynamicSharedMemorySize, LDS_BYTES);
            (void)hipFuncSetAttribute((const void*)fwd_megakernel<(SPLITK > 0 ? SPLITK : 0), 12>, hipFuncAttributeMaxDynamicSharedMemorySize, LDS_BYTES);
        }
        grid = cus;
        if (ws_size < WS_END || n_in != 20) fprintf(stderr, "kernel_launch: unexpected ws_size %zu / n_in %d\n", ws_size, n_in);
        (void)hipGetLastError();
    }
    Params p{};
    for (int i = 0; i < 20; ++i) p.in[i] = (const float*)d_in[i];
    p.out = (float*)d_out; p.ws = (unsigned char*)d_ws;
    hipError_t e = hipMemsetAsync(d_ws, 0, 65536, stream);
    if (e != hipSuccess) fprintf(stderr, "memset failed\n");
    if (SPLITK > 0) {
        e = launch_range<0, (SPLITK > 0 ? SPLITK : 12)>(p, 0, 12, 0, grid, stream);
        if (e == hipSuccess) e = launch_range<(SPLITK > 0 ? SPLITK : 0), 12>(p, 0, 12, 0, grid, stream);
    } else if (DUPK >= 0) {
        e = launch_range<0, (SPLITK > 0 ? SPLITK : 12)>(p, 0, DUPK + 1, 0, grid, stream);
        if (e == hipSuccess) e = launch_range<0, (SPLITK > 0 ? SPLITK : 12)>(p, DUPK, 12, VARIANT, grid, stream);
    } else {
        e = launch_range<0, (SPLITK > 0 ? SPLITK : 12)>(p, 0, 12, 0, grid, stream);
    }
    if (e != hipSuccess) fprintf(stderr, "cooperative launch failed: %s (grid %d)\n", hipGetErrorString(e), grid);
}
```

```cpp
#include <hip/hip_runtime.h>
#include <hip/hip_cooperative_groups.h>
#include <cstdio>
namespace cg = cooperative_groups;
#define VARIANT 0
#define SPLITK 0
#define TIMESEC 0
#define TSK 20
#define TS_BEGIN(id) do { if (TIMESEC == (id) && SPLITK > 0 && blockIdx.x == 0 && threadIdx.x == 0) ((volatile unsigned long long*)(P.ws + 32768))[0] = __builtin_amdgcn_s_memrealtime(); } while (0)
#define TS_END(id) do { if (TIMESEC == (id) && SPLITK > 0 && blockIdx.x == 0 && threadIdx.x == 0) { volatile unsigned long long* _p = (volatile unsigned long long*)(P.ws + 32768); _p[1] = _p[1] + (__builtin_amdgcn_s_memrealtime() - _p[0]); } } while (0)
#define DUPK -1

#define DI __device__ __forceinline__
#define LAS __attribute__((address_space(3)))
typedef unsigned short bf16_t;
typedef short bf16x8 __attribute__((ext_vector_type(8)));
typedef float f32x4 __attribute__((ext_vector_type(4)));
typedef float f32x16 __attribute__((ext_vector_type(16)));
typedef unsigned u32x4 __attribute__((ext_vector_type(4)));
typedef unsigned u32x2 __attribute__((ext_vector_type(2)));

constexpr int NB = 16, SEQ = 2048, DM = 1024, NTOK = NB * SEQ, CTXL = 256, NCTX = NB * CTXL;
constexpr int INW = 2560, F_OFF = 2048;
constexpr float EPSV = 1e-6f;
constexpr int NTHREADS = 512, NWAVES = 8;
constexpr int LDS_BYTES = 160 * 1024;
constexpr int NTOKP = NTOK;

constexpr size_t MB = 1024 * 1024;
constexpr size_t WS_MOD = 64 * 1024;
constexpr size_t WS_ROPE = 512 * 1024;
constexpr size_t WS_KEYS = 1 * MB;
constexpr size_t WS_WIN = 2 * MB;
constexpr size_t WS_WF = 6 * MB;
constexpr size_t WS_WOUT = 8 * MB;
constexpr size_t WS_WQ = 10 * MB;
constexpr size_t WS_DFT = 14 * MB;
constexpr size_t WS_HC = 30 * MB;
constexpr size_t WS_CKV = 38 * MB;
constexpr size_t WS_IDS = 46 * MB;
constexpr size_t WS_WTS = 62 * MB;
constexpr size_t WS_HX = 80 * MB;
constexpr size_t WS_QKVG = 144 * MB;
constexpr size_t WS_FT = 272 * MB;
constexpr size_t WS_MIX = 336 * MB;
constexpr size_t WS_SB = 400 * MB;
constexpr size_t WS_UB = 448 * MB;
constexpr size_t WS_VB8 = 464 * MB;
constexpr size_t WS_HXE = 336 * MB;
constexpr size_t WS_HXO = 368 * MB;
constexpr size_t WS_P1024 = 1 * MB + 128 * 1024;
constexpr size_t WS_H2S = 416 * MB;
constexpr size_t WS_END = 484 * MB;
constexpr size_t WS_SID = 30 * MB;
constexpr size_t WS_SIDB = 46 * MB;
constexpr size_t WS_OVF = 46 * MB + 32 * 4096 * 256 + 4096;
constexpr int OVF_CAP = 65536;
constexpr size_t WS_SWT = 400 * MB;
constexpr size_t WS_CIT = 14 * MB;
constexpr size_t WS_PART = 272 * MB;
constexpr size_t WS_POUT = 272 * MB;

namespace pg8 {
#define PG8_LAS __attribute__((address_space(3)))
constexpr int BM = 256, BK = 64, HALF = 128, HTB = HALF * BK * 2, STAGE_BYTES = 8 * HTB, NXCD = 8, WGM = 8;
__host__ __device__ __forceinline__ int lds_byte(int r, int c) { const int st = (r >> 4) * 2 + (c >> 5), rr = r & 15, cc = c & 31, ob = rr * 64 + cc * 2; return st * 1024 + (ob ^ (((ob >> 9) & 1) << 5)); }
__host__ __device__ __forceinline__ void stage_rc(int b, int& R, int& C) { const int st = b / 1024, sb = b % 1024, swz = sb ^ (((sb >> 9) & 1) << 5); R = (st >> 1) * 16 + swz / 64; C = (st & 1) * 32 + (swz % 64) / 2; }
__host__ __device__ __forceinline__ int perm32(int rho) { const int n = rho >> 4, i = rho & 15; return 8 * (i >> 2) + 4 * n + (i & 3); }
struct Unit { int pm, pn; };
struct Gemm { const bf16_t* A; const bf16_t* Bt; int M, N, K; };
struct StaticOrder {
    int nM, nN, nwg, G, c;
    __host__ __device__ void init(int M, int N, int G_, int c_) { nM = M / BM; nN = N / BM; nwg = nM * nN; G = G_; c = c_; }
    __host__ __device__ bool next(int i, Unit& u) const {
        const long L = (long)i * G + c; if (L >= nwg) return false;
        int wgid = (int)L; { const int q = nwg / NXCD, r = nwg % NXCD, xcd = wgid % NXCD, off = wgid / NXCD; wgid = (xcd < r ? xcd * (q + 1) : r * (q + 1) + (xcd - r) * q) + off; }
        const int nig = WGM * nN, gid = wgid / nig, fm = gid * WGM, gsz = (nM - fm) < WGM ? (nM - fm) : WGM;
        u.pm = fm + ((wgid % nig) % gsz); u.pn = (wgid % nig) / gsz; return true;
    }
    __device__ __forceinline__ void a_ready(const Unit&) const {}
    __device__ __forceinline__ void done(const Unit&) const {}
};
__device__ __forceinline__ unsigned cvt_pk_bf16(float lo, float hi) { unsigned r; asm volatile("v_cvt_pk_bf16_f32 %0, %1, %2" : "=v"(r) : "v"(lo), "v"(hi)); return r; }

struct EpiF32 {
    static constexpr bool PERM = false;
    float* C; int ldc;
    __device__ __forceinline__ void operator()(const f32x4 (&acc)[2][2][4][2], const Unit& u, int wr, int wc, int fr, int fq) const {
        const int row0 = u.pm * BM + wr * 64 + fr, col0 = u.pn * BM + wc * 32 + 4 * fq;
#pragma unroll
        for (int ai = 0; ai < 2; ++ai)
#pragma unroll
            for (int m = 0; m < 4; ++m) { float* rowp = C + (size_t)(row0 + ai * HALF + m * 16) * ldc + col0;
#pragma unroll
                for (int bj = 0; bj < 2; ++bj)
#pragma unroll
                    for (int n = 0; n < 2; ++n) *(f32x4*)(rowp + bj * HALF + n * 16) = acc[ai][bj][m][n]; }
    }
};
template <class F> struct EpiBf16F {
    static constexpr bool PERM = true;
    F f;
    __device__ __forceinline__ void operator()(const f32x4 (&acc)[2][2][4][2], const Unit& u, int wr, int wc, int fr, int fq) const {
        const int row0 = u.pm * BM + wr * 64 + fr, col0 = u.pn * BM + wc * 32 + 8 * fq;
#pragma unroll
        for (int ai = 0; ai < 2; ++ai)
#pragma unroll
            for (int m = 0; m < 4; ++m)
#pragma unroll
                for (int bj = 0; bj < 2; ++bj) f(row0 + ai * HALF + m * 16, col0 + bj * HALF, acc[ai][bj][m][0], acc[ai][bj][m][1]);
    }
};

template <class Epi, class Sched>
__device__ __forceinline__ void gemm_phase(PG8_LAS unsigned char* lds, const Gemm g, const Sched& S, const Epi& E) {
    const int tid = threadIdx.x, wid = __builtin_amdgcn_readfirstlane(tid >> 6), lane = tid & 63, wr = wid >> 2, wc = wid & 3, fr = lane & 15, fq = lane >> 4;
    const int K = g.K, nt = K / BK;
    unsigned voffA[2], voffB[2];
#pragma unroll
    for (int i = 0; i < 2; ++i) { int R, C; stage_rc(tid * 16 + i * 8192, R, C); const int Rb = Epi::PERM ? ((R & ~31) + perm32(R & 31)) : R;
        voffA[i] = (unsigned)(R * K + C) * 2u; voffB[i] = (unsigned)(Rb * K + C) * 2u; }
    const size_t kstep = (size_t)(BK * 2);
    const size_t hstep = (size_t)HALF * K * 2;
    const size_t tstep = 2 * hstep;
    const unsigned ldsw = (unsigned)wid * 1024u;
    const int aoff = lds_byte(wr * 64 + fr, fq * 8), boff = lds_byte(wc * 32 + fr, fq * 8);
#define PG8_SA(b, h) (((b) * 2 + (h)) * HTB)
#define PG8_SB(b, h) ((4 + (b) * 2 + (h)) * HTB)
#define PG8_STAGE(bufoff, gbase, voff) do { _Pragma("unroll") for (int _i = 0; _i < 2; ++_i) \
        __builtin_amdgcn_global_load_lds((const unsigned*)((const char*)(gbase) + (voff)[_i]), (PG8_LAS unsigned*)(lds + (bufoff) + ldsw + _i * 8192), 16, 0, 0); } while (0)
#define PG8_LDA(dst, b, h) do { _Pragma("unroll") for (int m = 0; m < 4; ++m) _Pragma("unroll") for (int k = 0; k < 2; ++k) dst[m][k] = *(const PG8_LAS bf16x8*)(lds + PG8_SA(b, h) + aoff + m * 2048 + k * 1024); } while (0)
#define PG8_LDB(dst, b, h) do { _Pragma("unroll") for (int n = 0; n < 2; ++n) _Pragma("unroll") for (int k = 0; k < 2; ++k) dst[n][k] = *(const PG8_LAS bf16x8*)(lds + PG8_SB(b, h) + boff + n * 2048 + k * 1024); } while (0)
#define PG8_MMA(ai, bj, At, Bt) do { __builtin_amdgcn_s_setprio(1); _Pragma("unroll") for (int m = 0; m < 4; ++m) _Pragma("unroll") for (int n = 0; n < 2; ++n) _Pragma("unroll") for (int k = 0; k < 2; ++k) \
        acc[ai][bj][m][n] = __builtin_amdgcn_mfma_f32_16x16x32_bf16(Bt[n][k], At[m][k], acc[ai][bj][m][n], 0, 0, 0); __builtin_amdgcn_s_setprio(0); } while (0)
#define PG8_WAIT_V(n) asm volatile("s_waitcnt vmcnt(" #n ")" ::: "memory")
#define PG8_WAIT_L(n) asm volatile("s_waitcnt lgkmcnt(" #n ")" ::: "memory")
#define PG8_BAR __builtin_amdgcn_s_barrier()
#define PG8_SCHED __builtin_amdgcn_sched_barrier(0)
    Unit cur, nxt; int ui = 0;
    if (!S.next(0, cur)) return;
    f32x4 acc[2][2][4][2];
#pragma unroll
    for (int a = 0; a < 2; ++a)
#pragma unroll
        for (int b = 0; b < 2; ++b)
#pragma unroll
            for (int m = 0; m < 4; ++m)
#pragma unroll
                for (int n = 0; n < 2; ++n) acc[a][b][m][n] = (f32x4){0.f, 0.f, 0.f, 0.f};
    bf16x8 At[4][2], B0[2][2], B1[2][2];
    const char* cA = (const char*)g.A + (size_t)cur.pm * tstep; const char* cB = (const char*)g.Bt + (size_t)cur.pn * tstep;
    S.a_ready(cur);
    PG8_STAGE(PG8_SB(0, 0), cB, voffB); PG8_STAGE(PG8_SA(0, 0), cA, voffA); PG8_STAGE(PG8_SB(0, 1), cB + hstep, voffB); PG8_STAGE(PG8_SA(0, 1), cA + hstep, voffA);
    if (wr == 1) PG8_BAR;
    PG8_WAIT_V(4); PG8_BAR;
    PG8_STAGE(PG8_SB(1, 0), cB + kstep, voffB); PG8_STAGE(PG8_SA(1, 0), cA + kstep, voffA); PG8_STAGE(PG8_SB(1, 1), cB + hstep + kstep, voffB);
    PG8_WAIT_V(6); PG8_BAR;
    for (;;) {
        const bool has_next = S.next(ui + 1, nxt);
        const char* nA = has_next ? (const char*)g.A + (size_t)nxt.pm * tstep : cA; const char* nB = has_next ? (const char*)g.Bt + (size_t)nxt.pn * tstep : cB;
        for (int t = 0; t < nt; t += 2) {
            const bool last = (t == nt - 2);
            const char* a1 = cA + (size_t)(t + 1) * kstep;
            const char* a2 = last ? nA : cA + (size_t)(t + 2) * kstep; const char* b2 = last ? nB : cB + (size_t)(t + 2) * kstep;
            const char* a3 = a2 + kstep; const char* b3 = b2 + kstep;
            if (last && has_next) S.a_ready(nxt);
            PG8_LDB(B0, 0, 0); PG8_SCHED; PG8_LDA(At, 0, 0); PG8_STAGE(PG8_SA(1, 1), a1 + hstep, voffA);
            PG8_WAIT_L(8); PG8_BAR; PG8_WAIT_L(0); PG8_MMA(0, 0, At, B0); PG8_BAR; PG8_SCHED;
            PG8_LDB(B1, 0, 1); PG8_STAGE(PG8_SB(0, 0), b2, voffB);
            PG8_BAR; PG8_WAIT_L(0); PG8_MMA(0, 1, At, B1); PG8_BAR;
            PG8_LDA(At, 0, 1); PG8_STAGE(PG8_SA(0, 0), a2, voffA);
            PG8_BAR; PG8_WAIT_L(0); PG8_MMA(1, 0, At, B0); PG8_BAR; PG8_SCHED;
            PG8_STAGE(PG8_SB(0, 1), b2 + hstep, voffB);
            PG8_WAIT_V(6); PG8_BAR; PG8_MMA(1, 1, At, B1); PG8_BAR;
            PG8_LDB(B0, 1, 0); PG8_SCHED; PG8_LDA(At, 1, 0); PG8_STAGE(PG8_SA(0, 1), a2 + hstep, voffA);
            PG8_WAIT_L(8); PG8_BAR; PG8_WAIT_L(0); PG8_MMA(0, 0, At, B0); PG8_BAR; PG8_SCHED;
            PG8_LDB(B1, 1, 1); PG8_STAGE(PG8_SB(1, 0), b3, voffB);
            PG8_BAR; PG8_WAIT_L(0); PG8_MMA(0, 1, At, B1); PG8_BAR;
            PG8_LDA(At, 1, 1); PG8_STAGE(PG8_SA(1, 0), a3, voffA);
            PG8_BAR; PG8_WAIT_L(0); PG8_MMA(1, 0, At, B0); PG8_BAR; PG8_SCHED;
            PG8_STAGE(PG8_SB(1, 1), b3 + hstep, voffB);
            PG8_WAIT_V(6); PG8_BAR; PG8_MMA(1, 1, At, B1); PG8_BAR;
        }
        E(acc, cur, wr, wc, fr, fq); S.done(cur);
        if (!has_next) break;
#pragma unroll
        for (int a = 0; a < 2; ++a)
#pragma unroll
            for (int b = 0; b < 2; ++b)
#pragma unroll
                for (int m = 0; m < 4; ++m)
#pragma unroll
                    for (int n = 0; n < 2; ++n) acc[a][b][m][n] = (f32x4){0.f, 0.f, 0.f, 0.f};
        cur = nxt; cA = nA; cB = nB; ++ui;
    }
    PG8_WAIT_V(0);
    if (wr == 0) PG8_BAR;
    PG8_BAR;
#undef PG8_SA
#undef PG8_SB
#undef PG8_STAGE
#undef PG8_LDA
#undef PG8_LDB
#undef PG8_MMA
#undef PG8_WAIT_V
#undef PG8_WAIT_L
#undef PG8_BAR
#undef PG8_SCHED
}
}

DI int tidx() { int t = (int)threadIdx.x; asm volatile("" : "+v"(t)); return t; }
DI unsigned pk2(float lo, float hi) { return pg8::cvt_pk_bf16(lo, hi); }
DI bf16_t f2bf(float f) { return (bf16_t)(pk2(f, 0.f) & 0xffffu); }
DI float bf2f(bf16_t b) { return __uint_as_float(((unsigned)b) << 16); }
DI float bflo(unsigned w) { return __uint_as_float(w << 16); }
DI float bfhi(unsigned w) { return __uint_as_float(w & 0xffff0000u); }
DI float wave_sum(float v) {
#pragma unroll
    for (int o = 1; o < 64; o <<= 1) v += __shfl_xor(v, o);
    return v;
}
DI float siluf(float x) { return x / (1.f + __expf(-x)); }
DI float clamp448(float x) { return fminf(fmaxf(x, -448.f), 448.f); }
DI float gelu_erf(float a) { return 0.5f * a * (1.f + erff(a * 0.70710678118654752f)); }
#define LDS_WAIT() asm volatile("s_waitcnt lgkmcnt(0)" ::: "memory")
#define MFMA32(a, b, c) __builtin_amdgcn_mfma_f32_32x32x16_bf16((a), (b), (c), 0, 0, 0)
DI int crow(int reg, int h) { return (reg & 3) + 8 * (reg >> 2) + 4 * h; }
DI f32x16 zero16() { f32x16 z;
#pragma unroll
    for (int i = 0; i < 16; ++i) z[i] = 0.f;
    return z; }


#define XB_TMO      128
#define XB_XCNT(j)  (256  + 64 * (j))
#define XB_XSUB(j)  (1280 + 64 * (j))
#define XB_XGEN(j)  (2304 + 64 * (j))
#define XB_TOP      3328
#define XB_TOPGEN   3392
#define XCD_BAR_WORDS 3456
#define XB_SPIN_CAP (1u << 22)
DI unsigned xb_ld(unsigned* p)              { return __hip_atomic_load(p, __ATOMIC_RELAXED, __HIP_MEMORY_SCOPE_AGENT); }
DI unsigned xb_add(unsigned* p, unsigned v) { return __hip_atomic_fetch_add(p, v, __ATOMIC_RELAXED, __HIP_MEMORY_SCOPE_AGENT); }
DI unsigned xb_xcc_id() { return (unsigned)__builtin_amdgcn_s_getreg((3 << 11) | 20) & 0xFu; }
#define XB_SPIN(cond, bar) do { unsigned _sp = 0; while (cond) { __builtin_amdgcn_s_sleep(1); \
    if ((++_sp & 255u) == 0u) { if (xb_ld(&(bar)[XB_TMO])) break; if (_sp > XB_SPIN_CAP) { atomicAdd(&(bar)[XB_TMO], 1u); break; } } } } while (0)
struct XcdBarrier { unsigned* bar; unsigned x; volatile LAS unsigned* st; };
DI XcdBarrier xcd_barrier_post(unsigned* bar, volatile LAS unsigned* st) {
    XcdBarrier b; b.bar = bar; b.x = xb_xcc_id(); b.st = st;
    if (threadIdx.x == 0) (void)xb_add(&bar[XB_XCNT(b.x)], 1u);
    return b;
}
DI void xcd_barrier_complete(unsigned* bar, unsigned x, unsigned& nloc, unsigned& nx) {
    const unsigned G = gridDim.x * gridDim.y * gridDim.z;
    unsigned sum, cnt, mine, sp = 0u;
    for (;;) {
        sum = 0u; cnt = 0u; mine = 0u;
#pragma unroll
        for (unsigned j = 0; j < 16; ++j) { const unsigned c = xb_ld(&bar[XB_XCNT(j)]); sum += c; cnt += (c > 0u) ? 1u : 0u; mine = (j == x) ? c : mine; }
        if (sum == G) break;
        __builtin_amdgcn_s_sleep(1);
        if ((++sp & 255u) == 0u) { if (xb_ld(&bar[XB_TMO])) break; if (sp > XB_SPIN_CAP) { atomicAdd(&bar[XB_TMO], 1u); break; } }
    }
    nloc = mine > 0u ? mine : 1u; nx = cnt > 0u ? cnt : 1u;
}
DI void xcd_barrier(const XcdBarrier& b) {
    asm volatile("s_waitcnt vmcnt(0)" ::: "memory");
    __syncthreads();
    if (threadIdx.x == 0) {
        unsigned* bar = b.bar;
        __builtin_amdgcn_s_waitcnt(0);
        unsigned nloc = b.st[0], nx = b.st[1];
        if (nloc == 0u) { xcd_barrier_complete(bar, b.x, nloc, nx); b.st[0] = nloc; b.st[1] = nx; }
        const unsigned old = xb_add(&bar[XB_XSUB(b.x)], 1u);
        const unsigned gen = old / nloc;
        if (old + 1u == (gen + 1u) * nloc) {
            __builtin_amdgcn_fence(__ATOMIC_RELEASE, "agent");
            asm volatile("s_waitcnt vmcnt(0)" ::: "memory");
            const unsigned og = xb_add(&bar[XB_TOP], 1u);
            const unsigned tg = og / nx;
            if (og + 1u == (tg + 1u) * nx) xb_add(&bar[XB_TOPGEN], 1u);
            else XB_SPIN(xb_ld(&bar[XB_TOPGEN]) == tg, bar);
            __builtin_amdgcn_fence(__ATOMIC_ACQUIRE, "agent");
            xb_add(&bar[XB_XGEN(b.x)], 1u);
            asm volatile("s_waitcnt vmcnt(0)" ::: "memory");
        } else {
            XB_SPIN(xb_ld(&bar[XB_XGEN(b.x)]) == gen, bar);
            __builtin_amdgcn_fence(__ATOMIC_ACQUIRE, "agent");
            asm volatile("s_waitcnt vmcnt(0)" ::: "memory");
        }
    }
    __syncthreads();
}

struct Params { const float* in[20]; float* out; unsigned char* ws; int ph_lo, ph_hi, variant, pad; };
enum { I_X = 0, I_C, I_CTX, I_CCTX, I_WADA, I_BADA, I_NPREMIX, I_NPOSTMIX, I_WIN, I_DECF, I_DECB, I_RETGAIN, I_WOUT, I_NPREFFN, I_NPOSTFFN, I_WQ, I_KEYS1, I_KEYS2, I_U, I_V };

DI int win_srccol(int n) { if (n < 1024) { const int p = n & 63; return (n & ~63) + (p >> 1) + 32 * (p & 1); } return n; }
DI void p0_transpose_item(const float* W, int ldw, int nout, bf16_t* WT, int mode, LAS float* scr, int item, int lane) {
    const int nblk = nout / 32, kb = item / nblk, nb = item % nblk, k0 = 64 * kb, n0 = 32 * nb;
    const int nn = n0 + (lane & 31);
    const int sc = mode ? win_srccol(nn) : nn;
    const float scale = (mode && nn >= 512 && nn < 1024) ? 0.125f : 1.0f;
#pragma unroll 8
    for (int i = 0; i < 32; ++i) { const int kk = 2 * i + (lane >> 5); scr[kk * 33 + (lane & 31)] = W[(size_t)(k0 + kk) * ldw + sc] * scale; }
    LDS_WAIT();
    const int c = lane & 7;
#pragma unroll
    for (int j = 0; j < 4; ++j) { const int n = (lane >> 3) + 8 * j; const LAS float* s = scr + (8 * c) * 33 + n;
        u32x4 o; o.x = pk2(s[0 * 33], s[1 * 33]); o.y = pk2(s[2 * 33], s[3 * 33]); o.z = pk2(s[4 * 33], s[5 * 33]); o.w = pk2(s[6 * 33], s[7 * 33]);
        *(u32x4*)(WT + (size_t)(n0 + n) * 1024 + k0 + 8 * c) = o; }
    LDS_WAIT();
}

DI void prep_tables(LAS unsigned char* lds) {
    const int tid = threadIdx.x;
    LAS float* ctab = (LAS float*)(lds + 69632);
    if (tid < 128) { float s, c; sincospif((float)tid * (1.0f / 64.0f), &s, &c); ctab[tid] = c; ctab[128 + tid] = s; }
    __syncthreads();
}
DI void prep_weights(const Params& P, LAS unsigned char* lds) {
    const int tid = threadIdx.x, lane = tid & 63, wave = tid >> 6;
    const int gw = blockIdx.x * NWAVES + wave, NGW = gridDim.x * NWAVES;
    const int gt = blockIdx.x * NTHREADS + tid, NGT = gridDim.x * NTHREADS;
    unsigned char* ws = P.ws;
    LAS float* scr = (LAS float*)(lds + wave * 8704);
    LAS float* ctab = (LAS float*)(lds + 69632);
    LAS float* stab = ctab + 128;
    {
        bf16_t* WIN = (bf16_t*)(ws + WS_WIN); bf16_t* WOUT = (bf16_t*)(ws + WS_WOUT); bf16_t* WQ = (bf16_t*)(ws + WS_WQ);
        constexpr int I1 = 16 * 64, I2 = 16 * 32, I3 = 16 * 64;
        for (int it = gw; it < I1 + I2 + I3; it += NGW) {
            int r = it;
            if (r < I1) { p0_transpose_item(P.in[I_WIN], INW, 2048, WIN, 1, scr, r, lane); continue; } r -= I1;
            if (r < I2) { p0_transpose_item(P.in[I_WOUT], 1024, 1024, WOUT, 0, scr, r, lane); continue; } r -= I2;
            p0_transpose_item(P.in[I_WQ], 2048, 2048, WQ, 0, scr, r, lane);
        }
    }
    {
        bf16_t* WF = (bf16_t*)(ws + WS_WF);
        for (int it = gw; it < 4096; it += NGW) {
            const int kk = it >> 2, g = it & 3;
            const float* src = P.in[I_WIN] + (size_t)kk * INW + F_OFF + g * 128;
            scr[lane] = src[lane]; scr[lane + 64] = src[lane + 64];
            LDS_WAIT();
#pragma unroll
            for (int q = 0; q < 2; ++q) {
                const int l = lane + 64 * q; float ac = 0.f, as = 0.f;
                for (int c = 0; c < 128; ++c) { const float f = scr[c]; const int m = (c * l) & 127; ac += f * ctab[m]; as += f * stab[m]; }
                WF[(size_t)(g * 128 + l) * 1024 + kk] = f2bf(ac);
                WF[(size_t)(512 + g * 128 + l) * 1024 + kk] = f2bf(as);
            }
            LDS_WAIT();
        }
    }
    {
        bf16_t* DFT = (bf16_t*)(ws + WS_DFT);
        for (int idx = gt; idx < 2048 * 1024; idx += NGT) {
            const int k = idx >> 10, c2 = (idx & 1023) * 2, part = c2 >> 10, j0 = c2 & 1023;
            float s0, c0, s1, c1;
            sincospif((float)((j0 * k) & 2047) * (1.0f / 1024.0f), &s0, &c0);
            sincospif((float)(((j0 + 1) * k) & 2047) * (1.0f / 1024.0f), &s1, &c1);
            const float v0 = (part ? (j0 == 0 ? 0.f : -s0) : c0) * (1.0f / 512.0f), v1 = (part ? -s1 : c1) * (1.0f / 512.0f);
            *(unsigned*)(DFT + (size_t)k * 2048 + c2) = pk2(v0, v1);
        }
    }
}

DI void phase0(const Params& P, LAS unsigned char* lds) {
    const int tid = threadIdx.x, lane = tid & 63, wave = tid >> 6;
    const int gw = blockIdx.x * NWAVES + wave, NGW = gridDim.x * NWAVES;
    const int gt = blockIdx.x * NTHREADS + tid, NGT = gridDim.x * NTHREADS;
    unsigned char* ws = P.ws;
    LAS float* svec = (LAS float*)(lds + 71680);
    for (int i = tid; i < 17 * 1024; i += NTHREADS) { const float v = (i < 16384) ? P.in[I_C][i] : P.in[I_CCTX][i - 16384]; svec[i] = siluf(v); }
    __syncthreads();
    {
        float* RC = (float*)(ws + WS_ROPE); float* RS = RC + 2048 * 32;
        for (int idx = gt; idx < 2048 * 32; idx += NGT) {
            const int n = idx >> 5, j = idx & 31; const float pos = (float)((j < 16) ? (n >> 6) : (n & 63));
            const float freq = powf(10000.0f, -(float)(j & 15) * (1.0f / 16.0f)); const float ang = pos * freq;
            RC[idx] = cosf(ang); RS[idx] = sinf(ang);
        }
        bf16_t* KEYS = (bf16_t*)(ws + WS_KEYS);
        for (int idx = gt; idx < 2 * 128 * 128; idx += NGT) KEYS[idx] = f2bf(idx < 16384 ? P.in[I_KEYS1][idx] : P.in[I_KEYS2][idx - 16384]);
    }
    {
        float* MOD = (float*)(ws + WS_MOD);
        for (int cb = blockIdx.x; cb < 256; cb += gridDim.x) {
            if (wave < 6) {
                const int col = cb * 24 + wave * 4;
                f32x4 acc[17];
#pragma unroll
                for (int r = 0; r < 17; ++r) acc[r] = (f32x4){0.f, 0.f, 0.f, 0.f};
#pragma unroll 1
                for (int i0 = 0; i0 < 16; i0 += 4) {
                    f32x4 w[4];
#pragma unroll
                    for (int i = 0; i < 4; ++i) w[i] = *(const f32x4*)(P.in[I_WADA] + (size_t)(lane + 64 * (i0 + i)) * 6144 + col);
#pragma unroll
                    for (int i = 0; i < 4; ++i) {
                        const int k = lane + 64 * (i0 + i);
#pragma unroll
                        for (int r = 0; r < 17; ++r) { const float s = svec[r * 1024 + k]; acc[r] += w[i] * s; }
                    }
                }
#pragma unroll
                for (int r = 0; r < 17; ++r) {
                    f32x4 a = acc[r];
#pragma unroll
                    for (int o = 1; o < 64; o <<= 1) { a.x += __shfl_xor(a.x, o); a.y += __shfl_xor(a.y, o); a.z += __shfl_xor(a.z, o); a.w += __shfl_xor(a.w, o); }
                    if (lane == 0) { const f32x4 bb = *(const f32x4*)(P.in[I_BADA] + col); *(f32x4*)(MOD + (size_t)r * 6144 + col) = a + bb; }
                }
            }
        }
    }
}

DI void norm_mod_row2(const float* xrow0, const float* xrow1, const float* gain, const float* sh, const float* sc, bf16_t* orow0, bf16_t* orow1, bf16_t* erow, bf16_t* frow, int fold, int lane) {
    const f32x4* xr0 = (const f32x4*)xrow0 + lane; const f32x4* xr1 = (const f32x4*)xrow1 + lane;
    f32x4 v0[4], v1[4]; float ss0 = 0.f, ss1 = 0.f;
#pragma unroll
    for (int j = 0; j < 4; ++j) { v0[j] = __builtin_nontemporal_load(&xr0[64 * j]); v1[j] = __builtin_nontemporal_load(&xr1[64 * j]); }
#pragma unroll
    for (int j = 0; j < 4; ++j) { ss0 += (v0[j].x * v0[j].x + v0[j].y * v0[j].y) + (v0[j].z * v0[j].z + v0[j].w * v0[j].w); ss1 += (v1[j].x * v1[j].x + v1[j].y * v1[j].y) + (v1[j].z * v1[j].z + v1[j].w * v1[j].w); }
    const float rstd0 = rsqrtf(wave_sum(ss0) * (1.0f / DM) + EPSV), rstd1 = rsqrtf(wave_sum(ss1) * (1.0f / DM) + EPSV);
#pragma unroll
    for (int j = 0; j < 4; ++j) {
        const f32x4 g = ((const f32x4*)gain)[64 * j + lane], s0 = ((const f32x4*)sc)[64 * j + lane], h0 = ((const f32x4*)sh)[64 * j + lane];
        const f32x4 gs = g * (s0 + 1.0f);
        const f32x4 y0 = v0[j] * rstd0 * gs + h0, y1 = v1[j] * rstd1 * gs + h0;
        u32x2 o0, o1; o0.x = pk2(y0.x, y0.y); o0.y = pk2(y0.z, y0.w); o1.x = pk2(y1.x, y1.y); o1.y = pk2(y1.z, y1.w);
        ((u32x2*)orow0)[64 * j + lane] = o0; ((u32x2*)orow1)[64 * j + lane] = o1;
        if (fold) {
            const f32x4 r0 = (f32x4){bflo(o0.x), bfhi(o0.x), bflo(o0.y), bfhi(o0.y)}, r1 = (f32x4){bflo(o1.x), bfhi(o1.x), bflo(o1.y), bfhi(o1.y)};
            const f32x4 e = fold == 1 ? r0 + r1 : r0, f = fold == 1 ? r0 - r1 : (f32x4){0.f, 0.f, 0.f, 0.f};
            u32x2 oe, of; oe.x = pk2(e.x, e.y); oe.y = pk2(e.z, e.w); of.x = pk2(f.x, f.y); of.y = pk2(f.z, f.w);
            ((u32x2*)erow)[64 * j + lane] = oe; ((u32x2*)frow)[64 * j + lane] = of;
        }
    }
}
DI void phase1(const Params& P) {
    const int lane = threadIdx.x & 63, wave = threadIdx.x >> 6;
    const int gw = blockIdx.x * NWAVES + wave, NGW = gridDim.x * NWAVES;
    const float* MOD = (const float*)(P.ws + WS_MOD);
    bf16_t* HX = (bf16_t*)(P.ws + WS_HX); bf16_t* HC = (bf16_t*)(P.ws + WS_HC);
    bf16_t* HXE = (bf16_t*)(P.ws + WS_HXE); bf16_t* HXO = (bf16_t*)(P.ws + WS_HXO);
    for (int q = gw; q < 16 * 1024 + NCTX / 2; q += NGW) {
        if (q < 16 * 1024) {
            const int b = q >> 10, j = q & 1023, n0 = j, n1 = j == 0 ? 1024 : 2048 - j;
            const float* m = MOD + (size_t)b * 6144;
            const size_t r0 = (size_t)b * SEQ + n0, r1 = (size_t)b * SEQ + n1;
            norm_mod_row2(P.in[I_X] + r0 * DM, P.in[I_X] + r1 * DM, P.in[I_NPREMIX], m, m + 1024, HX + r0 * DM, HX + r1 * DM,
                          HXE + (size_t)q * DM, HXO + (size_t)q * DM, j == 0 ? 2 : 1, lane);
        } else {
            const int rc = 2 * (q - 16 * 1024); const float* m = MOD + (size_t)16 * 6144;
            norm_mod_row2(P.in[I_CTX] + (size_t)rc * DM, P.in[I_CTX] + (size_t)(rc + 1) * DM, P.in[I_NPREMIX], m, m + 1024, HC + (size_t)rc * DM, HC + (size_t)(rc + 1) * DM, nullptr, nullptr, 0, lane);
        }
    }
}

struct FPlain { bf16_t* O; int ldc;
    DI void operator()(int row, int col0, const f32x4& v0, const f32x4& v1) const {
        u32x4 w; w.x = pk2(v0[0], v0[1]); w.y = pk2(v0[2], v0[3]); w.z = pk2(v1[0], v1[1]); w.w = pk2(v1[2], v1[3]);
        *(u32x4*)(O + (size_t)row * ldc + col0) = w; } };
struct FQkvg { bf16_t* O; const float* RC; const float* RS;
    DI void operator()(int row, int col0, const f32x4& a0, const f32x4& a1) const {
        f32x4 v0 = a0, v1 = a1;
        if (col0 < 1024) {
            const int n = row & 2047, j0 = (col0 & 63) >> 1;
            const f32x4 cs = *(const f32x4*)(RC + n * 32 + j0), sn = *(const f32x4*)(RS + n * 32 + j0);
            f32x4 r0, r1;
            r0[0] = v0[0] * cs[0] - v0[1] * sn[0]; r0[1] = v0[1] * cs[0] + v0[0] * sn[0];
            r0[2] = v0[2] * cs[1] - v0[3] * sn[1]; r0[3] = v0[3] * cs[1] + v0[2] * sn[1];
            r1[0] = v1[0] * cs[2] - v1[1] * sn[2]; r1[1] = v1[1] * cs[2] + v1[0] * sn[2];
            r1[2] = v1[2] * cs[3] - v1[3] * sn[3]; r1[3] = v1[3] * cs[3] + v1[2] * sn[3];
            v0 = r0; v1 = r1;
        }
        u32x4 w; w.x = pk2(v0[0], v0[1]); w.y = pk2(v0[2], v0[3]); w.z = pk2(v1[0], v1[1]); w.w = pk2(v1[2], v1[3]);
        *(u32x4*)(O + (size_t)row * 2048 + col0) = w; } };
struct FFoldT { bf16_t* FT; int koff;
    DI void operator()(int row, int col0, const f32x4& v0, const f32x4& v1) const {
        const int g = row >> 7, l = row & 127, b = col0 >> 10, j = col0 & 1023;
        u32x4 w; w.x = pk2(v0[0], v0[1]); w.y = pk2(v0[2], v0[3]); w.z = pk2(v1[0], v1[1]); w.w = pk2(v1[2], v1[3]);
        *(u32x4*)(FT + (size_t)((b * 4 + g) * 128 + l) * 2048 + koff + j) = w; } };
struct FFnetOut { bf16_t* MIX; const float* P1024;
    DI void operator()(int row, int col0, const f32x4& v0, const f32x4& v1) const {
        const int b = col0 >> 9, gc = col0 & 511;
        const float sg = (row & 1) ? (-1.0f / 512.0f) : (1.0f / 512.0f);
        const f32x4 n0 = *(const f32x4*)(P1024 + col0), n1 = *(const f32x4*)(P1024 + col0 + 4);
        const f32x4 a0 = v0 + n0 * sg, a1 = v1 + n1 * sg;
        u32x4 w; w.x = pk2(a0[0], a0[1]); w.y = pk2(a0[2], a0[3]); w.z = pk2(a1[0], a1[1]); w.w = pk2(a1[2], a1[3]);
        *(u32x4*)(MIX + (size_t)(b * 2048 + row) * 1024 + 512 + gc) = w; } };

template <class F> DI void run_gemm(LAS unsigned char* lds, const bf16_t* A, const bf16_t* Bt, int M, int N, int K, const F& f, int rot = 0) {
    pg8::Gemm g{A, Bt, M, N, K}; pg8::StaticOrder S; int cid_ = (int)blockIdx.x + rot; if (cid_ >= (int)gridDim.x) cid_ -= (int)gridDim.x;
    S.init(M, N, (int)gridDim.x, cid_);
    pg8::EpiBf16F<F> E{f};
    pg8::gemm_phase<pg8::EpiBf16F<F>, pg8::StaticOrder>(lds, g, S, E);
}

DI unsigned peer_blk(unsigned e) { return ((e >> 7) + (e & 31u)) & 31u; }
DI unsigned peer_row(unsigned e) { return ((e >> 7) << 2) | ((e >> 5) & 3u); }
DI void peer_tables(const Params& P, LAS unsigned char* lds, const int part, const int hb, const int nhb) {
    const int tid = threadIdx.x, lane = tid & 63, wave = tid >> 6;
    if (part == 0) {
        unsigned char* UB = P.ws + WS_UB;
        for (int e0 = (hb * NWAVES + wave) * 4; e0 < 16384; e0 += nhb * NWAVES * 4) {
            f32x4 v[4][4];
#pragma unroll
            for (int q = 0; q < 4; ++q)
#pragma unroll
                for (int j = 0; j < 4; ++j) v[q][j] = __builtin_nontemporal_load(&((const f32x4*)(P.in[I_U] + (size_t)(e0 + q) * DM))[64 * j + lane]);
#pragma unroll
            for (int q = 0; q < 4; ++q) {
                const unsigned eb = peer_blk((unsigned)(e0 + q)), row = peer_row((unsigned)(e0 + q));
#pragma unroll
                for (int j = 0; j < 4; ++j) {
                    int w8 = 0; w8 = __builtin_amdgcn_cvt_pk_fp8_f32(clamp448(v[q][j].x * 64.f), clamp448(v[q][j].y * 64.f), w8, false); w8 = __builtin_amdgcn_cvt_pk_fp8_f32(clamp448(v[q][j].z * 64.f), clamp448(v[q][j].w * 64.f), w8, true);
                    __builtin_nontemporal_store((unsigned)w8, (unsigned*)(UB + ((size_t)(eb * 8 + 2 * j + (lane >> 5)) * 512 + row) * 128 + 4 * (lane & 31)));
                }
            }
        }
    } else {
        unsigned char* VB8 = P.ws + WS_VB8;
        for (int tl = hb; tl < 512; tl += nhb) {
            const int e0 = tl * 32;
            __syncthreads();
#pragma unroll
            for (int hf = 0; hf < 2; ++hf) {
                f32x4 v[8];
#pragma unroll
                for (int it = 0; it < 8; ++it) { const int idx = (hf * 8 + it) * NTHREADS + tid; v[it] = __builtin_nontemporal_load(&((const f32x4*)(P.in[I_V] + (size_t)(e0 + (idx >> 8)) * DM))[idx & 255]); }
#pragma unroll
                for (int it = 0; it < 8; ++it) { const int idx = (hf * 8 + it) * NTHREADS + tid, row = idx >> 8, f4 = idx & 255;
                    int w = 0; w = __builtin_amdgcn_cvt_pk_fp8_f32(clamp448(v[it].x * 512.f), clamp448(v[it].y * 512.f), w, false); w = __builtin_amdgcn_cvt_pk_fp8_f32(clamp448(v[it].z * 512.f), clamp448(v[it].w * 512.f), w, true);
                    *(LAS unsigned*)(lds + (f4 >> 1) * 264 + row * 8 + (f4 & 1) * 4) = (unsigned)w; }
            }
            __syncthreads();
#pragma unroll
            for (int it = 0; it < 8; ++it) { const int g = it * NTHREADS + tid, c = g >> 5, e = g & 31;
                __builtin_nontemporal_store(*(const LAS u32x2*)(lds + c * 264 + e * 8), (u32x2*)(VB8 + ((size_t)c * 16384 + e0 + (int)peer_blk((unsigned)(e0 + e))) * 8)); }
        }
        __syncthreads();
    }
}

constexpr int R_Q = 0, R_K = 18432, R_KF = 36864, R_KB = 55296, R_V = 73728, R_P = 92160, R_SFT = 126976, R_SBT = 136192;
constexpr int LQ = 72, LT = 136, LO = 65;
constexpr int R_DTAB = 145408;

DI f32x16 mma_tile(const LAS bf16_t* A, int lda, const LAS bf16_t* Bt, int ldb, int K, f32x16 acc, int lane) {
    const int r = lane & 31, hh = lane >> 5;
    const LAS bf16_t* ap = A + r * lda + 8 * hh; const LAS bf16_t* bp = Bt + r * ldb + 8 * hh;
#pragma unroll 4
    for (int k0 = 0; k0 < K; k0 += 16) { const bf16x8 a = *(const LAS bf16x8*)(ap + k0); const bf16x8 b = *(const LAS bf16x8*)(bp + k0); acc = MFMA32(a, b, acc); }
    return acc;
}
typedef short s16x4 __attribute__((ext_vector_type(4)));
DI bf16x8 tr_frag(const LAS bf16_t* img, int pitch, int ks, int lane) {
    const int hq = lane >> 5, blk = (lane >> 4) & 1, q = (lane & 15) >> 2, p = lane & 3;
    const LAS bf16_t* a0 = img + (16 * ks + 8 * hq + q) * pitch + 16 * blk + 4 * p;
    const s16x4 lo = __builtin_amdgcn_ds_read_tr16_b64_v4i16((LAS s16x4*)a0);
    const s16x4 hi = __builtin_amdgcn_ds_read_tr16_b64_v4i16((LAS s16x4*)(a0 + 4 * pitch));
    return __builtin_shufflevector(lo, hi, 0, 1, 2, 3, 4, 5, 6, 7);
}
DI f32x16 mma_tile_rt(const LAS bf16_t* A, int lda, const LAS bf16_t* Timg, int pitch, int K, f32x16 acc, int lane) {
    const int r = lane & 31, hh = lane >> 5;
    const LAS bf16_t* ap = A + r * lda + 8 * hh;
#pragma unroll 4
    for (int ks = 0; ks < K / 16; ++ks) { const bf16x8 a = *(const LAS bf16x8*)(ap + 16 * ks); const bf16x8 b = tr_frag(Timg, pitch, ks, lane); acc = MFMA32(a, b, acc); }
    return acc;
}
DI f32x16 mma_tile_tt(const LAS bf16_t* TA, const LAS bf16_t* TB, int pitch, int K, f32x16 acc, int lane) {
#pragma unroll 4
    for (int ks = 0; ks < K / 16; ++ks) { const bf16x8 a = tr_frag(TA, pitch, ks, lane); const bf16x8 b = tr_frag(TB, pitch, ks, lane); acc = MFMA32(a, b, acc); }
    return acc;
}
struct ChunkRegs { u32x4 k0, k1, v0, v1, q0, q1; };
DI void chunk_load(ChunkRegs& R, const bf16_t* src, int stride, int colQ, int colK, int colV) {
    const int tid = threadIdx.x, j = tid >> 2, c0 = (tid & 3) * 16;
    const bf16_t* rowp = src + (size_t)j * stride;
    R.k0 = *(const u32x4*)(rowp + colK + c0); R.k1 = *(const u32x4*)(rowp + colK + c0 + 8);
    R.v0 = *(const u32x4*)(rowp + colV + c0); R.v1 = *(const u32x4*)(rowp + colV + c0 + 8);
    if (colQ >= 0) { R.q0 = *(const u32x4*)(rowp + colQ + c0); R.q1 = *(const u32x4*)(rowp + colQ + c0 + 8); }
}
DI void chunk_store(LAS unsigned char* lds, const ChunkRegs& R, bool hasQ, float lgf, float ef0, float lgb, float eb0) {
    const int tid = threadIdx.x, j = tid >> 2, c0 = (tid & 3) * 16;
    LAS bf16_t* Ks = (LAS bf16_t*)(lds + R_K); LAS bf16_t* Kf = (LAS bf16_t*)(lds + R_KF); LAS bf16_t* Kb = (LAS bf16_t*)(lds + R_KB); LAS bf16_t* Vs = (LAS bf16_t*)(lds + R_V);
    *(LAS u32x4*)(Ks + j * LQ + c0) = R.k0; *(LAS u32x4*)(Ks + j * LQ + c0 + 8) = R.k1;
    *(LAS u32x4*)(Vs + j * LQ + c0) = R.v0; *(LAS u32x4*)(Vs + j * LQ + c0 + 8) = R.v1;
    if (hasQ) { LAS bf16_t* Qs = (LAS bf16_t*)(lds + R_Q); *(LAS u32x4*)(Qs + j * LQ + c0) = R.q0; *(LAS u32x4*)(Qs + j * LQ + c0 + 8) = R.q1; }
    const float wf = __expf(lgf * (ef0 - (float)j)), wb = __expf(lgb * (eb0 + (float)j));
    const unsigned kw[8] = {R.k0.x, R.k0.y, R.k0.z, R.k0.w, R.k1.x, R.k1.y, R.k1.z, R.k1.w};
    unsigned fw[8], bw[8];
#pragma unroll
    for (int i = 0; i < 8; ++i) { const float ka = bflo(kw[i]), kb = bfhi(kw[i]); fw[i] = pk2(ka * wf, kb * wf); bw[i] = pk2(ka * wb, kb * wb); }
    *(LAS u32x4*)(Kf + j * LQ + c0) = (u32x4){fw[0], fw[1], fw[2], fw[3]}; *(LAS u32x4*)(Kf + j * LQ + c0 + 8) = (u32x4){fw[4], fw[5], fw[6], fw[7]};
    *(LAS u32x4*)(Kb + j * LQ + c0) = (u32x4){bw[0], bw[1], bw[2], bw[3]}; *(LAS u32x4*)(Kb + j * LQ + c0 + 8) = (u32x4){bw[4], bw[5], bw[6], bw[7]};
}
DI void store_state_T(bf16_t* ST, int ld, const f32x16& s, int dkb, int dvb, int lane) {
    const int dv = 32 * dvb + (lane & 31), hh = lane >> 5;
#pragma unroll
    for (int g = 0; g < 4; ++g) { u32x2 o; o.x = pk2(s[4 * g], s[4 * g + 1]); o.y = pk2(s[4 * g + 2], s[4 * g + 3]);
        *(u32x2*)(ST + dv * ld + 32 * dkb + 8 * g + 4 * hh) = o; }
}
DI void store_state_T(LAS bf16_t* ST, int ld, const f32x16& s, int dkb, int dvb, int lane) {
    const int dv = 32 * dvb + (lane & 31), hh = lane >> 5;
#pragma unroll
    for (int g = 0; g < 4; ++g) { u32x2 o; o.x = pk2(s[4 * g], s[4 * g + 1]); o.y = pk2(s[4 * g + 2], s[4 * g + 3]);
        *(LAS u32x2*)(ST + dv * ld + 32 * dkb + 8 * g + 4 * hh) = o; }
}

DI void retention_item(const Params& P, LAS unsigned char* lds, int item) {
    const int tid = threadIdx.x, lane = tid & 63, wave = __builtin_amdgcn_readfirstlane(tid >> 6), hh = lane >> 5;
    const int b = item >> 4, h = (item >> 1) & 7, hf = item & 1;
    const float lgf = log1pf(-expf(P.in[I_DECF][h])), lgb = log1pf(-expf(P.in[I_DECB][h]));
    const bf16_t* QKVG = (const bf16_t*)(P.ws + WS_QKVG) + (size_t)b * SEQ * 2048;
    const bf16_t* CKV = (const bf16_t*)(P.ws + WS_CKV) + (size_t)b * CTXL * 1024;
    bf16_t* SBST = (bf16_t*)(P.ws + WS_SB) + (size_t)item * 8 * 4096;
    bf16_t* MIX = (bf16_t*)(P.ws + WS_MIX) + (size_t)b * SEQ * 1024;
    const int c0 = 8 * hf, clast = c0 + 7; const float P0 = 128.f * c0, Pend = 128.f * (clast + 1);
    LAS bf16_t* Qs = (LAS bf16_t*)(lds + R_Q); LAS bf16_t* Ks = (LAS bf16_t*)(lds + R_K); LAS bf16_t* Kf = (LAS bf16_t*)(lds + R_KF); LAS bf16_t* Kb = (LAS bf16_t*)(lds + R_KB);
    LAS bf16_t* Vs = (LAS bf16_t*)(lds + R_V); LAS bf16_t* Ps = (LAS bf16_t*)(lds + R_P); LAS float* Os = (LAS float*)(lds + R_P);
    LAS bf16_t* SfT = (LAS bf16_t*)(lds + R_SFT); LAS bf16_t* SbT = (LAS bf16_t*)(lds + R_SBT);
    const int sdk = (wave >> 1) & 1, sdv = wave & 1;
    const bool isF = wave < 4;
    f32x16 Sacc;
#pragma unroll
    for (int i = 0; i < 16; ++i) Sacc[i] = 0.f;
    LAS float* dtab = (LAS float*)(lds + R_DTAB);
    { const int k = tid & 127, which = tid >> 7;
      dtab[tid] = which == 0 ? __expf(lgf * (float)k) : which == 1 ? __expf(lgb * (float)k) : which == 2 ? __expf(lgf * (float)(k + 1)) : __expf(lgb * (float)(128 - k)); }
    const float gb128 = __expf(lgb * 128.f), gf128 = __expf(lgf * 128.f);
    ChunkRegs R; u32x4 gat0, gat1, gn0, gn1, sbr;
    const int grow = tid >> 2, gq4 = tid & 3;
#define RET_DESC(S_, SRC_, STRIDE_, CQ_, CK_, CV_) do { \
        if ((S_) < 2) { SRC_ = CKV + (size_t)(128 * (S_)) * 1024; STRIDE_ = 1024; CQ_ = -1; CK_ = h * 64; CV_ = 512 + h * 64; } \
        else { const int c_ = (S_) < 10 ? (hf ? 0 : 8) + ((S_) - 2) : (S_) < 17 ? clast - ((S_) - 10) : c0 + ((S_) - 17); \
               SRC_ = QKVG + (size_t)(128 * c_) * 2048; STRIDE_ = 2048; CQ_ = (S_) >= 17 ? h * 64 : -1; CK_ = 512 + h * 64; CV_ = 1024 + h * 64; } } while (0)
    { const bf16_t* src; int stride, cq, ck, cv; RET_DESC(0, src, stride, cq, ck, cv); chunk_load(R, src, stride, cq, ck, cv); }
    for (int s = 0; s < 25; ++s) {
        float ef0 = 127.f, eb0 = 0.f; bool cf = false, cb = false;
        if (s < 2) { cf = true; cb = true; ef0 = P0 - 1.f - (-256.f + 128.f * s); eb0 = (2048.f + 128.f * s) - Pend; }
        else if (s < 10) { const float pos0 = 128.f * ((hf ? 0 : 8) + (s - 2)); cf = (hf == 1); cb = (hf == 0); ef0 = cf ? (P0 - 1.f - pos0) : 0.f; eb0 = cb ? (pos0 - Pend) : 0.f; }
        const bool fwd = s >= 17, bwd = (s >= 10 && s < 17);
        const int c = fwd ? c0 + (s - 17) : bwd ? clast - (s - 10) : 0;
        if ((bwd || s == 17) && !isF) store_state_T(SBST + (size_t)(c - c0) * 4096, 64, Sacc, sdk, sdv, lane);
        __syncthreads();
        chunk_store(lds, R, fwd, lgf, ef0, lgb, eb0);
        if (fwd) {
            if (isF) store_state_T(SfT, LQ, Sacc, sdk, sdv, lane);
            if (s == 17) { const int r = tid >> 3, pc = tid & 7; sbr = *(const u32x4*)(SBST + (size_t)(c - c0) * 4096 + r * 64 + pc * 8); }
            { const int r = tid >> 3, pc = tid & 7; *(LAS u32x4*)(SbT + r * LQ + pc * 8) = sbr; }
            gat0 = gn0; gat1 = gn1;
            if (s == 17) { const bf16_t* gp = QKVG + (size_t)(128 * c + grow) * 2048 + 1536 + h * 64 + 16 * gq4; gat0 = *(const u32x4*)gp; gat1 = *(const u32x4*)(gp + 8); }
        }
        if (s + 1 < 25) {
            const bf16_t* src; int stride, cq, ck, cv; RET_DESC(s + 1, src, stride, cq, ck, cv); chunk_load(R, src, stride, cq, ck, cv);
            if (s + 1 > 17) { const int cn = c0 + (s + 1 - 17);
                const bf16_t* gp = QKVG + (size_t)(128 * cn + grow) * 2048 + 1536 + h * 64 + 16 * gq4; gn0 = *(const u32x4*)gp; gn1 = *(const u32x4*)(gp + 8);
                const int r = tid >> 3, pc = tid & 7; sbr = *(const u32x4*)(SBST + (size_t)(cn - c0) * 4096 + r * 64 + pc * 8); }
        }
        __syncthreads();
        if (!fwd) {
            if (s < 10) {
                if (isF) { if (cf) Sacc = mma_tile_tt(Kf + 32 * sdk, Vs + 32 * sdv, LQ, 128, Sacc, lane); }
                else { if (cb) Sacc = mma_tile_tt(Kb + 32 * sdk, Vs + 32 * sdv, LQ, 128, Sacc, lane); }
            } else if (!isF) { Sacc = Sacc * gb128; Sacc = mma_tile_tt(Kb + 32 * sdk, Vs + 32 * sdv, LQ, 128, Sacc, lane); }
            continue;
        }
        const int ib = wave >> 1, db = wave & 1;
#pragma unroll
        for (int t = 0; t < 2; ++t) {
            const int jb = 2 * db + t;
            f32x16 sc = mma_tile(Qs + 32 * ib * LQ, LQ, Ks + 32 * jb * LQ, LQ, 64, zero16(), lane);
            const int j = 32 * jb + (lane & 31);
#pragma unroll
            for (int r = 0; r < 16; ++r) { const int i = 32 * ib + crow(r, hh); const int dlt = i - j;
                const float dec = dtab[dlt >= 0 ? dlt : 128 - dlt];
                Ps[i * LT + j] = f2bf(sc[r] * dec); }
        }
        __syncthreads();
        f32x16 o = mma_tile_rt(Ps + 32 * ib * LT, LT, Vs + 32 * db, LQ, 128, zero16(), lane);
        f32x16 tf = mma_tile(Qs + 32 * ib * LQ, LQ, SfT + 32 * db * LQ, LQ, 64, zero16(), lane);
        f32x16 tb = mma_tile(Qs + 32 * ib * LQ, LQ, SbT + 32 * db * LQ, LQ, 64, zero16(), lane);
#pragma unroll
        for (int r = 0; r < 16; ++r) { const int i = 32 * ib + crow(r, hh); o[r] += dtab[256 + i] * tf[r] + dtab[384 + i] * tb[r]; }
        __syncthreads();
#pragma unroll
        for (int r = 0; r < 16; ++r) Os[(32 * ib + crow(r, hh)) * LO + 32 * db + (lane & 31)] = o[r];
        if (isF) { Sacc = Sacc * gf128; Sacc = mma_tile_tt(Kf + 32 * sdk, Vs + 32 * sdv, LQ, 128, Sacc, lane); }
        __syncthreads();
        {
            const int i = grow, q4 = gq4; float ov[16]; float ss = 0.f;
#pragma unroll
            for (int e = 0; e < 16; ++e) { ov[e] = Os[i * LO + 16 * q4 + e]; ss += ov[e] * ov[e]; }
            ss += __shfl_xor(ss, 1); ss += __shfl_xor(ss, 2);
            const float rstd = rsqrtf(ss * (1.0f / 64.0f) + EPSV);
            const unsigned gw_[8] = {gat0.x, gat0.y, gat0.z, gat0.w, gat1.x, gat1.y, gat1.z, gat1.w};
            const float* gn = P.in[I_RETGAIN] + h * 64 + 16 * q4;
            unsigned ow[8];
#pragma unroll
            for (int e = 0; e < 8; ++e) {
                const float ya = ov[2 * e] * rstd * gn[2 * e] * siluf(bflo(gw_[e])), yb = ov[2 * e + 1] * rstd * gn[2 * e + 1] * siluf(bfhi(gw_[e]));
                ow[e] = pk2(ya, yb);
            }
            bf16_t* mp = MIX + (size_t)(128 * c + i) * 1024 + h * 64 + 16 * q4;
            *(u32x4*)mp = (u32x4){ow[0], ow[1], ow[2], ow[3]}; *(u32x4*)(mp + 8) = (u32x4){ow[4], ow[5], ow[6], ow[7]};
        }
    }
#undef RET_DESC
    __syncthreads();
}

DI void phase5(const Params& P) {
    const int lane = threadIdx.x & 63, wave = threadIdx.x >> 6;
    const int gw = blockIdx.x * NWAVES + wave, NGW = gridDim.x * NWAVES;
    const float* MOD = (const float*)(P.ws + WS_MOD);
    const bf16_t* O = (const bf16_t*)(P.ws + WS_QKVG);
    bf16_t* H2 = (bf16_t*)(P.ws + WS_HX); unsigned char* H2S = P.ws + WS_H2S;
    for (int r = gw; r < NTOK; r += NGW) {
        const int b = r >> 11; const float* m = MOD + (size_t)b * 6144;
        const u32x2* orow = (const u32x2*)(O + (size_t)r * DM) + lane; const f32x4* xrow = (const f32x4*)(P.in[I_X] + (size_t)r * DM) + lane;
        f32x4 ov[4], xv[4]; float ss = 0.f;
#pragma unroll
        for (int j = 0; j < 4; ++j) { const u32x2 ow = __builtin_nontemporal_load(&orow[64 * j]); ov[j] = (f32x4){bflo(ow.x), bfhi(ow.x), bflo(ow.y), bfhi(ow.y)}; xv[j] = __builtin_nontemporal_load(&xrow[64 * j]); ss += (ov[j].x * ov[j].x + ov[j].y * ov[j].y) + (ov[j].z * ov[j].z + ov[j].w * ov[j].w); }
        const float rstd = rsqrtf(wave_sum(ss) * (1.0f / DM) + EPSV);
        float ss2 = 0.f;
#pragma unroll
        for (int j = 0; j < 4; ++j) {
            const f32x4 gn = ((const f32x4*)P.in[I_NPOSTMIX])[64 * j + lane], g1 = ((const f32x4*)(m + 2048))[64 * j + lane];
            xv[j] = xv[j] + g1 * (ov[j] * rstd * gn);
            ss2 += (xv[j].x * xv[j].x + xv[j].y * xv[j].y) + (xv[j].z * xv[j].z + xv[j].w * xv[j].w);
        }
        const float rstd2 = rsqrtf(wave_sum(ss2) * (1.0f / DM) + EPSV);
#pragma unroll
        for (int j = 0; j < 4; ++j) {
            const f32x4 gn = ((const f32x4*)P.in[I_NPREFFN])[64 * j + lane], sh = ((const f32x4*)(m + 3072))[64 * j + lane], sc = ((const f32x4*)(m + 4096))[64 * j + lane];
            const f32x4 y = xv[j] * rstd2 * gn * (sc + 1.0f) + sh;
            u32x2 o; o.x = pk2(y.x, y.y); o.y = pk2(y.z, y.w);
            ((u32x2*)(H2 + (size_t)r * DM))[64 * j + lane] = o;
            int w8 = 0; w8 = __builtin_amdgcn_cvt_pk_fp8_f32(clamp448(y.x * 8.f), clamp448(y.y * 8.f), w8, false); w8 = __builtin_amdgcn_cvt_pk_fp8_f32(clamp448(y.z * 8.f), clamp448(y.w * 8.f), w8, true);
            *(unsigned*)(H2S + ((size_t)(2 * j + (lane >> 5)) * NTOKP + r) * 128 + 4 * (lane & 31)) = (unsigned)w8;
        }
    }
}

#define INS16(L, xx) do { float _x = (xx); _Pragma("unroll") for (int _i = 0; _i < 16; ++_i) { const float _t = fmaxf(L[_i], _x); _x = fminf(L[_i], _x); L[_i] = _t; } } while (0)
#define CE_DESC(a, b) do { const float _h = fmaxf((a), (b)), _l = fminf((a), (b)); (a) = _h; (b) = _l; } while (0)
DI void sort16_desc(float (&v)[16]) {
#pragma unroll
    for (int k = 2; k <= 16; k <<= 1)
#pragma unroll
        for (int j = k >> 1; j > 0; j >>= 1)
#pragma unroll
            for (int i = 0; i < 16; ++i) { const int l = i ^ j; if (l > i) { if ((i & k) == 0) CE_DESC(v[i], v[l]); else CE_DESC(v[l], v[i]); } }
}
DI void bitonic_merge16_desc(float (&v)[16]) {
#pragma unroll
    for (int j = 8; j > 0; j >>= 1)
#pragma unroll
        for (int i = 0; i < 16; ++i) { const int l = i ^ j; if (l > i) CE_DESC(v[i], v[l]); }
}
DI void merge16_top(float (&a)[16], const float (&b)[16]) {
#pragma unroll
    for (int i = 0; i < 16; ++i) a[i] = fmaxf(a[i], b[15 - i]);
    bitonic_merge16_desc(a);
}
constexpr int KLD = 136;
DI void topk_half(const LAS bf16_t* keys  , const bf16_t* qh  , float (&L)[16], int lane) {
    const int r = lane & 31, hh = lane >> 5;
    f32x16 acc[4];
#pragma unroll
    for (int t = 0; t < 4; ++t)
#pragma unroll
        for (int i = 0; i < 16; ++i) acc[t][i] = 0.f;
#pragma unroll
    for (int ks = 0; ks < 8; ks += 4) {
        bf16x8 bq[4];
#pragma unroll
        for (int u = 0; u < 4; ++u) bq[u] = *(const bf16x8*)(qh + 16 * (ks + u) + 8 * hh);
#pragma unroll
        for (int u = 0; u < 4; ++u) {
#pragma unroll
            for (int t = 0; t < 4; ++t) { const bf16x8 a = *(const LAS bf16x8*)(keys + (32 * t + r) * KLD + 16 * (ks + u) + 8 * hh); acc[t] = MFMA32(a, bq[u], acc[t]); }
            if (u & 1) __builtin_amdgcn_sched_barrier(0);
        }
    }
#pragma unroll
    for (int t = 0; t < 4; ++t) {
        float G[16];
#pragma unroll
        for (int i = 0; i < 16; ++i) {
            const unsigned idx = 32u * t + (unsigned)((i & 3) + 8 * (i >> 2));
            G[i] = __uint_as_float((__float_as_uint(acc[t][i]) & 0xFFFFFF80u) | idx);
        }
        sort16_desc(G);
        if (t == 0) {
#pragma unroll
            for (int i = 0; i < 16; ++i) L[i] = G[i];
        } else merge16_top(L, G);
        __builtin_amdgcn_sched_barrier(0);
    }
    float Pn[16];
#pragma unroll
    for (int i = 0; i < 16; ++i) { L[i] = __uint_as_float(__float_as_uint(L[i]) | ((unsigned)hh << 2)); Pn[i] = __shfl_xor(L[i], 32); }
    merge16_top(L, Pn);
}
DI unsigned pack4idx(float a, float b, float c, float d) { return (__float_as_uint(a) & 127u) | ((__float_as_uint(b) & 127u) << 8) | ((__float_as_uint(c) & 127u) << 16) | ((__float_as_uint(d) & 127u) << 24); }
DI unsigned pick_idx(unsigned w0, unsigned w1, unsigned w2, unsigned w3, unsigned a) {
    const unsigned lo = (a & 4u) ? w1 : w0, hi = (a & 4u) ? w3 : w2, w = (a & 8u) ? hi : lo;
    return (w >> (8u * (a & 3u))) & 127u;
}
typedef __bf16 bf16x2_t __attribute__((ext_vector_type(2)));
DI float dot2bf(unsigned a, unsigned b, float acc) { return __builtin_amdgcn_fdot2_f32_bf16(__builtin_bit_cast(bf16x2_t, a), __builtin_bit_cast(bf16x2_t, b), acc, false); }
#define DPP_ADD(x, ctrl) ((x) + __int_as_float(__builtin_amdgcn_update_dpp(0, __float_as_int(x), (ctrl), 0xf, 0xf, true)))
DI float dpp_sum16(float x) {
    x = DPP_ADD(x, 0x128);
    x = DPP_ADD(x, 0x141);
    x = DPP_ADD(x, 0x4E);
    x = DPP_ADD(x, 0xB1);
    return x;
}

#define DPP_MOV(x, ctrl) __int_as_float(__builtin_amdgcn_update_dpp(0, __float_as_int(x), (ctrl), 0xf, 0xf, true))
DI float dpp_sum16x4(float d0, float d1, float d2, float d3, int l16) {
    const bool hi = (l16 & 8) != 0;
    float k0 = hi ? d2 : d0, k1 = hi ? d3 : d1; const float g0 = hi ? d0 : d2, g1 = hi ? d1 : d3;
    k0 += DPP_MOV(g0, 0x128); k1 += DPP_MOV(g1, 0x128);
    const bool b2 = (l16 & 4) != 0;
    float k = b2 ? k1 : k0; const float gv = b2 ? k0 : k1;
    k += DPP_MOV(gv, 0x141);
    k += DPP_MOV(k, 0xB1);
    k += DPP_MOV(k, 0x4E);
    return k;
}

DI unsigned peer_expert(unsigned blk, unsigned row) { const unsigned e1 = row >> 2; return e1 * 128u + (row & 3u) * 32u + ((blk - e1) & 31u); }

constexpr int P7_IDS = 69632, P7_WTS = 77952, P7_SID = 94336, P7_SWT = 102528, P7_CUM = 118912;
DI void phase7_keys(const Params& P, LAS unsigned char* lds) {
    const int tid = threadIdx.x;
    LAS bf16_t* keys = (LAS bf16_t*)lds; const bf16_t* KEYS = (const bf16_t*)(P.ws + WS_KEYS);
    for (int i = tid; i < 256 * 16; i += NTHREADS) { const int r = i >> 4, pc = i & 15; *(LAS u32x4*)(keys + r * KLD + pc * 8) = *(const u32x4*)(KEYS + r * 128 + pc * 8); }
}
DI void phase7(const Params& P, LAS unsigned char* lds, const bool pre) {
    const int tid = threadIdx.x, lane = tid & 63, wave = tid >> 6;
    LAS bf16_t* keys = (LAS bf16_t*)lds;
    LAS bf16_t* ids_l = (LAS bf16_t*)(lds + P7_IDS);
    LAS float* wts_l = (LAS float*)(lds + P7_WTS);
    LAS bf16_t* sid_l = (LAS bf16_t*)(lds + P7_SID);
    LAS float* swt_l = (LAS float*)(lds + P7_SWT);
    LAS unsigned char* cum_l = (LAS unsigned char*)(lds + P7_CUM);
    LAS unsigned* msk_l = (LAS unsigned*)(lds + P7_CUM + 1280);
    if (!pre) phase7_keys(P, lds);
    __syncthreads();
    const bf16_t* PQ = (const bf16_t*)(P.ws + WS_FT);
    bf16_t* SID = (bf16_t*)(P.ws + WS_SID); unsigned* LSTG = (unsigned*)(P.ws + WS_SIDB); float* SWT = (float*)(P.ws + WS_SWT);
    unsigned* OVF = (unsigned*)(P.ws + WS_OVF); unsigned* ovf_cnt = (unsigned*)P.ws + 3500;
    for (int tile = blockIdx.x; tile < 1024; tile += gridDim.x) {
        const int t0 = tile * 32;
        {
            const int h = wave, tl = lane & 31, tok = t0 + tl, hh = lane >> 5;
            const bf16_t* qrow = PQ + (size_t)tok * 2048 + h * 256;
            float L1[16], L2[16];
            topk_half(keys, qrow, L1, lane);
            __builtin_amdgcn_sched_barrier(0);
            topk_half(keys + 128 * KLD, qrow + 128, L2, lane);
            __builtin_amdgcn_sched_barrier(0);
            const unsigned w10 = pack4idx(L1[0], L1[1], L1[2], L1[3]), w11 = pack4idx(L1[4], L1[5], L1[6], L1[7]), w12 = pack4idx(L1[8], L1[9], L1[10], L1[11]), w13 = pack4idx(L1[12], L1[13], L1[14], L1[15]);
            const unsigned w20 = pack4idx(L2[0], L2[1], L2[2], L2[3]), w21 = pack4idx(L2[4], L2[5], L2[6], L2[7]), w22 = pack4idx(L2[8], L2[9], L2[10], L2[11]), w23 = pack4idx(L2[12], L2[13], L2[14], L2[15]);
#define CAND(a_, b_) __uint_as_float((__float_as_uint(L1[a_] + L2[b_]) & 0xFFFFFF00u) | (unsigned)((a_) * 16 + (b_)))
            float C[16], Bq[16], Cq[16];
#pragma unroll
            for (int i = 0; i < 16; ++i) C[i] = CAND(0, i);
#pragma unroll
            for (int i = 0; i < 8; ++i) { Bq[i] = CAND(1, i); Bq[8 + i] = CAND(15 - i, 0); }
            bitonic_merge16_desc(Bq);
            merge16_top(C, Bq);
            Cq[0] = CAND(2, 0); Cq[1] = CAND(2, 1); Cq[2] = CAND(2, 2); Cq[3] = CAND(2, 3); Cq[4] = CAND(2, 4);
            Cq[5] = CAND(3, 0); Cq[6] = CAND(3, 1); Cq[7] = CAND(3, 2); Cq[8] = CAND(3, 3);
            Cq[9] = CAND(4, 0); Cq[10] = CAND(4, 1); Cq[11] = CAND(4, 2);
            Cq[12] = -3.0e38f; Cq[13] = -3.0e38f; Cq[14] = -3.0e38f; Cq[15] = -3.0e38f;
            sort16_desc(Cq);
            merge16_top(C, Cq);
            INS16(C, CAND(5, 0)); INS16(C, CAND(5, 1)); INS16(C, CAND(6, 0)); INS16(C, CAND(6, 1)); INS16(C, CAND(7, 0)); INS16(C, CAND(7, 1));
#undef CAND
            float e[16], sum = 0.f;
#pragma unroll
            for (int i = 0; i < 16; ++i) { e[i] = __expf(C[i] - C[0]); sum += e[i]; }
            const float inv = 1.0f / sum;
            if (hh == 0) {
#pragma unroll
                for (int i = 0; i < 16; ++i) { const unsigned code = __float_as_uint(C[i]) & 255u;
                    ids_l[tl * 130 + h * 16 + i] = (bf16_t)(pick_idx(w10, w11, w12, w13, code >> 4) * 128u + pick_idx(w20, w21, w22, w23, code & 15u)); }
            } else {
#pragma unroll
                for (int i = 0; i < 16; ++i) wts_l[tl * 128 + h * 16 + i] = e[i] * inv;
            }
        }
        __syncthreads();
        {
            const int tl = tid >> 4, j = tid & 15;
            for (int i = tid; i < 32 * 32 * 4; i += NTHREADS) msk_l[i] = 0u;
            __syncthreads();
            unsigned myid[8], myb[8];
#pragma unroll
            for (int m = 0; m < 8; ++m) { myid[m] = ids_l[tl * 130 + 8 * j + m]; myb[m] = peer_blk(myid[m]); }
#pragma unroll
            for (int m = 0; m < 8; ++m) { const int i = 8 * j + m; atomicOr((unsigned*)&msk_l[(tl * 32 + myb[m]) * 4 + (i >> 5)], 1u << (i & 31)); }
            __syncthreads();
            {
                const u32x4 ma = *(const LAS u32x4*)(msk_l + (tl * 32 + j) * 4), mb = *(const LAS u32x4*)(msk_l + (tl * 32 + 16 + j) * 4);
                const unsigned ca = __builtin_popcount(ma.x) + __builtin_popcount(ma.y) + __builtin_popcount(ma.z) + __builtin_popcount(ma.w);
                const unsigned cb2 = __builtin_popcount(mb.x) + __builtin_popcount(mb.y) + __builtin_popcount(mb.z) + __builtin_popcount(mb.w);
                unsigned sa = ca, sb = cb2;
#pragma unroll
                for (int o = 1; o < 16; o <<= 1) { const unsigned ua = __shfl_up(sa, o, 16), ub = __shfl_up(sb, o, 16); if (j >= o) { sa += ua; sb += ub; } }
                const unsigned tot_a = __shfl(sa, 15, 16);
                cum_l[tl * 40 + j] = (unsigned char)(sa - ca); cum_l[tl * 40 + 16 + j] = (unsigned char)(tot_a + sb - cb2); if (j == 0) cum_l[tl * 40 + 32] = 128;
            }
            __syncthreads();
#pragma unroll
            for (int m = 0; m < 8; ++m) {
                const int i = 8 * j + m; const LAS unsigned* mk = msk_l + (tl * 32 + myb[m]) * 4;
                unsigned before = 0;
#pragma unroll
                for (int w = 0; w < 4; ++w) { const unsigned mw = mk[w]; const unsigned sel = (w < (i >> 5)) ? mw : (w == (i >> 5)) ? (mw & ((1u << (i & 31)) - 1u)) : 0u; before += __builtin_popcount(sel); }
                const unsigned rank = (unsigned)cum_l[tl * 40 + myb[m]] + before;
                sid_l[tl * 128 + rank] = (bf16_t)myid[m]; swt_l[tl * 128 + rank] = wts_l[tl * 128 + i];
            }
        }
        __syncthreads();
        {
            const int tl = tid >> 4, pc = tid & 15;
            *(u32x4*)(SID + (size_t)(t0 + tl) * 128 + pc * 8) = *(const LAS u32x4*)(sid_l + tl * 128 + pc * 8);
            *(u32x4*)(SWT + (size_t)(t0 + tl) * 128 + pc * 4) = *(const LAS u32x4*)(swt_l + tl * 128 + pc * 4);
            *(u32x4*)(SWT + (size_t)(t0 + tl) * 128 + 64 + pc * 4) = *(const LAS u32x4*)(swt_l + tl * 128 + 64 + pc * 4);
#pragma unroll
            for (int rr = 0; rr < 2; ++rr) {
                const int cell = tid + rr * NTHREADS, eb = cell >> 5, tk = cell & 31, u8 = tk >> 3, slot = tk & 7;
                unsigned off = 0;
                for (int sl = 0; sl < slot; ++sl) off += (unsigned)cum_l[(u8 * 8 + sl) * 40 + eb + 1] - (unsigned)cum_l[(u8 * 8 + sl) * 40 + eb];
                const unsigned lo = cum_l[tk * 40 + eb], cnt = (unsigned)cum_l[tk * 40 + eb + 1] - lo;
                unsigned* lp = LSTG + ((size_t)eb * 4096 + (size_t)(t0 >> 3) + u8) * 64;
                for (unsigned jj = 0; jj < cnt; ++jj) {
                    const unsigned sidx = lo + jj, row = peer_row((unsigned)sid_l[tk * 128 + sidx]);
                    if (off + jj < 63u) lp[1 + 4 * ((off + jj) & 15u) + ((off + jj) >> 4)] = sidx | (row << 7) | ((unsigned)slot << 16);
                    else { const unsigned oi = atomicAdd(ovf_cnt, 1u); if (oi < (unsigned)OVF_CAP) { OVF[2 * oi] = ((unsigned)(t0 + tk) << 7) | sidx; OVF[2 * oi + 1] = row | ((unsigned)eb << 16); } }
                }
                if (slot == 7) lp[0] = (off + cnt < 63u) ? off + cnt : 63u;
            }
        }
        __syncthreads();
    }
}

DI int peer_role(const unsigned* xctr, int my_xcc, int my_xrank) {
    bool ok = (gridDim.x == 256) && my_xcc < 8 && my_xrank < 32;
#pragma unroll
    for (int j = 0; j < 8; ++j) ok = ok && (__hip_atomic_load(&xctr[64 * j], __ATOMIC_RELAXED, __HIP_MEMORY_SCOPE_AGENT) == 32u);
    return ok ? (my_xrank * 8 + my_xcc) : (int)blockIdx.x;
}

constexpr int U_TAB = 131072;
typedef float f32x2v __attribute__((ext_vector_type(2)));
typedef int i32x8 __attribute__((ext_vector_type(8)));
typedef int i32x4v __attribute__((ext_vector_type(4)));
DI void phase8_table(const Params& P, LAS unsigned char* lds, const int role) {
    const int tid = threadIdx.x, ds = role & 7, eb = role >> 3;
    const u32x4* src = (const u32x4*)(P.ws + WS_UB + (size_t)(eb * 8 + ds) * 512 * 128);
#pragma unroll 8
    for (int idx = tid; idx < 4096; idx += NTHREADS) { const u32x4 v = src[idx]; LAS unsigned char* d = lds + (idx >> 3) * 256 + (idx & 7) * 16; *(LAS u32x4*)d = v; *(LAS u32x4*)(d + 128) = v; }
}
template <int VAR> DI void phase8(const Params& P, LAS unsigned char* lds, _Float16* PART, const int role0, const bool pre) {
    const int tid = threadIdx.x, lane = tid & 63, wave = __builtin_amdgcn_readfirstlane(tid >> 6), g4 = lane >> 4, l16 = lane & 15, i16 = lane & 15;
    const bool isdiag = (lane >> 4) == ((lane & 15) >> 2); const int dsel = lane & 3;
    LAS unsigned char* tab = lds;
    LAS unsigned char* hst = lds + U_TAB + wave * 4096;
    volatile LAS unsigned* xsv = (volatile LAS unsigned*)(lds + LDS_BYTES - 16); unsigned sv0 = 0u, sv1 = 0u; if (tid == 0) { sv0 = xsv[0]; sv1 = xsv[1]; }
    const unsigned char* H2S = P.ws + WS_H2S;
    const unsigned* LSTG = (const unsigned*)(P.ws + WS_SIDB);
    const unsigned* OVF = (const unsigned*)(P.ws + WS_OVF); unsigned* ovf_cnt = (unsigned*)P.ws + 3500;
    for (int role = role0; role < 256; role += gridDim.x) {
        const int ds = role & 7, eb = role >> 3;
        TS_BEGIN(1);
        if (!(pre && role == role0)) { __syncthreads(); phase8_table(P, lds, role); }
        __syncthreads();
        TS_END(1);
        TS_BEGIN(2);
        const unsigned* lpl = LSTG + (size_t)eb * 4096 * 64;
        const unsigned char* hpl = H2S + (size_t)ds * NTOKP * 128;
        _Float16* ppl = PART + (size_t)ds * NTOK * 128;
        const unsigned g0 = (unsigned)(128 * (i16 >> 3) + 16 * ((2 * g4) ^ (i16 & 7))), g1 = g0 ^ 16u;
#define U_DECL(S) unsigned hd##S, e##S##0, e##S##1, e##S##2, e##S##3; u32x4 ha##S;
        U_DECL(0) U_DECL(1) U_DECL(2) U_DECL(3) U_DECL(4) U_DECL(5) U_DECL(6) U_DECL(7)
#define U_LOADSET(S, IT_) do { const int tl_ = ((IT_) < 512 ? (IT_) : 511) * 8 + wave; const unsigned* lp_ = lpl + (size_t)tl_ * 64; \
            hd##S = lp_[0]; { const u32x4 q_ = *(const u32x4*)(lp_ + 1 + 4 * i16); e##S##0 = q_.x; e##S##1 = q_.y; e##S##2 = q_.z; e##S##3 = q_.w; } \
            ha##S = *(const u32x4*)(hpl + (size_t)tl_ * 1024 + lane * 16); } while (0)
#define U_SEL(C_) ((dsel & 2) ? ((dsel & 1) ? (C_).w : (C_).z) : ((dsel & 1) ? (C_).y : (C_).x))
#define U_FRAG(B_, O_) __builtin_shufflevector(*(const LAS i32x4v*)((B_) + (O_) + g0), *(const LAS i32x4v*)((B_) + (O_) + g1), 0, 1, 2, 3, 4, 5, 6, 7)
#define U_MMA(A_, B_) __builtin_amdgcn_mfma_scale_f32_16x16x128_f8f6f4((A_), (B_), (f32x4){0.f, 0.f, 0.f, 0.f}, 0, 0, 0, 127, 0, 127)
#define U_ST(PT_, E_, R_) (PT_)[(((E_) >> 16) << 7) + ((E_) & 127u)] = (_Float16)(R_)
#define U_SETX(EA_, EB_, K_) do { const bool va_ = (K_) + i16 < totA_, vb_ = (K_) + i16 < totB_; const unsigned ea_ = va_ ? (EA_) : 0u, eb_ = vb_ ? (EB_) : 0u; \
            const i32x8 hva_ = U_FRAG(hst, (ea_ >> 16) * 256), uva_ = U_FRAG(tab, ((ea_ >> 7) & 511u) * 256), hvb_ = U_FRAG(hst + 2048, (eb_ >> 16) * 256), uvb_ = U_FRAG(tab, ((eb_ >> 7) & 511u) * 256); \
            __builtin_amdgcn_sched_barrier(0); \
            const f32x4 ca_ = U_MMA(uva_, hva_), cb_ = U_MMA(uvb_, hvb_); \
            float ra_ = U_SEL(ca_), rb_ = U_SEL(cb_); asm volatile("" : "+v"(ra_), "+v"(rb_)); \
            if (isdiag) { if (va_) U_ST(ptA_, ea_, ra_); if (vb_) U_ST(ptB_, eb_, rb_); } } while (0)
#define U_BODY2(SA, SB, IT_) do { \
            { LAS unsigned char* d_ = hst + (lane >> 3) * 256 + (lane & 7) * 16; *(LAS u32x4*)d_ = ha##SA; *(LAS u32x4*)(d_ + 128) = ha##SA; *(LAS u32x4*)(d_ + 2048) = ha##SB; *(LAS u32x4*)(d_ + 2048 + 128) = ha##SB; } \
            const int totA_ = __builtin_amdgcn_readfirstlane((int)hd##SA), totB_ = __builtin_amdgcn_readfirstlane((int)hd##SB); \
            _Float16* ptA_ = ppl + (size_t)((IT_) * 8 + wave) * 1024; _Float16* ptB_ = ppl + (size_t)(((IT_) + 1) * 8 + wave) * 1024; \
            if (VAR != 1) { \
                { const bool va0_ = i16 < totA_, va1_ = 16 + i16 < totA_, vb0_ = i16 < totB_, vb1_ = 16 + i16 < totB_; \
                  const unsigned ea0_ = va0_ ? e##SA##0 : 0u, ea1_ = va1_ ? e##SA##1 : 0u, eb0_ = vb0_ ? e##SB##0 : 0u, eb1_ = vb1_ ? e##SB##1 : 0u; \
                  const i32x8 ha0_ = U_FRAG(hst, (ea0_ >> 16) * 256), ua0_ = U_FRAG(tab, ((ea0_ >> 7) & 511u) * 256), ha1_ = U_FRAG(hst, (ea1_ >> 16) * 256), ua1_ = U_FRAG(tab, ((ea1_ >> 7) & 511u) * 256); \
                  const i32x8 hb0_ = U_FRAG(hst + 2048, (eb0_ >> 16) * 256), ub0_ = U_FRAG(tab, ((eb0_ >> 7) & 511u) * 256), hb1_ = U_FRAG(hst + 2048, (eb1_ >> 16) * 256), ub1_ = U_FRAG(tab, ((eb1_ >> 7) & 511u) * 256); \
                  __builtin_amdgcn_sched_barrier(0); \
                  const f32x4 ca0_ = U_MMA(ua0_, ha0_), ca1_ = U_MMA(ua1_, ha1_), cb0_ = U_MMA(ub0_, hb0_), cb1_ = U_MMA(ub1_, hb1_); \
                  float ra0_ = U_SEL(ca0_), ra1_ = U_SEL(ca1_), rb0_ = U_SEL(cb0_), rb1_ = U_SEL(cb1_); asm volatile("" : "+v"(ra0_), "+v"(ra1_), "+v"(rb0_), "+v"(rb1_)); \
                  if (isdiag) { if (va0_) U_ST(ptA_, ea0_, ra0_); if (va1_) U_ST(ptA_, ea1_, ra1_); if (vb0_) U_ST(ptB_, eb0_, rb0_); if (vb1_) U_ST(ptB_, eb1_, rb1_); } } \
                if (totA_ > 32 || totB_ > 32) U_SETX(e##SA##2, e##SB##2, 32); \
                if (totA_ > 48 || totB_ > 48) U_SETX(e##SA##3, e##SB##3, 48); } \
            U_LOADSET(SA, (IT_) + 8); U_LOADSET(SB, (IT_) + 9); } while (0)
        U_LOADSET(0, 0); U_LOADSET(1, 1); U_LOADSET(2, 2); U_LOADSET(3, 3); U_LOADSET(4, 4); U_LOADSET(5, 5); U_LOADSET(6, 6); U_LOADSET(7, 7);
        for (int it = 0; it < 512; it += 8) { U_BODY2(0, 1, it); U_BODY2(2, 3, it + 2); U_BODY2(4, 5, it + 4); U_BODY2(6, 7, it + 6); }
#undef U_DECL
#undef U_LOADSET
#undef U_SEL
#undef U_FRAG
#undef U_MMA
#undef U_ST
#undef U_SETX
#undef U_BODY2
        {
            const unsigned novf = min(__hip_atomic_load(ovf_cnt, __ATOMIC_RELAXED, __HIP_MEMORY_SCOPE_AGENT), (unsigned)OVF_CAP);
            if (wave == 0 && g4 == 0) {
                for (unsigned i = 0; i < novf; ++i) {
                    const unsigned w0 = OVF[2 * i], w1 = OVF[2 * i + 1];
                    if ((int)(w1 >> 16) != eb) continue;
                    const unsigned t = w0 >> 7, sidx = w0 & 127u, row = w1 & 511u;
                    const u32x2 hv = *(const u32x2*)(hpl + (size_t)t * 128 + 8 * l16);
                    const u32x2 u = *(const LAS u32x2*)(tab + row * 256 + 8 * l16);
                    const f32x2v u0 = __builtin_amdgcn_cvt_pk_f32_fp8((int)u.x, false), u1 = __builtin_amdgcn_cvt_pk_f32_fp8((int)u.x, true), u2 = __builtin_amdgcn_cvt_pk_f32_fp8((int)u.y, false), u3 = __builtin_amdgcn_cvt_pk_f32_fp8((int)u.y, true);
                    const f32x2v h0 = __builtin_amdgcn_cvt_pk_f32_fp8((int)hv.x, false), h1 = __builtin_amdgcn_cvt_pk_f32_fp8((int)hv.x, true), h2 = __builtin_amdgcn_cvt_pk_f32_fp8((int)hv.y, false), h3 = __builtin_amdgcn_cvt_pk_f32_fp8((int)hv.y, true);
                    float d = (u0.x * h0.x + u0.y * h0.y) + (u1.x * h1.x + u1.y * h1.y) + (u2.x * h2.x + u2.y * h2.y) + (u3.x * h3.x + u3.y * h3.y);
                    d = dpp_sum16(d);
                    if (l16 == 0) ppl[(size_t)t * 128 + sidx] = (_Float16)d;
                }
            }
        }
        TS_END(2);
    }
    __syncthreads();
    if (tid == 0) { xsv[0] = sv0; xsv[1] = sv1; }
}

DI void phase9(const Params& P, LAS unsigned char* lds) {
    const int tid = threadIdx.x;
    LAS unsigned* stage = (LAS unsigned*)lds;
    const _Float16* PART = (const _Float16*)(P.ws + WS_PART); const float* SWT = (const float*)(P.ws + WS_SWT); const bf16_t* SID = (const bf16_t*)(P.ws + WS_SID);
    unsigned* CIT = (unsigned*)(P.ws + WS_CIT);
    for (int tile = blockIdx.x; tile < 512; tile += gridDim.x) {
        const int t0 = tile * 64;
        __syncthreads();
#pragma unroll 4
        for (int it = 0; it < 16; ++it) {
            const int tl = (tid >> 7) + 4 * it, s = tid & 127; const size_t pi = (size_t)(t0 + tl) * 128 + s;
            float act = 0.f;
#pragma unroll
            for (int d = 0; d < 8; ++d) act += (float)PART[(size_t)d * NTOK * 128 + pi];
            const float coef = SWT[pi] * gelu_erf(act * (1.0f / 512.0f));
            const unsigned id_ = (unsigned)SID[pi], idp = (id_ & ~31u) | peer_blk(id_);
            stage[tl * 132 + s] = (idp << 16) | (unsigned)__builtin_bit_cast(unsigned short, (_Float16)coef);
        }
        __syncthreads();
        {
            const int sg = tid >> 4, tq = tid & 15;
#pragma unroll
            for (int q = 0; q < 4; ++q) { const int tk = tq + 16 * q;
                *(u32x4*)(CIT + ((size_t)sg * NTOK + t0 + tk) * 4) = *(const LAS u32x4*)(stage + tk * 132 + ((sg + ((t0 + tk) & 31)) & 31) * 4); }
        }
    }
}

typedef _Float16 f16x2 __attribute__((ext_vector_type(2)));
DI void phase10_table(const Params& P, LAS unsigned char* lds, const int role) {
    const int tid = threadIdx.x, xl = role & 7, r = role >> 3, c = xl * 16 + (r & 15);
    const u32x4* src = (const u32x4*)(P.ws + WS_VB8 + (size_t)c * 16384 * 8);
#pragma unroll 8
    for (int idx = tid; idx < 8192; idx += NTHREADS) *(LAS u32x4*)(lds + idx * 16) = src[idx];
}
DI void phase10(const Params& P, LAS unsigned char* lds, const int role0, const bool pre) {
    const int tid = threadIdx.x, lane = tid & 63, wave = tid >> 6;
    LAS unsigned char* tab = lds;
    const unsigned* CIT = (const unsigned*)(P.ws + WS_CIT);
    float* POUT = (float*)(P.ws + WS_POUT);
    for (int role = role0; role < 256; role += gridDim.x) {
        const int xl = role & 7, r = role >> 3, c = xl * 16 + (r & 15), half = r >> 4;
        if (!(pre && role == role0)) { __syncthreads(); phase10_table(P, lds, role); }
        __syncthreads();
        const int tb = half * (NTOK / 2) + lane;
        f16x2 a0 = {0, 0}, a1 = {0, 0}, a2 = {0, 0}, a3 = {0, 0};
        u32x4 cb[8], nb[8];
#pragma unroll
        for (int i = 0; i < 8; ++i) cb[i] = *(const u32x4*)(CIT + ((size_t)i * NTOK + tb + wave * 64) * 4);
#define V_BLOCK(CUR, NXT, BLK) do { \
            { const int nk = (BLK) < 127 ? (BLK) + 1 : 127, tn = tb + (wave + NWAVES * (nk >> 2)) * 64, sgn = (nk & 3) * 8; \
              _Pragma("unroll") for (int i = 0; i < 8; ++i) NXT[i] = *(const u32x4*)(CIT + ((size_t)(sgn + i) * NTOK + tn) * 4); } \
            _Pragma("unroll") for (int i = 0; i < 8; ++i) { \
                const unsigned cw[4] = {CUR[i].x, CUR[i].y, CUR[i].z, CUR[i].w}; \
                _Pragma("unroll") for (int q = 0; q < 4; ++q) { \
                    const f16x2 cf = __builtin_bit_cast(f16x2, cw[q]), cl = __builtin_shufflevector(cf, cf, 0, 0);     \
                    const u32x2 v = *(const LAS u32x2*)(tab + (cw[q] >> 16) * 8); \
                    const f16x2 p0 = __builtin_amdgcn_cvt_scalef32_pk_f16_fp8((int)v.x, 0.25f, false), p1 = __builtin_amdgcn_cvt_scalef32_pk_f16_fp8((int)v.x, 0.25f, true); \
                    const f16x2 p2 = __builtin_amdgcn_cvt_scalef32_pk_f16_fp8((int)v.y, 0.25f, false), p3 = __builtin_amdgcn_cvt_scalef32_pk_f16_fp8((int)v.y, 0.25f, true); \
                    a0 = __builtin_elementwise_fma(cl, p0, a0); a1 = __builtin_elementwise_fma(cl, p1, a1); a2 = __builtin_elementwise_fma(cl, p2, a2); a3 = __builtin_elementwise_fma(cl, p3, a3); \
                } \
                if (i & 1) __builtin_amdgcn_sched_barrier(0); \
            } } while (0)
#pragma unroll 1
        for (int blk = 1; blk < 128; blk += 2) {
            V_BLOCK(cb, nb, blk - 1);
            V_BLOCK(nb, cb, blk);
            if ((blk & 3) == 3) {
                const int t = tb + (wave + NWAVES * (blk >> 2)) * 64;
                const float sc = 1.0f / 128.0f;
                const f32x4 o0 = (f32x4){(float)a0.x * sc, (float)a0.y * sc, (float)a1.x * sc, (float)a1.y * sc}, o1 = (f32x4){(float)a2.x * sc, (float)a2.y * sc, (float)a3.x * sc, (float)a3.y * sc};
                const f32x4 s0 = (f32x4){DPP_MOV(o0.x, 0xB1), DPP_MOV(o0.y, 0xB1), DPP_MOV(o0.z, 0xB1), DPP_MOV(o0.w, 0xB1)}, s1 = (f32x4){DPP_MOV(o1.x, 0xB1), DPP_MOV(o1.y, 0xB1), DPP_MOV(o1.z, 0xB1), DPP_MOV(o1.w, 0xB1)};
                const int pp = lane & 1;
                float* op = POUT + ((size_t)xl * NTOK + (t - pp)) * 128 + 8 * (c & 15) + 4 * pp;
                *(f32x4*)op = pp ? s1 : o0; *(f32x4*)(op + 128) = pp ? o1 : s0;
                a0 = (f16x2){0, 0}; a1 = a0; a2 = a0; a3 = a0;
            }
        }
#undef V_BLOCK
    }
}

DI void phase11(const Params& P) {
    const int lane = threadIdx.x & 63, wave = threadIdx.x >> 6;
    const int gw = blockIdx.x * NWAVES + wave, NGW = gridDim.x * NWAVES;
    const float* MOD = (const float*)(P.ws + WS_MOD);
    const float* POUT = (const float*)(P.ws + WS_POUT);
    const bf16_t* O = (const bf16_t*)(P.ws + WS_QKVG);
    for (int t = gw; t < NTOK; t += NGW) {
        const int b = t >> 11; const float* m = MOD + (size_t)b * 6144;
        f32x4 acc[4], ov[4], xv[4]; float ss = 0.f, so = 0.f;
#pragma unroll
        for (int j = 0; j < 4; ++j) {
            acc[j] = __builtin_nontemporal_load((const f32x4*)(POUT + ((size_t)(2 * j + (lane >> 5)) * NTOK + t) * 128 + 4 * (lane & 31)));
            const u32x2 ow = __builtin_nontemporal_load(&((const u32x2*)(O + (size_t)t * DM))[64 * j + lane]); ov[j] = (f32x4){bflo(ow.x), bfhi(ow.x), bflo(ow.y), bfhi(ow.y)};
            xv[j] = __builtin_nontemporal_load(&((const f32x4*)(P.in[I_X] + (size_t)t * DM))[64 * j + lane]);
            ss += (acc[j].x * acc[j].x + acc[j].y * acc[j].y) + (acc[j].z * acc[j].z + acc[j].w * acc[j].w);
            so += (ov[j].x * ov[j].x + ov[j].y * ov[j].y) + (ov[j].z * ov[j].z + ov[j].w * ov[j].w);
        }
        const float rstd = rsqrtf(wave_sum(ss) * (1.0f / DM) + EPSV), rstdo = rsqrtf(wave_sum(so) * (1.0f / DM) + EPSV);
#pragma unroll
        for (int j = 0; j < 4; ++j) {
            const f32x4 gn = ((const f32x4*)P.in[I_NPOSTFFN])[64 * j + lane], g2 = ((const f32x4*)(m + 5120))[64 * j + lane];
            const f32x4 gm = ((const f32x4*)P.in[I_NPOSTMIX])[64 * j + lane], g1 = ((const f32x4*)(m + 2048))[64 * j + lane];
            const f32x4 x1 = xv[j] + g1 * (ov[j] * rstdo * gm);
            ((f32x4*)(P.out + (size_t)t * DM))[64 * j + lane] = x1 + g2 * (acc[j] * rstd * gn);
        }
    }
}

template <int PLO, int PHI> __global__ void __launch_bounds__(NTHREADS, 2) fwd_megakernel(Params P) {
    extern __shared__ __attribute__((aligned(16))) unsigned char lds_raw[];
    LAS unsigned char* lds = (LAS unsigned char*)lds_raw;
    cg::grid_group grid = cg::this_grid();
    volatile LAS unsigned* xst = (volatile LAS unsigned*)(lds + LDS_BYTES - 16);
    if (threadIdx.x == 0) { xst[0] = 0u; xst[1] = 0u; }
    __syncthreads();
    XcdBarrier xbar = xcd_barrier_post((unsigned*)P.ws + (PLO > 0 ? 8192 : 0), xst);
    unsigned* xctr = (unsigned*)P.ws + 3584 + (PLO > 0 ? 8192 : 0);
    if (threadIdx.x == 0) xst[2] = xb_add(&xctr[64 * xbar.x], 1u);
    __syncthreads();
    const int my_xrank = __builtin_amdgcn_readfirstlane((int)xst[2]);
    const int my_xcc = (int)xbar.x;
    unsigned char* ws = P.ws;
    const int lo = P.ph_lo, hi = P.ph_hi;
    if (TIMESEC && PLO > 0 && PLO < 12 && blockIdx.x == 0 && threadIdx.x == 0) ((volatile unsigned long long*)(P.ws + 32768))[1] = 0ull;
#define IN(k) (PLO <= (k) && (k) < PHI && lo <= (k) && (k) < hi)
#define SEAM(k) do { if (IN(k) && IN((k) + 1)) { if ((k) == PLO) grid.sync(); else xcd_barrier(xbar); } } while (0)
#define RUN(k, ...) do { if (IN(k)) { TS_BEGIN(100 + (k)); TS_BEGIN(200 + (k)); __VA_ARGS__; TS_END(100 + (k)); } SEAM(k); if (IN(k)) TS_END(200 + (k)); } while (0)
    RUN(0, phase0(P, lds));
    RUN(1, { prep_tables(lds); const bool pf = (threadIdx.x >> 8) != 0; if (pf) prep_weights(P, lds); phase1(P); if (!pf) prep_weights(P, lds); });
    RUN(2, {
        { const int nskip = gridDim.x > 128u ? 64 : 0;
          if ((int)blockIdx.x >= nskip) { peer_tables(P, lds, 0, (int)blockIdx.x - nskip, (int)gridDim.x - nskip); peer_tables(P, lds, 1, (int)blockIdx.x - nskip, (int)gridDim.x - nskip); } }
        run_gemm(lds, (const bf16_t*)(ws + WS_HC), (const bf16_t*)(ws + WS_WIN) + (size_t)512 * 1024, NCTX, 1024, 1024, FPlain{(bf16_t*)(ws + WS_CKV), 1024});
        run_gemm(lds, (const bf16_t*)(ws + WS_HX), (const bf16_t*)(ws + WS_WIN), NTOK, 2048, 1024, FQkvg{(bf16_t*)(ws + WS_QKVG), (const float*)(ws + WS_ROPE), (const float*)(ws + WS_ROPE) + 2048 * 32});
        run_gemm(lds, (const bf16_t*)(ws + WS_WF), (const bf16_t*)(ws + WS_HXE), 512, 16384, 1024, FFoldT{(bf16_t*)(ws + WS_FT), 0});
        run_gemm(lds, (const bf16_t*)(ws + WS_WF) + (size_t)512 * 1024, (const bf16_t*)(ws + WS_HXO), 512, 16384, 1024, FFoldT{(bf16_t*)(ws + WS_FT), 1024}, 128);
        {
            const int lane_ = threadIdx.x & 63, gw_ = blockIdx.x * NWAVES + (threadIdx.x >> 6), NGW_ = gridDim.x * NWAVES;
            float* P1024 = (float*)(ws + WS_P1024);
            for (int o = gw_; o < 16 * 512; o += NGW_) {
                const int b = o >> 9, gl = o & 511;
                const u32x4* hr = (const u32x4*)((const bf16_t*)(ws + WS_HX) + ((size_t)b * SEQ + 1024) * DM) + 2 * lane_;
                const u32x4* wr_ = (const u32x4*)((const bf16_t*)(ws + WS_WF) + (size_t)gl * 1024) + 2 * lane_;
                const u32x4 h0 = hr[0], h1 = hr[1], w0 = wr_[0], w1 = wr_[1];
                float d = dot2bf(w0.x, h0.x, 0.f); d = dot2bf(w0.y, h0.y, d); d = dot2bf(w0.z, h0.z, d); d = dot2bf(w0.w, h0.w, d);
                d = dot2bf(w1.x, h1.x, d); d = dot2bf(w1.y, h1.y, d); d = dot2bf(w1.z, h1.z, d); d = dot2bf(w1.w, h1.w, d);
                d = wave_sum(d);
                if (lane_ == 0) P1024[o] = d;
            }
        }
    });
    RUN(3, {
        run_gemm(lds, (const bf16_t*)(ws + WS_DFT), (const bf16_t*)(ws + WS_FT), 2048, 8192, 2048, FFnetOut{(bf16_t*)(ws + WS_MIX), (const float*)(ws + WS_P1024)});
        TS_BEGIN(5);
        for (int item = blockIdx.x; item < 256; item += gridDim.x) retention_item(P, lds, item);
        TS_END(5);
    });
    RUN(4, {
        run_gemm(lds, (const bf16_t*)(ws + WS_MIX), (const bf16_t*)(ws + WS_WOUT), NTOK, 1024, 1024, FPlain{(bf16_t*)(ws + WS_QKVG), 1024});
    });
    RUN(5, phase5(P));
    const bool pre7 = IN(6) && IN(7);
    RUN(6, { run_gemm(lds, (const bf16_t*)(ws + WS_HX), (const bf16_t*)(ws + WS_WQ), NTOK, 2048, 1024, FPlain{(bf16_t*)(ws + WS_FT), 2048}); if (pre7) { __syncthreads(); phase7_keys(P, lds); } });
    const int prole = (IN(8) || IN(10)) ? peer_role(xctr, my_xcc, my_xrank) : 0;
    const bool pre8 = IN(7) && IN(8) && prole < 256, pre10 = IN(9) && IN(10) && prole < 256;
    RUN(7, { phase7(P, lds, pre7); if (pre8) { __syncthreads(); phase8_table(P, lds, prole); } });
    RUN(8, phase8<0>(P, lds, (_Float16*)(ws + WS_PART), prole, pre8));
    if (TIMESEC == 3 && SPLITK > 0 && IN(8)) { grid.sync(); TS_BEGIN(3); phase8<VARIANT>(P, lds, (_Float16*)(ws + WS_POUT), prole, false); TS_END(3); grid.sync(); }
    RUN(9, { phase9(P, lds); if (pre10) { __syncthreads(); phase10_table(P, lds, prole); } });
    RUN(10, phase10(P, lds, prole, pre10));
    if (IN(11)) phase11(P);
    if (TIMESEC && PLO > 0 && PHI == 12 && blockIdx.x == 0 && threadIdx.x == 0) {
        const unsigned long long dt = ((volatile unsigned long long*)(P.ws + 32768))[1] * TSK, t0 = __builtin_amdgcn_s_memrealtime();
        while (__builtin_amdgcn_s_memrealtime() - t0 < dt) __builtin_amdgcn_s_sleep(16);
    }
#undef RUN
#undef IN
#undef SEAM
}

template <int PLO, int PHI> static hipError_t launch_range(const Params& p0, int lo, int hi, int variant, int grid, hipStream_t stream) {
    Params p = p0; p.ph_lo = lo; p.ph_hi = hi; p.variant = variant;
    void* args[] = {&p};
    return hipLaunchCooperativeKernel((const void*)fwd_megakernel<PLO, PHI>, dim3(grid), dim3(NTHREADS), args, LDS_BYTES, stream);
}
extern "C" void kernel_launch(void* const* d_in, const int* in_sizes, int n_in, void* d_out, int out_size, void* d_ws, size_t ws_size, hipStream_t stream) {
    static int grid = 0;
    if (grid == 0) {
        int dev = 0, cus = 0;
        (void)hipGetDevice(&dev);
        (void)hipDeviceGetAttribute(&cus, hipDeviceAttributeMultiprocessorCount, dev);
        if (SPLITK == 0) (void)hipFuncSetAttribute((const void*)fwd_megakernel<0, (SPLITK > 0 ? SPLITK : 12)>, hipFuncAttributeMaxDynamicSharedMemorySize, LDS_BYTES);
        if (SPLITK > 0) {
            (void)hipFuncSetAttribute((const void*)fwd_megakernel<0, (SPLITK > 0 ? SPLITK : 12)>, hipFuncAttributeMaxDynamicSharedMemorySize, LDS_BYTES);
            (void)hipFuncSetAttribute((const void*)fwd_megakernel<(SPLITK > 0 ? SPLITK : 0), 12>, hipFuncAttributeMaxDynamicSharedMemorySize, LDS_BYTES);
        }
        grid = cus;
        if (ws_size < WS_END || n_in != 20) fprintf(stderr, "kernel_launch: unexpected ws_size %zu / n_in %d\n", ws_size, n_in);
        (void)hipGetLastError();
    }
    Params p{};
    for (int i = 0; i < 20; ++i) p.in[i] = (const float*)d_in[i];
    p.out = (float*)d_out; p.ws = (unsigned char*)d_ws;
    hipError_t e = hipMemsetAsync(d_ws, 0, 65536, stream);
    if (e != hipSuccess) fprintf(stderr, "memset failed\n");
    if (SPLITK > 0) {
        e = launch_range<0, (SPLITK > 0 ? SPLITK : 12)>(p, 0, 12, 0, grid, stream);
        if (e == hipSuccess) e = launch_range<(SPLITK > 0 ? SPLITK : 0), 12>(p, 0, 12, 0, grid, stream);
    } else if (DUPK >= 0) {
        e = launch_range<0, (SPLITK > 0 ? SPLITK : 12)>(p, 0, DUPK + 1, 0, grid, stream);
        if (e == hipSuccess) e = launch_range<0, (SPLITK > 0 ? SPLITK : 12)>(p, DUPK, 12, VARIANT, grid, stream);
    } else {
        e = launch_range<0, (SPLITK > 0 ? SPLITK : 12)>(p, 0, 12, 0, grid, stream);
    }
    if (e != hipSuccess) fprintf(stderr, "cooperative launch failed: %s (grid %d)\n", hipGetErrorString(e), grid);
}
```
